# Optimizing an MI355X kernel written in HIP

```python
import jax, jax.numpy as jnp
from jax import lax
import numpy as np


D_MODEL = 1024
BATCH = 8
SEQ = 4096
DEPTH = 2

D_MIX = D_MODEL
NSA_HEADS = 6
NSA_KV_HEADS = 2
NSA_HPG = NSA_HEADS // NSA_KV_HEADS
NSA_DH = 64
NSA_CMP_LEN = 32
NSA_CMP_STRIDE = 16
NSA_SLC_LEN = 64
NSA_TOPN = 16
NSA_WINDOW = 512
NSA_Q_BLOCK = 64
NSA_FORCE = 1.0e4
MLA_HEADS = 6
MLA_Q_LORA = 256
MLA_KV_LORA = 128
MLA_NOPE = 64
MLA_ROPE = 32
MLA_VDIM = 64
MLA_Q_BLOCK = 128
ROPE_THETA = 10000.0
POOL_WINDOWS = (2, 4, 8, 16)
POOL_GROUP = 64
POOL_WIDTH = 4 * POOL_GROUP
D_FF = 4 * D_MODEL
EPS = 1e-6

NSA_Q_W = NSA_HEADS * NSA_DH
NSA_KV_W = 3 * 2 * NSA_KV_HEADS * NSA_DH
NSA_GATE_W = 3 * NSA_HEADS
IN_SPLITS = (NSA_Q_W, NSA_KV_W, NSA_GATE_W, MLA_Q_LORA, MLA_KV_LORA, MLA_ROPE, POOL_WIDTH)
P_IN = 384 + 768 + 18 + 256 + 128 + 32 + 256

kernel_name = 'hybrid_nsa_mla_pool_trunk'


def rmsnorm(x, g):
    x32 = x.astype(jnp.float32)
    y = x32 * lax.rsqrt(jnp.mean(x32 * x32, axis=-1, keepdims=True) + EPS)
    return (y * g.astype(jnp.float32)).astype(x.dtype)


def masked_softmax(s, mask):
    s = jnp.where(mask, s.astype(jnp.float32), -jnp.inf)
    m = jnp.max(s, axis=-1, keepdims=True)
    m = jnp.where(jnp.isfinite(m), m, 0.0)
    e = jnp.exp(s - m)
    d = jnp.sum(e, axis=-1, keepdims=True)
    return e / jnp.maximum(d, jnp.finfo(jnp.float32).tiny)


def rope_cos_sin(positions, dim):
    half = dim // 2
    inv = jnp.power(jnp.float32(ROPE_THETA), -(jnp.arange(half, dtype=jnp.float32) / half))
    ang = positions.astype(jnp.float32)[..., None] * inv
    return jnp.cos(ang), jnp.sin(ang)


def apply_rope(x, cos, sin):
    half = x.shape[-1] // 2
    x1, x2 = x[..., :half], x[..., half:]
    cos = cos.astype(x.dtype)
    sin = sin.astype(x.dtype)
    return jnp.concatenate([x1 * cos - x2 * sin, x2 * cos + x1 * sin], axis=-1)


def nsa_compress(t, pos, w1, w2):
    B, G, T, DH = t.shape
    n_chunks = T // NSA_CMP_STRIDE
    r = NSA_CMP_LEN // NSA_CMP_STRIDE
    c = t.reshape(B, G, n_chunks, NSA_CMP_STRIDE, DH)
    blocks = jnp.concatenate([c[:, :, i:n_chunks - r + 1 + i] for i in range(r)], axis=3)
    h = jax.nn.gelu(jnp.einsum('bgnld,lde->bgne', blocks + pos, w1))
    return jnp.einsum('bgne,ef->bgnf', h, w2)


def cmp_to_slc_overlap(n_cmp, n_slc):
    start = np.arange(n_cmp)[:, None] * NSA_CMP_STRIDE
    end = start + NSA_CMP_LEN
    s0 = np.arange(n_slc)[None, :] * NSA_SLC_LEN
    s1 = s0 + NSA_SLC_LEN
    ov = np.clip(np.minimum(end, s1) - np.maximum(start, s0), 0, None) / NSA_CMP_LEN
    return jnp.asarray(ov, dtype=jnp.float32)


def nsa_mixer(q, kv, gate, cmp_pos, cmp_w1, cmp_w2):
    B, T, _ = q.shape
    G, HPG, DH = NSA_KV_HEADS, NSA_HPG, NSA_DH
    q = q.reshape(B, T, G, HPG, DH).transpose(0, 2, 3, 1, 4)
    kv = kv.reshape(B, T, 3, 2, G, DH).transpose(2, 3, 0, 4, 1, 5)
    g = jax.nn.sigmoid(gate).reshape(B, T, G, HPG, 3).transpose(0, 2, 3, 1, 4)

    k_cmp = nsa_compress(kv[0, 0], cmp_pos[0], cmp_w1[0], cmp_w2[0])
    v_cmp = nsa_compress(kv[0, 1], cmp_pos[1], cmp_w1[1], cmp_w2[1])
    n_cmp = k_cmp.shape[2]
    n_slc = T // NSA_SLC_LEN
    n_sel = min(NSA_TOPN, n_slc)
    overlap = cmp_to_slc_overlap(n_cmp, n_slc)
    k_blk = kv[1, 0].reshape(B, G, n_slc, NSA_SLC_LEN, DH)
    v_blk = kv[1, 1].reshape(B, G, n_slc, NSA_SLC_LEN, DH)
    pad = ((0, 0), (0, 0), (NSA_WINDOW, 0), (0, 0))
    k_win = jnp.pad(kv[2, 0], pad)
    v_win = jnp.pad(kv[2, 1], pad)

    cmp_end = jnp.arange(n_cmp) * NSA_CMP_STRIDE + NSA_CMP_LEN - 1
    blk_ids = jnp.arange(n_slc)
    scale = DH ** -0.5
    gather = jax.vmap(jax.vmap(lambda blocks, ix: blocks[ix]))

    def block_fn(c):
        q0 = c * NSA_Q_BLOCK
        qc = lax.dynamic_slice_in_dim(q, q0, NSA_Q_BLOCK, axis=3)
        gc = lax.dynamic_slice_in_dim(g, q0, NSA_Q_BLOCK, axis=3)
        qpos = q0 + jnp.arange(NSA_Q_BLOCK)
        s = jnp.einsum('bghqd,bgnd->bghqn', qc, k_cmp) * scale
        p_cmp = masked_softmax(s, cmp_end[None, :] <= qpos[:, None])
        o_cmp = jnp.einsum('bghqn,bgnd->bghqd', p_cmp.astype(v_cmp.dtype), v_cmp)
        imp = jnp.einsum('bghqn,ns->bgqs', p_cmp, overlap)
        cur = (qpos // NSA_SLC_LEN)[:, None]
        forced = (blk_ids[None, :] == 0) | (blk_ids[None, :] == cur) | (blk_ids[None, :] == cur - 1)
        valid = blk_ids[None, :] * NSA_SLC_LEN <= qpos[:, None]
        score = jnp.where(forced, NSA_FORCE, jnp.where(valid, imp, -1.0))
        _, idx = lax.top_k(score, n_sel)
        ks = gather(k_blk, idx).reshape(B, G, NSA_Q_BLOCK, n_sel * NSA_SLC_LEN, DH)
        vs = gather(v_blk, idx).reshape(B, G, NSA_Q_BLOCK, n_sel * NSA_SLC_LEN, DH)
        kpos = (idx[..., None] * NSA_SLC_LEN + jnp.arange(NSA_SLC_LEN)).reshape(B, G, NSA_Q_BLOCK, n_sel * NSA_SLC_LEN)
        s = jnp.einsum('bghqd,bgqkd->bghqk', qc, ks) * scale
        p = masked_softmax(s, (kpos <= qpos[:, None])[:, :, None])
        o_slc = jnp.einsum('bghqk,bgqkd->bghqd', p.astype(vs.dtype), vs)
        kw = lax.dynamic_slice_in_dim(k_win, q0, NSA_Q_BLOCK + NSA_WINDOW, axis=2)
        vw = lax.dynamic_slice_in_dim(v_win, q0, NSA_Q_BLOCK + NSA_WINDOW, axis=2)
        wpos = q0 - NSA_WINDOW + jnp.arange(NSA_Q_BLOCK + NSA_WINDOW)
        dist = qpos[:, None] - wpos[None, :]
        mask_w = (dist >= 0) & (dist < NSA_WINDOW) & (wpos[None, :] >= 0)
        s = jnp.einsum('bghqd,bgkd->bghqk', qc, kw) * scale
        p = masked_softmax(s, mask_w)
        o_win = jnp.einsum('bghqk,bgkd->bghqd', p.astype(vw.dtype), vw)
        return gc[..., 0:1] * o_cmp + gc[..., 1:2] * o_slc + gc[..., 2:3] * o_win

    o = lax.map(block_fn, jnp.arange(T // NSA_Q_BLOCK))
    return o.transpose(1, 0, 4, 2, 3, 5).reshape(B, T, NSA_HEADS * DH)


def mla_mixer(cq, ckv, k_rope, positions, q_norm_g, w_qup, kv_norm_g, w_kvup):
    B, T, _ = cq.shape
    q = (rmsnorm(cq, q_norm_g) @ w_qup).reshape(B, T, MLA_HEADS, MLA_NOPE + MLA_ROPE)
    kv = (rmsnorm(ckv, kv_norm_g) @ w_kvup).reshape(B, T, MLA_HEADS, MLA_NOPE + MLA_VDIM)
    cos, sin = rope_cos_sin(positions, MLA_ROPE)
    q_rope = apply_rope(q[..., MLA_NOPE:], cos[:, :, None], sin[:, :, None])
    k_rope = apply_rope(k_rope, cos, sin)
    q = jnp.concatenate([q[..., :MLA_NOPE], q_rope], axis=-1).transpose(0, 2, 1, 3)
    k = jnp.concatenate([kv[..., :MLA_NOPE],
                         jnp.broadcast_to(k_rope[:, :, None, :], (B, T, MLA_HEADS, MLA_ROPE))],
                        axis=-1).transpose(0, 2, 1, 3)
    v = kv[..., MLA_NOPE:].transpose(0, 2, 1, 3)
    scale = (MLA_NOPE + MLA_ROPE) ** -0.5
    kpos = jnp.arange(T)

    def block_fn(c):
        q0 = c * MLA_Q_BLOCK
        qc = lax.dynamic_slice_in_dim(q, q0, MLA_Q_BLOCK, axis=2)
        qpos = q0 + jnp.arange(MLA_Q_BLOCK)
        s = jnp.einsum('bhqd,bhkd->bhqk', qc, k).astype(jnp.float32) * scale
        s = jnp.where(kpos[None, :] <= qpos[:, None], s, -jnp.inf)
        p = jax.nn.softmax(s, axis=-1)
        return jnp.einsum('bhqk,bhkd->bhqd', p.astype(v.dtype), v)

    o = lax.map(block_fn, jnp.arange(T // MLA_Q_BLOCK))
    return o.transpose(1, 0, 3, 2, 4).reshape(B, T, MLA_HEADS * MLA_VDIM)


def pool_mixer(u, w_pool, scale):
    B, T, _ = u.shape
    u32 = u.astype(jnp.float32)
    csum = jnp.pad(jnp.cumsum(u32, axis=1), ((0, 0), (1, 0), (0, 0)))
    t_idx = jnp.arange(T)
    means = []
    for gi, w in enumerate(POOL_WINDOWS):
        cg = csum[..., gi * POOL_GROUP:(gi + 1) * POOL_GROUP]
        upper = cg[:, 1:T + 1]
        lower = jnp.pad(cg, ((0, 0), (w, 0), (0, 0)))[:, 1:T + 1]
        cnt = jnp.minimum(t_idx + 1, w).astype(jnp.float32)[None, :, None]
        means.append((upper - lower) / cnt)
    pooled = (jnp.concatenate(means, axis=-1) - u32).astype(u.dtype)
    pooled = pooled.reshape(B, T, len(POOL_WINDOWS), POOL_GROUP)
    y = jnp.einsum('btgc,gcd->btgd', pooled, w_pool).reshape(B, T, POOL_WIDTH)
    return y * scale


def setup_inputs(seed: int = 0) -> dict:
    key = jax.random.key(seed)
    ks = jax.random.split(key, 20)
    f32 = jnp.float32

    def nrm(k, shape, s):
        return jax.random.normal(k, shape, f32) * s

    x = jax.random.normal(ks[0], (BATCH, SEQ, D_MODEL), f32)
    positions = (jnp.arange(SEQ, dtype=jnp.int32)[None, :]
                 + jax.random.randint(ks[1], (BATCH, 1), 0, 1024, dtype=jnp.int32))
    return {
        'x': x,
        'positions': positions,
        'ln1_g': 1.0 + nrm(ks[2], (DEPTH, D_MODEL), 0.05),
        'w_in': nrm(ks[3], (DEPTH, D_MODEL, P_IN), D_MODEL ** -0.5),
        'nsa_cmp_pos': nrm(ks[4], (DEPTH, 2, NSA_CMP_LEN, NSA_DH), 0.1),
        'nsa_cmp_w1': nrm(ks[5], (DEPTH, 2, NSA_CMP_LEN, NSA_DH, NSA_DH), (NSA_CMP_LEN * NSA_DH) ** -0.5),
        'nsa_cmp_w2': nrm(ks[6], (DEPTH, 2, NSA_DH, NSA_DH), NSA_DH ** -0.5),
        'mla_q_norm': 1.0 + nrm(ks[7], (DEPTH, MLA_Q_LORA), 0.05),
        'mla_w_qup': nrm(ks[8], (DEPTH, MLA_Q_LORA, MLA_HEADS * (MLA_NOPE + MLA_ROPE)), MLA_Q_LORA ** -0.5),
        'mla_kv_norm': 1.0 + nrm(ks[9], (DEPTH, MLA_KV_LORA), 0.05),
        'mla_w_kvup': nrm(ks[10], (DEPTH, MLA_KV_LORA, MLA_HEADS * (MLA_NOPE + MLA_VDIM)), MLA_KV_LORA ** -0.5),
        'pool_w': nrm(ks[11], (DEPTH, len(POOL_WINDOWS), POOL_GROUP, POOL_GROUP), POOL_GROUP ** -0.5),
        'pool_scale': 1.0 + nrm(ks[12], (DEPTH, POOL_WIDTH), 0.1),
        'w_out': nrm(ks[13], (DEPTH, D_MIX, D_MODEL), D_MIX ** -0.5),
        'ln2_g': 1.0 + nrm(ks[14], (DEPTH, D_MODEL), 0.05),
        'w_ff1': nrm(ks[15], (DEPTH, D_MODEL, D_FF), D_MODEL ** -0.5),
        'w_ff2': nrm(ks[16], (DEPTH, D_FF, D_MODEL), D_FF ** -0.5),
        'final_g': 1.0 + nrm(ks[17], (D_MODEL,), 0.05),
    }


def reference(x, positions, ln1_g, w_in, nsa_cmp_pos, nsa_cmp_w1, nsa_cmp_w2, mla_q_norm, mla_w_qup,
              mla_kv_norm, mla_w_kvup, pool_w, pool_scale, w_out, ln2_g, w_ff1, w_ff2, final_g):
    offsets = np.cumsum(IN_SPLITS)[:-1].tolist()
    for l in range(DEPTH):
        h = rmsnorm(x, ln1_g[l])
        z = h @ w_in[l]
        nq, nkv, ngate, cq, ckv, kr, pu = jnp.split(z, offsets, axis=-1)
        o_nsa = nsa_mixer(nq, nkv, ngate, nsa_cmp_pos[l], nsa_cmp_w1[l], nsa_cmp_w2[l])
        o_mla = mla_mixer(cq, ckv, kr, positions, mla_q_norm[l], mla_w_qup[l], mla_kv_norm[l], mla_w_kvup[l])
        o_pool = pool_mixer(pu, pool_w[l], pool_scale[l])
        mix = jnp.concatenate([o_nsa, o_mla, o_pool], axis=-1)
        x = x + mix @ w_out[l]
        h = rmsnorm(x, ln2_g[l])
        x = x + jnp.square(jax.nn.relu(h @ w_ff1[l])) @ w_ff2[l]
    return rmsnorm(x, final_g)
```

```cpp
#include <hip/hip_runtime.h>
#include <hip/hip_cooperative_groups.h>
#include <cstdio>
#include <cstdint>
namespace cg = cooperative_groups;

namespace pg8 {
#define PG8_LAS __attribute__((address_space(3)))
typedef unsigned short bf16_t;
typedef short bf16x8 __attribute__((ext_vector_type(8)));
typedef float f32x4 __attribute__((ext_vector_type(4)));
typedef unsigned u32x4 __attribute__((ext_vector_type(4)));
constexpr int BM = 256, BK = 64, HALF = 128, HTB = HALF * BK * 2  , STAGE_BYTES = 8 * HTB, NXCD = 8, WGM = 8;

__host__ __device__ __forceinline__ int lds_byte(int r, int c) { const int st = (r >> 4) * 2 + (c >> 5), rr = r & 15, cc = c & 31, ob = rr * 64 + cc * 2; return st * 1024 + (ob ^ (((ob >> 9) & 1) << 5)); }
__host__ __device__ __forceinline__ void stage_rc(int b, int& R, int& C) { const int st = b / 1024, sb = b % 1024, swz = sb ^ (((sb >> 9) & 1) << 5); R = (st >> 1) * 16 + swz / 64; C = (st & 1) * 32 + (swz % 64) / 2; }
__host__ __device__ __forceinline__ int perm32(int rho) { const int n = rho >> 4, i = rho & 15; return 8 * (i >> 2) + 4 * n + (i & 3); }

struct Unit { int pm, pn; };
struct Gemm { const bf16_t* A; const bf16_t* Bt; int M, N, K, lda; };
struct StaticOrder {
    int nM, nN, nwg, G, c;
    __host__ __device__ void init(int M, int N, int G_, int c_) { nM = M / BM; nN = N / BM; nwg = nM * nN; G = G_; c = c_; }
    __host__ __device__ bool next(int i, Unit& u) const {
        const long L = (long)i * G + c; if (L >= nwg) return false;
        int wgid = (int)L; { const int q = nwg / NXCD, r = nwg % NXCD, xcd = wgid % NXCD, off = wgid / NXCD; wgid = (xcd < r ? xcd * (q + 1) : r * (q + 1) + (xcd - r) * q) + off; }
        const int nig = WGM * nN, gid = wgid / nig, fm = gid * WGM, gsz = (nM - fm) < WGM ? (nM - fm) : WGM;
        u.pm = fm + ((wgid % nig) % gsz); u.pn = (wgid % nig) / gsz; return true;
    }
    __device__ __forceinline__ void a_ready(const Unit&) const {}
    __device__ __forceinline__ void done(const Unit&) const {}
};
__device__ __forceinline__ unsigned cvt_pk_bf16(float lo, float hi) { unsigned r; asm volatile("v_cvt_pk_bf16_f32 %0, %1, %2" : "=v"(r) : "v"(lo), "v"(hi)); return r; }
template <class Epi, class Sched, bool ALIGN_EPI = false, bool SP2 = false>
__device__ __forceinline__ void gemm_phase(PG8_LAS unsigned char* lds, const Gemm g, const Sched& S, const Epi& E) {
    int tid = threadIdx.x; asm volatile("" : "+v"(tid)); const int wid = __builtin_amdgcn_readfirstlane(tid >> 6), lane = tid & 63, wr = wid >> 2, wc = wid & 3, fr = lane & 15, fq = lane >> 4;
    const int K = g.K, nt = K / BK;
    unsigned voffA[2], voffB[2];
#pragma unroll
    for (int i = 0; i < 2; ++i) { int R, C; stage_rc(tid * 16 + i * 8192, R, C); const int Rb = Epi::PERM ? ((R & ~31) + perm32(R & 31)) : R;
        voffA[i] = (unsigned)(R * g.lda + C) * 2u; voffB[i] = (unsigned)(Rb * K + C) * 2u; }
    const size_t kstep = (size_t)(BK * 2);
    const size_t hstepB = (size_t)HALF * K * 2, hstepA = (size_t)HALF * g.lda * 2;
    const size_t tstepB = 2 * hstepB, tstepA = 2 * hstepA;
    const unsigned ldsw = (unsigned)wid * 1024u;
    const int aoff = lds_byte(wr * 64 + fr, fq * 8), boff = lds_byte(wc * 32 + fr, fq * 8);
#define PG8_SA(b, h) (((b) * 2 + (h)) * HTB)
#define PG8_SB(b, h) ((4 + (b) * 2 + (h)) * HTB)
#define PG8_STAGE(bufoff, gbase, voff) do { _Pragma("unroll") for (int _i = 0; _i < 2; ++_i) \
        __builtin_amdgcn_global_load_lds((const unsigned*)((const char*)(gbase) + (voff)[_i]), (PG8_LAS unsigned*)(lds + (bufoff) + ldsw + _i * 8192), 16, 0, 0); } while (0)
#define PG8_LDA(dst, b, h) do { _Pragma("unroll") for (int m = 0; m < 4; ++m) _Pragma("unroll") for (int k = 0; k < 2; ++k) dst[m][k] = *(const PG8_LAS bf16x8*)(lds + PG8_SA(b, h) + aoff + m * 2048 + k * 1024); } while (0)
#define PG8_LDB(dst, b, h) do { _Pragma("unroll") for (int n = 0; n < 2; ++n) _Pragma("unroll") for (int k = 0; k < 2; ++k) dst[n][k] = *(const PG8_LAS bf16x8*)(lds + PG8_SB(b, h) + boff + n * 2048 + k * 1024); } while (0)
#define PG8_MMA(ai, bj, At, Bt) do { __builtin_amdgcn_s_setprio(1); _Pragma("unroll") for (int m = 0; m < 4; ++m) _Pragma("unroll") for (int n = 0; n < 2; ++n) _Pragma("unroll") for (int k = 0; k < 2; ++k) \
        acc[ai][bj][m][n] = __builtin_amdgcn_mfma_f32_16x16x32_bf16(Bt[n][k], At[m][k], acc[ai][bj][m][n], 0, 0, 0); __builtin_amdgcn_s_setprio(0); } while (0)
#define PG8_WAIT_V(n) asm volatile("s_waitcnt vmcnt(" #n ")" ::: "memory")
#define PG8_WAIT_L(n) asm volatile("s_waitcnt lgkmcnt(" #n ")" ::: "memory")
#define PG8_BAR __builtin_amdgcn_s_barrier()
#define PG8_SCHED __builtin_amdgcn_sched_barrier(0)
    Unit cur, nxt; int ui = 0;
    if (!S.next(0, cur)) return;
    f32x4 acc[2][2][4][2];
#pragma unroll
    for (int a = 0; a < 2; ++a)
#pragma unroll
        for (int b = 0; b < 2; ++b)
#pragma unroll
            for (int m = 0; m < 4; ++m)
#pragma unroll
                for (int n = 0; n < 2; ++n) acc[a][b][m][n] = (f32x4){0.f, 0.f, 0.f, 0.f};
    bf16x8 At[4][2], B0[2][2], B1[2][2];
    const char* cA = (const char*)g.A + (size_t)cur.pm * tstepA; const char* cB = (const char*)g.Bt + (size_t)cur.pn * tstepB;
    S.a_ready(cur);
    if constexpr (SP2) {
        PG8_STAGE(PG8_SB(0, 0), cB, voffB); PG8_STAGE(PG8_SB(0, 1), cB + hstepB, voffB); PG8_STAGE(PG8_SA(0, 0), cA, voffA); PG8_STAGE(PG8_SA(0, 1), cA + hstepA, voffA);
        if (wr == 1) PG8_BAR;
        PG8_WAIT_V(2); PG8_BAR;
        PG8_STAGE(PG8_SB(1, 0), cB + kstep, voffB); PG8_STAGE(PG8_SA(1, 0), cA + kstep, voffA); PG8_STAGE(PG8_SB(1, 1), cB + hstepB + kstep, voffB);
        PG8_WAIT_V(6); PG8_BAR;
    } else {
        PG8_STAGE(PG8_SB(0, 0), cB, voffB); PG8_STAGE(PG8_SA(0, 0), cA, voffA); PG8_STAGE(PG8_SB(0, 1), cB + hstepB, voffB); PG8_STAGE(PG8_SA(0, 1), cA + hstepA, voffA);
        if (wr == 1) PG8_BAR;
        PG8_WAIT_V(4); PG8_BAR;
        PG8_STAGE(PG8_SB(1, 0), cB + kstep, voffB); PG8_STAGE(PG8_SA(1, 0), cA + kstep, voffA); PG8_STAGE(PG8_SB(1, 1), cB + hstepB + kstep, voffB);
        PG8_WAIT_V(6); PG8_BAR;
    }
    for (;;) {
        const bool has_next = S.next(ui + 1, nxt);
        const char* nA = has_next ? (const char*)g.A + (size_t)nxt.pm * tstepA : cA; const char* nB = has_next ? (const char*)g.Bt + (size_t)nxt.pn * tstepB : cB;
        for (int t = 0; t < nt; t += 2) {
            const bool last = (t == nt - 2);
            const char* a1 = cA + (size_t)(t + 1) * kstep;
            const char* a2 = last ? nA : cA + (size_t)(t + 2) * kstep; const char* b2 = last ? nB : cB + (size_t)(t + 2) * kstep;
            const char* a3 = a2 + kstep; const char* b3 = b2 + kstep;
            if (last && has_next) S.a_ready(nxt);
            if constexpr (SP2) {
            PG8_LDB(B0, 0, 0); PG8_LDB(B1, 0, 1); PG8_SCHED; PG8_LDA(At, 0, 0); PG8_STAGE(PG8_SA(1, 1), a1 + hstepA, voffA);
            PG8_WAIT_V(8); PG8_WAIT_L(0); PG8_BAR; PG8_MMA(0, 0, At, B0); PG8_MMA(0, 1, At, B1); PG8_BAR; PG8_SCHED;
            PG8_LDA(At, 0, 1); PG8_STAGE(PG8_SB(0, 0), b2, voffB); PG8_STAGE(PG8_SB(0, 1), b2 + hstepB, voffB); PG8_STAGE(PG8_SA(0, 0), a2, voffA);
            PG8_WAIT_V(8); PG8_WAIT_L(0); PG8_BAR; PG8_MMA(1, 0, At, B0); PG8_MMA(1, 1, At, B1); PG8_BAR; PG8_SCHED;
            PG8_LDB(B0, 1, 0); PG8_LDB(B1, 1, 1); PG8_SCHED; PG8_LDA(At, 1, 0); PG8_STAGE(PG8_SA(0, 1), a2 + hstepA, voffA);
            PG8_WAIT_V(8); PG8_WAIT_L(0); PG8_BAR; PG8_MMA(0, 0, At, B0); PG8_MMA(0, 1, At, B1); PG8_BAR; PG8_SCHED;
            PG8_LDA(At, 1, 1); PG8_STAGE(PG8_SB(1, 0), b3, voffB); PG8_STAGE(PG8_SB(1, 1), b3 + hstepB, voffB); PG8_STAGE(PG8_SA(1, 0), a3, voffA);
            PG8_WAIT_V(8); PG8_WAIT_L(0); PG8_BAR; PG8_MMA(1, 0, At, B0); PG8_MMA(1, 1, At, B1); PG8_BAR; PG8_SCHED;
            } else {
            PG8_LDB(B0, 0, 0); PG8_SCHED; PG8_LDA(At, 0, 0); PG8_STAGE(PG8_SA(1, 1), a1 + hstepA, voffA);
            PG8_WAIT_L(8); PG8_BAR; PG8_WAIT_L(0); PG8_MMA(0, 0, At, B0); PG8_BAR; PG8_SCHED;
            PG8_LDB(B1, 0, 1); PG8_STAGE(PG8_SB(0, 0), b2, voffB);
            PG8_BAR; PG8_WAIT_L(0); PG8_MMA(0, 1, At, B1); PG8_BAR;
            PG8_LDA(At, 0, 1); PG8_STAGE(PG8_SA(0, 0), a2, voffA);
            PG8_BAR; PG8_WAIT_L(0); PG8_MMA(1, 0, At, B0); PG8_BAR; PG8_SCHED;
            PG8_STAGE(PG8_SB(0, 1), b2 + hstepB, voffB);
            PG8_WAIT_V(6); PG8_BAR; PG8_MMA(1, 1, At, B1); PG8_BAR;
            PG8_LDB(B0, 1, 0); PG8_SCHED; PG8_LDA(At, 1, 0); PG8_STAGE(PG8_SA(0, 1), a2 + hstepA, voffA);
            PG8_WAIT_L(8); PG8_BAR; PG8_WAIT_L(0); PG8_MMA(0, 0, At, B0); PG8_BAR; PG8_SCHED;
            PG8_LDB(B1, 1, 1); PG8_STAGE(PG8_SB(1, 0), b3, voffB);
            PG8_BAR; PG8_WAIT_L(0); PG8_MMA(0, 1, At, B1); PG8_BAR;
            PG8_LDA(At, 1, 1); PG8_STAGE(PG8_SA(1, 0), a3, voffA);
            PG8_BAR; PG8_WAIT_L(0); PG8_MMA(1, 0, At, B0); PG8_BAR; PG8_SCHED;
            PG8_STAGE(PG8_SB(1, 1), b3 + hstepB, voffB);
            PG8_WAIT_V(6); PG8_BAR; PG8_MMA(1, 1, At, B1); PG8_BAR;
            }
        }
        if constexpr (ALIGN_EPI) { if (wr == 0) PG8_BAR; }
        if constexpr (!Epi::AFTER_DRAIN) { E(acc, cur, wr, wc, fr, fq); S.done(cur); }
        if (!has_next) break;
#pragma unroll
        for (int a = 0; a < 2; ++a)
#pragma unroll
            for (int b = 0; b < 2; ++b)
#pragma unroll
                for (int m = 0; m < 4; ++m)
#pragma unroll
                    for (int n = 0; n < 2; ++n) acc[a][b][m][n] = (f32x4){0.f, 0.f, 0.f, 0.f};
        cur = nxt; cA = nA; cB = nB; ++ui;
        if constexpr (ALIGN_EPI) { if (wr == 1) PG8_BAR; }
    }
    PG8_WAIT_V(0);
    if constexpr (!ALIGN_EPI) { if (wr == 0) PG8_BAR; }
    PG8_BAR;
    if constexpr (Epi::AFTER_DRAIN) { E.fused(acc, cur, wr, wc, fr, fq, lds, wid, lane); S.done(cur); }
#undef PG8_SA
#undef PG8_SB
#undef PG8_STAGE
#undef PG8_LDA
#undef PG8_LDB
#undef PG8_MMA
#undef PG8_WAIT_V
#undef PG8_WAIT_L
#undef PG8_BAR
#undef PG8_SCHED
}
}


#define LAS __attribute__((address_space(3)))
typedef unsigned short bf16_t;
typedef short bf16x8 __attribute__((ext_vector_type(8)));
typedef short s16x4 __attribute__((ext_vector_type(4)));
typedef float f32x4 __attribute__((ext_vector_type(4)));
typedef float f32x16 __attribute__((ext_vector_type(16)));
typedef unsigned u32x4 __attribute__((ext_vector_type(4)));
typedef unsigned u32x2 __attribute__((ext_vector_type(2)));
typedef float f32x2_t __attribute__((ext_vector_type(2)));
typedef __bf16 bf16x2_t __attribute__((ext_vector_type(2)));
typedef short v4i16_t __attribute__((ext_vector_type(4)));

constexpr int NB = 8, T = 4096, M = NB * T, D = 1024, FF = 4096, DEPTH = 2;
constexpr int P_IN = 1842, ZP = 2048;
constexpr int Z_CQ = 0, Z_CKV = 256, Z_KR = 384, Z_GATE = 416, Z_NQ = 512, Z_NKV = 896, Z_PU = 1664;
constexpr int QMP = 768, KVP = 768;
constexpr float EPS = 1e-6f;
constexpr float LOG2E = 1.4426950408889634f;
constexpr float NSA_QS = 0.125f * LOG2E;
constexpr float MLA_QS = 0.10206207261596575f * LOG2E;

constexpr size_t MiB = 1u << 20;
constexpr size_t WS_CTL = 0;
constexpr size_t WS_SS = 1 * MiB;
constexpr size_t WS_ROPE = 3 * MiB;
constexpr size_t WS_BIASP = 7 * MiB;
constexpr size_t WS_KCMP = 7 * MiB + 512 * 1024;
constexpr size_t WS_WIN = 10 * MiB, WS_WOUT = 18 * MiB, WS_WFF1 = 22 * MiB, WS_WFF2 = 38 * MiB, WS_WQUP = 54 * MiB, WS_WKVUP = 55 * MiB;
constexpr size_t WS_W1T = 56 * MiB, WS_W2T = 57 * MiB, WS_WPT = 57 * MiB + 512 * 1024;
constexpr size_t WS_XB = 64 * MiB, WS_MIX = 128 * MiB, WS_H = 192 * MiB, WS_Z = 192 * MiB, WS_QM = 320 * MiB, WS_KVM = 368 * MiB, WS_END = 448 * MiB;

constexpr int LDS_BYTES = 131072 + 2048;

struct Params { const float* in[18]; float* out; unsigned char* ws; };

__device__ __forceinline__ unsigned f2bf(float f) { unsigned u = __builtin_bit_cast(unsigned, f); return (u + 0x7fffu + ((u >> 16) & 1u)) >> 16; }
__device__ __forceinline__ unsigned pk2(float lo, float hi) { f32x2_t v = {lo, hi}; bf16x2_t b = __builtin_convertvector(v, bf16x2_t); return __builtin_bit_cast(unsigned, b); }
__device__ __forceinline__ float bf2f(unsigned short b) { return __builtin_bit_cast(float, (unsigned)b << 16); }
__device__ __forceinline__ float wave_sum(float v) {
#pragma unroll
    for (int o = 1; o < 64; o <<= 1) v += __shfl_xor(v, o);
    return v;
}
__device__ __forceinline__ int crow(int r, int h) { return (r & 3) + 8 * (r >> 2) + 4 * h; }
__device__ __forceinline__ void atomic_addf(float* p, float v) { __hip_atomic_fetch_add(p, v, __ATOMIC_RELAXED, __HIP_MEMORY_SCOPE_AGENT); }
__device__ __forceinline__ float fast_exp2(float x) { return __builtin_amdgcn_exp2f(x); }

__device__ __forceinline__ int tid_() { int t = threadIdx.x; asm volatile("" : "+v"(t)); return t; }
__device__ __forceinline__ int bid_() { int t = blockIdx.x; asm volatile("" : "+s"(t)); return t; }
__device__ __forceinline__ int gdim_() { int t = gridDim.x; asm volatile("" : "+s"(t)); return t; }
#define EPI_LOOP_ROWS  _Pragma("unroll") for (int ai = 0; ai < 2; ++ai) _Pragma("unroll") for (int m = 0; m < 4; ++m) if (epi_fence())
__device__ __forceinline__ bool epi_fence() { asm volatile("" ::: "memory"); return true; }
__device__ __forceinline__ void st_bf4(bf16_t* p, f32x4 v) { u32x2 w; w.x = pk2(v[0], v[1]); w.y = pk2(v[2], v[3]); *(u32x2*)p = w; }
__device__ __forceinline__ float dot4(f32x4 v) { return (v[0] * v[0] + v[1] * v[1]) + (v[2] * v[2] + v[3] * v[3]); }

struct EpiInProj {
    static constexpr bool PERM = false, AFTER_DRAIN = false;
    bf16_t* z; const float* ss_x; float* ss_cq; float* ss_ckv; const float* ropec; const float* ropes;
    __device__ __forceinline__ void operator()(const f32x4 (&acc)[2][2][4][2], const pg8::Unit& u, int wr, int wc, int fr, int fq) const {
        const int pn = u.pn;
        EPI_LOOP_ROWS {
            const int row = u.pm * 256 + ai * 128 + wr * 64 + m * 16 + fr;
            const float rs = rsqrtf(ss_x[row] * (1.0f / 1024.0f) + EPS);
            float sq = 0.f;
#pragma unroll
            for (int bj = 0; bj < 2; ++bj) {
                f32x4 v0 = acc[ai][bj][m][0] * rs, v1 = acc[ai][bj][m][1] * rs;
                const int cb = pn * 256 + bj * 128 + wc * 32;
                if (pn == 0 || (pn == 1 && bj == 0)) sq += dot4(v0) + dot4(v1);
                if (pn == 1 && bj == 1 && wc == 0) {
                    const f32x4 c = *(const f32x4*)(ropec + (size_t)row * 16 + 4 * fq), s = *(const f32x4*)(ropes + (size_t)row * 16 + 4 * fq);
                    const f32x4 a = v0 * c - v1 * s, b = v1 * c + v0 * s; v0 = a; v1 = b;
                }
                if (cb >= Z_NQ && cb < Z_NKV) { v0 = v0 * NSA_QS; v1 = v1 * NSA_QS; }
                bf16_t* p = z + (size_t)row * ZP + cb + 4 * fq;
                st_bf4(p, v0); st_bf4(p + 16, v1);
            }
            if (pn <= 1) {
                sq += __shfl_xor(sq, 16); sq += __shfl_xor(sq, 32);
                if (fq == 0) atomic_addf((pn == 0 ? ss_cq : ss_ckv) + row, sq);
            }
        }
    }
};

struct EpiQup {
    static constexpr bool PERM = false, AFTER_DRAIN = false;
    bf16_t* qm; const float* ss_cq; const float* ropec; const float* ropes;
    __device__ __forceinline__ void operator()(const f32x4 (&acc)[2][2][4][2], const pg8::Unit& u, int wr, int wc, int fr, int fq) const {
        EPI_LOOP_ROWS {
            const int row = u.pm * 256 + ai * 128 + wr * 64 + m * 16 + fr;
            const float rs = rsqrtf(ss_cq[row] * (1.0f / 256.0f) + EPS) * MLA_QS;
#pragma unroll
            for (int bj = 0; bj < 2; ++bj) {
                f32x4 v0 = acc[ai][bj][m][0] * rs, v1 = acc[ai][bj][m][1] * rs;
                const int gi = u.pn * 8 + bj * 4 + wc;
                if (gi % 3 == 2) {
                    const f32x4 c = *(const f32x4*)(ropec + (size_t)row * 16 + 4 * fq), s = *(const f32x4*)(ropes + (size_t)row * 16 + 4 * fq);
                    const f32x4 a = v0 * c - v1 * s, b = v1 * c + v0 * s; v0 = a; v1 = b;
                }
                bf16_t* p = qm + (size_t)row * QMP + gi * 32 + 4 * fq;
                st_bf4(p, v0); st_bf4(p + 16, v1);
            }
        }
    }
};

struct EpiKVup {
    static constexpr bool PERM = false, AFTER_DRAIN = false;
    bf16_t* kvm; const float* ss_ckv;
    __device__ __forceinline__ void operator()(const f32x4 (&acc)[2][2][4][2], const pg8::Unit& u, int wr, int wc, int fr, int fq) const {
        EPI_LOOP_ROWS {
            const int row = u.pm * 256 + ai * 128 + wr * 64 + m * 16 + fr;
            const float rs = rsqrtf(ss_ckv[row] * (1.0f / 128.0f) + EPS);
#pragma unroll
            for (int bj = 0; bj < 2; ++bj) {
                const f32x4 v0 = acc[ai][bj][m][0] * rs, v1 = acc[ai][bj][m][1] * rs;
                bf16_t* p = kvm + (size_t)row * KVP + u.pn * 256 + bj * 128 + wc * 32 + 4 * fq;
                st_bf4(p, v0); st_bf4(p + 16, v1);
            }
        }
    }
};

struct EpiResid {
    static constexpr bool PERM = false, AFTER_DRAIN = false;
    const float* xold; float* xout; bf16_t* xb; float* ss;
    __device__ __forceinline__ void operator()(const f32x4 (&acc)[2][2][4][2], const pg8::Unit& u, int wr, int wc, int fr, int fq) const {
        EPI_LOOP_ROWS {
            const int row = u.pm * 256 + ai * 128 + wr * 64 + m * 16 + fr;
            float sq = 0.f;
#pragma unroll
            for (int bj = 0; bj < 2; ++bj) {
                const size_t off = (size_t)row * D + u.pn * 256 + bj * 128 + wc * 32 + 4 * fq;
                const f32x4 v0 = *(const f32x4*)(xold + off) + acc[ai][bj][m][0], v1 = *(const f32x4*)(xold + off + 16) + acc[ai][bj][m][1];
                *(f32x4*)(xout + off) = v0; *(f32x4*)(xout + off + 16) = v1;
                st_bf4(xb + off, v0); st_bf4(xb + off + 16, v1);
                sq += dot4(v0) + dot4(v1);
            }
            sq += __shfl_xor(sq, 16); sq += __shfl_xor(sq, 32);
            if (fq == 0) atomic_addf(ss + row, sq);
        }
    }
};

struct EpiFF1 {
    static constexpr bool PERM = false, AFTER_DRAIN = false;
    bf16_t* h; const float* ss;
    __device__ __forceinline__ void operator()(const f32x4 (&acc)[2][2][4][2], const pg8::Unit& u, int wr, int wc, int fr, int fq) const {
        EPI_LOOP_ROWS {
            const int row = u.pm * 256 + ai * 128 + wr * 64 + m * 16 + fr;
            const float rs = rsqrtf(ss[row] * (1.0f / 1024.0f) + EPS);
#pragma unroll
            for (int bj = 0; bj < 2; ++bj) {
                f32x4 v0 = acc[ai][bj][m][0] * rs, v1 = acc[ai][bj][m][1] * rs;
#pragma unroll
                for (int j = 0; j < 4; ++j) { const float a = fmaxf(v0[j], 0.f), b = fmaxf(v1[j], 0.f); v0[j] = a * a; v1[j] = b * b; }
                bf16_t* p = h + (size_t)row * FF + u.pn * 256 + bj * 128 + wc * 32 + 4 * fq;
                st_bf4(p, v0); st_bf4(p + 16, v1);
            }
        }
    }
};

template <class Epi>
__device__ __forceinline__ void run_gemm(LAS unsigned char* lds, const bf16_t* A, int lda, const bf16_t* Bt, int N, int K, const Epi& E) {
    asm volatile("" : "+s"(N), "+s"(K), "+s"(lda));
    pg8::Gemm g{A, Bt, M, N, K, lda}; pg8::StaticOrder S; S.init(M, N, gdim_(), bid_());
    pg8::gemm_phase<Epi, pg8::StaticOrder, true, true>(lds, g, S, E);
}

__device__ __forceinline__ int colmap(int mode, int n) {
    if (mode == 0) return n;
    if (mode == 1) {
        if (n < 256) return 1170 + n;
        if (n < 384) return 1426 + (n - 256);
        if (n < 416) return 1554 + (n - 384);
        if (n < 434) return 1152 + (n - 416);
        if (n < 512) return -1;
        if (n < 896) return n - 512;
        if (n < 1664) return 384 + (n - 896);
        if (n < 1920) return 1586 + (n - 1664);
        return -1;
    }
    if (mode == 2) {
        if (n < 384) return (n >> 6) * 128 + (n & 63);
        return ((n - 384) >> 6) * 128 + 64 + ((n - 384) & 63);
    }
    return n < 576 ? n : -1;
}
__device__ __forceinline__ void convert_tile(const float* src, int srcPitch, int K, bf16_t* dst, const float* rowscale, int mode, int n0, int k0, LAS float* tile, int tid) {
#pragma unroll
    for (int i = 0; i < 8; ++i) {
        const int kk = (tid >> 6) + 8 * i, nn = tid & 63; const int sc = colmap(mode, n0 + nn);
        float v = 0.f;
        if (sc >= 0) { v = src[(size_t)(k0 + kk) * srcPitch + sc]; if (rowscale) v *= rowscale[k0 + kk]; }
        tile[kk * 65 + nn] = v;
    }
    __syncthreads();
    { const int nn = tid >> 3, kc = (tid & 7) * 8; const LAS float* s = tile + kc * 65 + nn;
      u32x4 o; o.x = pk2(s[0], s[65]); o.y = pk2(s[2 * 65], s[3 * 65]); o.z = pk2(s[4 * 65], s[5 * 65]); o.w = pk2(s[6 * 65], s[7 * 65]);
      *(u32x4*)(dst + (size_t)(n0 + nn) * K + k0 + kc) = o; }
    __syncthreads();
}

__device__ __forceinline__ void prologue(const Params& P, LAS unsigned char* lds) {
    const int tid = tid_(), bid = bid_(), gdim = gdim_(), lane = tid & 63, wave = tid >> 6;
    const int gw = bid * 8 + wave, NGW = gdim * 8;
    unsigned char* ws = P.ws;
    if (bid == 0 && tid < 256) ((unsigned*)(ws + WS_CTL))[tid] = 0u;
    { float* ss = (float*)(ws + WS_SS) + M;
      for (size_t i = (size_t)bid * 512 + tid; i < (size_t)8 * M / 4; i += (size_t)gdim * 512) ((f32x4*)ss)[i] = (f32x4){0.f, 0.f, 0.f, 0.f}; }
    { const float* x = P.in[0]; bf16_t* xb = (bf16_t*)(ws + WS_XB); float* ss0 = (float*)(ws + WS_SS);
      for (int r = gw; r < M; r += NGW) {
          const f32x4* xr = (const f32x4*)(x + (size_t)r * D) + lane; f32x4 v[4]; float s = 0.f;
#pragma unroll
          for (int j = 0; j < 4; ++j) { v[j] = xr[64 * j]; s += dot4(v[j]); }
          s = wave_sum(s); if (lane == 0) ss0[r] = s;
          u32x2* o = (u32x2*)(xb + (size_t)r * D) + lane;
#pragma unroll
          for (int j = 0; j < 4; ++j) { u32x2 w; w.x = pk2(v[j][0], v[j][1]); w.y = pk2(v[j][2], v[j][3]); o[64 * j] = w; }
      } }
    { const int* pos = (const int*)P.in[1]; float* rc = (float*)(ws + WS_ROPE); float* rsn = rc + (size_t)M * 16;
      const float INV[16] = {1.0f, 0.5623413324356079f, 0.3162277638912201f, 0.17782793939113617f, 0.10000000149011612f, 0.05623413249850273f, 0.03162277489900589f, 0.017782794311642647f,
                             0.009999999776482582f, 0.005623413249850273f, 0.003162277629598975f, 0.0017782794311642647f, 0.0010000000474974513f, 0.000562341301701963f, 0.0003162277571391314f, 0.00017782794020604342f};
      for (int i = bid * 512 + tid; i < M * 16; i += gdim * 512) {
          const int r = i >> 4, k = i & 15; float inv = INV[0];
#pragma unroll
          for (int q = 1; q < 16; ++q) inv = (k == q) ? INV[q] : inv;
          const float ang = (float)pos[r] * inv;
          double rev = (double)ang * 0.15915494309189535; rev -= floor(rev);
          const float fr = (float)rev;
          rc[i] = __builtin_amdgcn_cosf(fr); rsn[i] = __builtin_amdgcn_sinf(fr);
      } }
    { float* bp = (float*)(ws + WS_BIASP);
      for (int it = gw; it < DEPTH * 2 * 32; it += NGW) {
          const int lk = it >> 5, ch = it & 31; const float* pp = P.in[4] + (size_t)lk * 2048 + ch * 64; const float* w1 = P.in[5] + (size_t)lk * 2048 * 64 + (size_t)ch * 64 * 64;
          float s = 0.f;
          for (int k = 0; k < 64; ++k) s += pp[k] * w1[k * 64 + lane];
          bp[it * 64 + lane] = s;
      } }
    { LAS float* tile = (LAS float*)lds;
      constexpr int C_IN = 32 * 16, C_OUT = 16 * 16, C_F1 = 64 * 16, C_F2 = 16 * 64, C_QU = 12 * 4, C_KV = 12 * 2, C_W1 = 2 * 32, C_W2 = 2, C_WP = 4;
      constexpr int PER_L = C_IN + C_OUT + C_F1 + C_F2 + C_QU + C_KV + C_W1 + C_W2 + C_WP;
      for (int it = bid; it < DEPTH * PER_L; it += gdim) {
          const int l = it / PER_L; int r = it % PER_L;
          if (r < C_IN) { convert_tile(P.in[3] + (size_t)l * D * P_IN, P_IN, D, (bf16_t*)(ws + WS_WIN) + (size_t)l * ZP * D, P.in[2] + l * D, 1, (r >> 4) * 64, (r & 15) * 64, tile, tid); continue; } r -= C_IN;
          if (r < C_OUT) { convert_tile(P.in[13] + (size_t)l * D * D, D, D, (bf16_t*)(ws + WS_WOUT) + (size_t)l * D * D, nullptr, 0, (r >> 4) * 64, (r & 15) * 64, tile, tid); continue; } r -= C_OUT;
          if (r < C_F1) { convert_tile(P.in[15] + (size_t)l * D * FF, FF, D, (bf16_t*)(ws + WS_WFF1) + (size_t)l * FF * D, P.in[14] + l * D, 0, (r >> 4) * 64, (r & 15) * 64, tile, tid); continue; } r -= C_F1;
          if (r < C_F2) { convert_tile(P.in[16] + (size_t)l * FF * D, D, FF, (bf16_t*)(ws + WS_WFF2) + (size_t)l * D * FF, nullptr, 0, (r >> 6) * 64, (r & 63) * 64, tile, tid); continue; } r -= C_F2;
          if (r < C_QU) { convert_tile(P.in[8] + (size_t)l * 256 * 576, 576, 256, (bf16_t*)(ws + WS_WQUP) + (size_t)l * 768 * 256, P.in[7] + l * 256, 3, (r >> 2) * 64, (r & 3) * 64, tile, tid); continue; } r -= C_QU;
          if (r < C_KV) { convert_tile(P.in[10] + (size_t)l * 128 * 768, 768, 128, (bf16_t*)(ws + WS_WKVUP) + (size_t)l * 768 * 128, P.in[9] + l * 128, 2, (r >> 1) * 64, (r & 1) * 64, tile, tid); continue; } r -= C_KV;
          if (r < C_W1) { const int kv = r >> 5, kt = r & 31; convert_tile(P.in[5] + (size_t)(l * 2 + kv) * 2048 * 64, 64, 2048, (bf16_t*)(ws + WS_W1T) + (size_t)(l * 2 + kv) * 64 * 2048, nullptr, 0, 0, kt * 64, tile, tid); continue; } r -= C_W1;
          if (r < C_W2) { convert_tile(P.in[6] + (size_t)(l * 2 + r) * 64 * 64, 64, 64, (bf16_t*)(ws + WS_W2T) + (size_t)(l * 2 + r) * 64 * 64, nullptr, 0, 0, 0, tile, tid); continue; } r -= C_W2;
          convert_tile(P.in[11] + (size_t)(l * 4 + r) * 64 * 64, 64, 64, (bf16_t*)(ws + WS_WPT) + (size_t)(l * 4 + r) * 64 * 64, nullptr, 0, 0, 0, tile, tid);
      } }
}

#define MFMA16(a, b, c) __builtin_amdgcn_mfma_f32_16x16x32_bf16((a), (b), (c), 0, 0, 0)
#define MFMA32(a, b, c) __builtin_amdgcn_mfma_f32_32x32x16_bf16((a), (b), (c), 0, 0, 0)

__device__ __forceinline__ float gelu_tanh(float x) {
    const float u = 0.7978845608028654f * (x + 0.044715f * x * x * x);
    const float e = __expf(2.f * u);
    const float th = 1.f - 2.f / (e + 1.f);
    return 0.5f * x * (1.f + th);
}

__device__ __forceinline__ void compress_phase(const Params& P, int layer, LAS unsigned char* lds) {
    const int tid = tid_(), bid = bid_(), gdim = gdim_(), lane = tid & 63, wave = tid >> 6, sub = wave >> 2, et = wave & 3;
    const int l16 = lane & 15, quad = lane >> 4;
    unsigned char* ws = P.ws;
    const bf16_t* z = (const bf16_t*)(ws + WS_Z);
    bf16_t* kc = (bf16_t*)(ws + WS_KCMP);
    const float* bp = (const float*)(ws + WS_BIASP);
    LAS bf16_t* hb = (LAS bf16_t*)lds + sub * (16 * 72);
    for (int bi = bid; bi < 256; bi += gdim) {
        const int id = bi * 2 + sub, kv = id >> 8, rest = id & 255, b = rest >> 5, g = (rest >> 4) & 1, n0 = (rest & 15) * 16;
        const bf16_t* w1t = (const bf16_t*)(ws + WS_W1T) + ((size_t)(layer * 2 + kv) * 64 + 16 * et + l16) * 2048 + 8 * quad;
        const bf16_t* w2t = (const bf16_t*)(ws + WS_W2T) + ((size_t)(layer * 2 + kv) * 64 + 16 * et + l16) * 64 + 8 * quad;
        const int n = n0 + l16;
        const bf16_t* zc = z + Z_NKV + (kv * 2 + g) * 64 + 8 * quad;
        f32x4 acc = {0.f, 0.f, 0.f, 0.f};
#pragma unroll 4
        for (int l = 0; l < 32; ++l) {
            int tok = 16 * n + l; tok = tok > T - 1 ? T - 1 : tok;
            const bf16_t* ar = zc + (size_t)(b * T + tok) * ZP;
#pragma unroll
            for (int dh = 0; dh < 2; ++dh) {
                const bf16x8 a = *(const bf16x8*)(ar + 32 * dh);
                const bf16x8 bb = *(const bf16x8*)(w1t + l * 64 + 32 * dh);
                acc = MFMA16(a, bb, acc);
            }
        }
        float bsum = 0.f;
        for (int ch = 0; ch < 32; ++ch) bsum += bp[((size_t)(layer * 2 + kv) * 32 + ch) * 64 + 16 * et + l16];
#pragma unroll
        for (int j = 0; j < 4; ++j) hb[(4 * quad + j) * 72 + 16 * et + l16] = (bf16_t)f2bf(gelu_tanh(acc[j] + bsum));
        __syncthreads();
        f32x4 acc2 = {0.f, 0.f, 0.f, 0.f};
#pragma unroll
        for (int ks = 0; ks < 2; ++ks) {
            const bf16x8 a = *(const LAS bf16x8*)(hb + l16 * 72 + 32 * ks + 8 * quad);
            const bf16x8 bb = *(const bf16x8*)(w2t + 32 * ks);
            acc2 = MFMA16(a, bb, acc2);
        }
#pragma unroll
        for (int j = 0; j < 4; ++j) {
            const int nr = n0 + 4 * quad + j;
            kc[((size_t)((kv * NB + b) * 2 + g) * 256 + nr) * 64 + 16 * et + l16] = (bf16_t)(nr < 255 ? f2bf(acc2[j]) : 0u);
        }
        __syncthreads();
    }
}

__device__ __forceinline__ void pool_phase(const Params& P, int layer) {
    const int tid = tid_(), bid = bid_(), gdim = gdim_(), lane = tid & 63, wave = tid >> 6, l16 = lane & 15, quad = lane >> 4;
    unsigned char* ws = P.ws;
    const bf16_t* z = (const bf16_t*)(ws + WS_Z);
    bf16_t* mix = (bf16_t*)(ws + WS_MIX);
    const float* psc = P.in[12] + layer * 256;
    for (int wi = bid * 8 + wave; wi < (M / 16) * 4; wi += gdim * 8) {
        const int tt = wi >> 2, gi = wi & 3, w = 2 << gi;
        const int row = tt * 16 + l16, t = row & (T - 1);
        const int cnt = (t + 1 < w) ? t + 1 : w; const float icnt = 1.0f / (float)cnt;
        const bf16_t* wpt = (const bf16_t*)(ws + WS_WPT) + ((size_t)(layer * 4 + gi) * 64 + l16) * 64 + 8 * quad;
        f32x4 acc[4];
#pragma unroll
        for (int dt = 0; dt < 4; ++dt) acc[dt] = (f32x4){0.f, 0.f, 0.f, 0.f};
#pragma unroll
        for (int ks = 0; ks < 2; ++ks) {
            const bf16_t* ur = z + (size_t)row * ZP + Z_PU + gi * 64 + 32 * ks + 8 * quad;
            float s[8];
#pragma unroll
            for (int j = 0; j < 8; ++j) s[j] = 0.f;
            for (int i = 0; i < w; ++i) {
                if (i < cnt) {
                    const bf16x8 v = *(const bf16x8*)(ur - (size_t)i * ZP);
#pragma unroll
                    for (int j = 0; j < 8; ++j) s[j] += bf2f((unsigned short)v[j]);
                }
            }
            const bf16x8 u0 = *(const bf16x8*)ur;
            u32x4 pa;
            pa.x = pk2(s[0] * icnt - bf2f((unsigned short)u0[0]), s[1] * icnt - bf2f((unsigned short)u0[1]));
            pa.y = pk2(s[2] * icnt - bf2f((unsigned short)u0[2]), s[3] * icnt - bf2f((unsigned short)u0[3]));
            pa.z = pk2(s[4] * icnt - bf2f((unsigned short)u0[4]), s[5] * icnt - bf2f((unsigned short)u0[5]));
            pa.w = pk2(s[6] * icnt - bf2f((unsigned short)u0[6]), s[7] * icnt - bf2f((unsigned short)u0[7]));
            const bf16x8 a = __builtin_bit_cast(bf16x8, pa);
#pragma unroll
            for (int dt = 0; dt < 4; ++dt) {
                const bf16x8 bb = *(const bf16x8*)(wpt + (size_t)dt * 16 * 64 + 32 * ks);
                acc[dt] = MFMA16(a, bb, acc[dt]);
            }
        }
#pragma unroll
        for (int dt = 0; dt < 4; ++dt) {
            const float sc = psc[gi * 64 + 16 * dt + l16];
#pragma unroll
            for (int j = 0; j < 4; ++j) mix[(size_t)(tt * 16 + 4 * quad + j) * D + 768 + gi * 64 + 16 * dt + l16] = (bf16_t)f2bf(acc[dt][j] * sc);
        }
    }
}

constexpr int AL_K0 = 0, AL_KSZ = 13312, AL_V0 = 2 * AL_KSZ, AL_VSZ = 9216, AL_WSF = AL_V0 + 2 * AL_VSZ, AL_IMP = AL_WSF + 2048, AL_SCORE = AL_IMP + 6 * 8192, AL_SEL = AL_SCORE + 16384, AL_BC = AL_SEL + 512;
static_assert(AL_BC + 64 <= 131072, "attention LDS map");
constexpr int VPB = 144;

__device__ __forceinline__ s16x4 vtr(const LAS unsigned char* p) { return __builtin_bit_cast(s16x4, __builtin_amdgcn_ds_read_tr16_b64_v4i16((LAS v4i16_t*)p)); }

template <int NDC, int KPB>
__device__ __forceinline__ void qk_tile(f32x16& p0, f32x16& p1, const LAS unsigned char* Kt, const bf16x8* qf, int r, int h) {
    const LAS unsigned char* kb = Kt + r * KPB + h * 16;
#pragma unroll
    for (int c = 0; c < 16; ++c) { p0[c] = 0.f; p1[c] = 0.f; }
#pragma unroll
    for (int c = 0; c < NDC; ++c) {
        const bf16x8 k0 = *(const LAS bf16x8*)(kb + c * 32);
        const bf16x8 k1 = *(const LAS bf16x8*)(kb + 32 * KPB + c * 32);
        p0 = MFMA32(k0, qf[c], p0); p1 = MFMA32(k1, qf[c], p1);
    }
}

__device__ __forceinline__ bf16x8 pack8(const f32x16& p, int s) {
    u32x4 w; w.x = pk2(p[8 * s], p[8 * s + 1]); w.y = pk2(p[8 * s + 2], p[8 * s + 3]); w.z = pk2(p[8 * s + 4], p[8 * s + 5]); w.w = pk2(p[8 * s + 6], p[8 * s + 7]);
    return __builtin_bit_cast(bf16x8, w);
}

__device__ __forceinline__ void pv_tile(f32x16& o0, f32x16& o1, const f32x16& p0, const f32x16& p1, const LAS unsigned char* Vt, int lane) {
    const int i16 = lane & 15, q4 = i16 >> 2, p4 = i16 & 3, blk = (lane >> 4) & 1, h = lane >> 5;
    const LAS unsigned char* vb = Vt + (4 * h + q4) * VPB + blk * 32 + p4 * 8;
#pragma unroll
    for (int ks = 0; ks < 4; ++ks) {
        const bf16x8 pa = (ks < 2) ? pack8(p0, ks & 1) : pack8(p1, ks & 1);
        {
            const s16x4 lo = vtr(vb + (16 * ks) * VPB), hi = vtr(vb + (16 * ks + 8) * VPB);
            const bf16x8 vv = __builtin_shufflevector(lo, hi, 0, 1, 2, 3, 4, 5, 6, 7);
            o0 = MFMA32(pa, vv, o0);
        }
        {
            const s16x4 lo = vtr(vb + (16 * ks) * VPB + 64), hi = vtr(vb + (16 * ks + 8) * VPB + 64);
            const bf16x8 vv = __builtin_shufflevector(lo, hi, 0, 1, 2, 3, 4, 5, 6, 7);
            o1 = MFMA32(pa, vv, o1);
        }
    }
}

__device__ __forceinline__ float tile_rowmax(const f32x16& p0, const f32x16& p1) {
    float a = fmaxf(p0[0], p1[0]);
#pragma unroll
    for (int i = 1; i < 16; ++i) a = fmaxf(a, fmaxf(p0[i], p1[i]));
    return fmaxf(a, __shfl_xor(a, 32));
}

__device__ __forceinline__ void softmax_step(f32x16& p0, f32x16& p1, float& mref, float& l, f32x16& o0, f32x16& o1, LAS float* wsf, int r, int h) {
    const float rm = tile_rowmax(p0, p1);
    const bool need = rm > mref + 6.0f;
    if (__any(need)) {
        const float mnew = fmaxf(mref, rm);
        const float alpha = (mnew == -INFINITY) ? 1.f : fast_exp2(mref - mnew);
        mref = mnew; l *= alpha;
        if (h == 0) wsf[r] = alpha;
        asm volatile("" ::: "memory");
#pragma unroll
        for (int i = 0; i < 16; ++i) { const float a = wsf[crow(i, h)]; o0[i] *= a; o1[i] *= a; }
    }
    const float ms = (mref == -INFINITY) ? 0.f : mref;
    float s = 0.f;
#pragma unroll
    for (int i = 0; i < 16; ++i) { p0[i] = fast_exp2(p0[i] - ms); p1[i] = fast_exp2(p1[i] - ms); s += p0[i] + p1[i]; }
    l += s;
}

enum { MODE_MLA = 0, MODE_WIN = 1, MODE_SLC = 2, MODE_CMP1 = 3, MODE_CMP2 = 4 };

template <int MODE>
__device__ __forceinline__ void attn_branch(LAS unsigned char* L, const bf16_t* kS, int kP, const bf16_t* vS, int vP, const bf16_t* rS, int rP,
                                            int t0, int t1, const bf16x8* qf, int qpos, bool active, int wlo, int whi, int cblk, unsigned long long sel,
                                            float& mref, float& l, f32x16& o0, f32x16& o1, float pscale, float pgate, LAS float* impw, LAS float* wsf, int tid) {
    constexpr int KPB = (MODE == MODE_MLA) ? 208 : 144;
    constexpr int NDC = (MODE == MODE_MLA) ? 6 : 4;
    const int lane = tid & 63, r = lane & 31, h = lane >> 5;
    const int srow = tid >> 3, sch = tid & 7;
    u32x4 kreg = {0, 0, 0, 0}, vreg = {0, 0, 0, 0}, rreg = {0, 0, 0, 0};
#define AB_LOAD(t) do { const size_t row_ = (size_t)(t) * 64 + srow; kreg = *(const u32x4*)(kS + row_ * kP + sch * 8); \
        if (MODE != MODE_CMP1) vreg = *(const u32x4*)(vS + row_ * vP + sch * 8); \
        if (MODE == MODE_MLA) { if (tid < 256) rreg = *(const u32x4*)(rS + ((size_t)(t) * 64 + (tid >> 2)) * rP + (tid & 3) * 8); } } while (0)
#define AB_STORE(buf) do { *(LAS u32x4*)(L + AL_K0 + (buf) * AL_KSZ + srow * KPB + sch * 16) = kreg; \
        if (MODE != MODE_CMP1) *(LAS u32x4*)(L + AL_V0 + (buf) * AL_VSZ + srow * VPB + sch * 16) = vreg; \
        if (MODE == MODE_MLA) { if (tid < 256) *(LAS u32x4*)(L + AL_K0 + (buf) * AL_KSZ + (tid >> 2) * KPB + 128 + (tid & 3) * 16) = rreg; } } while (0)
    if (t0 < t1) { AB_LOAD(t0); AB_STORE(0); }
    __syncthreads();
    for (int t = t0; t < t1; ++t) {
        const int cur = (t - t0) & 1;
        if (t + 1 < t1) AB_LOAD(t + 1);
        if (active && t >= wlo && t <= whi) {
            f32x16 p0, p1;
            qk_tile<NDC, KPB>(p0, p1, L + AL_K0 + cur * AL_KSZ, qf, r, h);
            const int kb = 64 * t + 4 * h;
            if (MODE == MODE_MLA) {
                if (64 * t + 63 > (qpos - r)) {
#pragma unroll
                    for (int i = 0; i < 16; ++i) { const int kv = kb + (i & 3) + 8 * (i >> 2); if (kv > qpos) p0[i] = -INFINITY; if (kv + 32 > qpos) p1[i] = -INFINITY; }
                }
            } else if (MODE == MODE_WIN) {
#pragma unroll
                for (int i = 0; i < 16; ++i) { const int kv = kb + (i & 3) + 8 * (i >> 2);
                    if (kv > qpos || kv <= qpos - 512) p0[i] = -INFINITY; if (kv + 32 > qpos || kv + 32 <= qpos - 512) p1[i] = -INFINITY; }
            } else if (MODE == MODE_SLC) {
                const bool on = (sel >> t) & 1ull;
#pragma unroll
                for (int i = 0; i < 16; ++i) { const int kv = kb + (i & 3) + 8 * (i >> 2);
                    if (!on || kv > qpos) p0[i] = -INFINITY; if (!on || kv + 32 > qpos) p1[i] = -INFINITY; }
            } else {
#pragma unroll
                for (int i = 0; i < 16; ++i) { const int kv = kb + (i & 3) + 8 * (i >> 2);
                    if (16 * kv + 31 > qpos) p0[i] = -INFINITY; if (16 * (kv + 32) + 31 > qpos) p1[i] = -INFINITY; }
            }
            if (MODE == MODE_CMP1) {
                const float rm = tile_rowmax(p0, p1);
                const float mnew = fmaxf(mref, rm);
                const float ms = (mnew == -INFINITY) ? 0.f : mnew;
                const float alpha = (mnew == -INFINITY) ? 1.f : fast_exp2(mref - mnew);
                float s = 0.f;
#pragma unroll
                for (int i = 0; i < 16; ++i) s += fast_exp2(p0[i] - ms) + fast_exp2(p1[i] - ms);
                l = l * alpha + s; mref = mnew;
            } else if (MODE == MODE_CMP2) {
                const float ms = (mref == -INFINITY) ? 0.f : mref;
#pragma unroll
                for (int i = 0; i < 16; ++i) { p0[i] = fast_exp2(p0[i] - ms) * pscale; p1[i] = fast_exp2(p1[i] - ms) * pscale; }
                LAS float* iw = impw + r * 64 + 16 * (t - t0) + h;
#pragma unroll
                for (int k = 0; k < 4; ++k) { iw[2 * k] += (p0[4 * k] + p0[4 * k + 1]) + (p0[4 * k + 2] + 0.5f * p0[4 * k + 3]); iw[8 + 2 * k] += (p1[4 * k] + p1[4 * k + 1]) + (p1[4 * k + 2] + 0.5f * p1[4 * k + 3]); }
                asm volatile("" ::: "memory");
#pragma unroll
                for (int k = 0; k < 4; ++k) { iw[2 * k + 1] += 0.5f * p0[4 * k + 3]; if (16 * (t - t0) + h + 8 + 2 * k + 1 < 64) iw[8 + 2 * k + 1] += 0.5f * p1[4 * k + 3]; }
#pragma unroll
                for (int i = 0; i < 16; ++i) { p0[i] *= pgate; p1[i] *= pgate; }
                pv_tile(o0, o1, p0, p1, L + AL_V0 + cur * AL_VSZ, lane);
            } else {
                softmax_step(p0, p1, mref, l, o0, o1, wsf, r, h);
                pv_tile(o0, o1, p0, p1, L + AL_V0 + cur * AL_VSZ, lane);
            }
        }
        if (t + 1 < t1) AB_STORE(cur ^ 1);
        __syncthreads();
    }
#undef AB_LOAD
#undef AB_STORE
}

__device__ __forceinline__ void branch_finish(f32x16& out0, f32x16& out1, const f32x16& o0, const f32x16& o1, float l, float gate, LAS float* wsf, int r, int h) {
    const float lt = l + __shfl_xor(l, 32);
    const float f = lt > 0.f ? gate / lt : 0.f;
    if (h == 0) wsf[r] = f;
    asm volatile("" ::: "memory");
#pragma unroll
    for (int i = 0; i < 16; ++i) { const float a = wsf[crow(i, h)]; out0[i] += o0[i] * a; out1[i] += o1[i] * a; }
    asm volatile("" ::: "memory");
}

__device__ __forceinline__ float sigmoidf_(float x) { return 1.f / (1.f + __expf(-x)); }

__device__ __forceinline__ void nsa_unit(const Params& P, LAS unsigned char* L, int b, int g, int c) {
    const int tid = tid_(), lane = tid & 63, wave = __builtin_amdgcn_readfirstlane(tid >> 6), r = lane & 31, h = lane >> 5;
    unsigned char* ws = P.ws;
    const bf16_t* z = (const bf16_t*)(ws + WS_Z);
    const bf16_t* kcmp = (const bf16_t*)(ws + WS_KCMP);
    bf16_t* mix = (bf16_t*)(ws + WS_MIX);
    const bool active = wave < 6;
    const int hh = active ? (wave >> 1) : 0, qh = wave & 1, head = 3 * g + hh;
    const int q0 = 64 * c, qpos = q0 + 32 * qh + r;
    const size_t qrow = (size_t)b * T + qpos;
    LAS float* wsf = (LAS float*)(L + AL_WSF) + wave * 64;
    LAS float* impw = (LAS float*)(L + AL_IMP) + (active ? wave : 0) * 2048;
    bf16x8 qf[4];
#pragma unroll
    for (int cc = 0; cc < 4; ++cc) qf[cc] = *(const bf16x8*)(z + qrow * ZP + Z_NQ + head * 64 + 16 * cc + 8 * h);
    const bf16_t* gp = z + qrow * ZP + Z_GATE + head * 3;
    const float g_cmp = sigmoidf_(bf2f(gp[0])), g_slc = sigmoidf_(bf2f(gp[1])), g_win = sigmoidf_(bf2f(gp[2]));
    f32x16 out0, out1, o0, o1;
#pragma unroll
    for (int i = 0; i < 16; ++i) { out0[i] = 0.f; out1[i] = 0.f; o0[i] = 0.f; o1[i] = 0.f; }
    const int ntc = (4 * c + 3 + 63) >> 6;
    const bf16_t* kc = kcmp + (size_t)((0 * NB + b) * 2 + g) * 256 * 64;
    const bf16_t* vc = kcmp + (size_t)((1 * NB + b) * 2 + g) * 256 * 64;
    float m1 = -INFINITY, l1 = 0.f;
    attn_branch<MODE_CMP1>(L, kc, 64, vc, 64, nullptr, 0, 0, ntc, qf, qpos, active, 0, ntc, c, 0ull, m1, l1, o0, o1, 0.f, 0.f, impw, wsf, tid);
    { const float lt = l1 + __shfl_xor(l1, 32); const float inv = lt > 0.f ? 1.f / lt : 0.f;
      if (active) { for (int i = lane; i < 2048; i += 64) impw[i] = 0.f; }
      attn_branch<MODE_CMP2>(L, kc, 64, vc, 64, nullptr, 0, 0, ntc, qf, qpos, active, 0, ntc, c, 0ull, m1, l1, out0, out1, inv, g_cmp, impw, wsf, tid); }
    {
        LAS float* imp = (LAS float*)(L + AL_IMP); LAS float* sc = (LAS float*)(L + AL_SCORE); LAS unsigned long long* selL = (LAS unsigned long long*)(L + AL_SEL);
        const int q = tid >> 3, part = tid & 7;
        float my[8];
#pragma unroll
        for (int j = 0; j < 8; ++j) { const int s = part * 8 + j; const int o = (q >> 5) * 2048 + (q & 31) * 64 + s;
            const float v = (imp[o] + imp[o + 2 * 2048]) + imp[o + 4 * 2048];
            my[j] = (s > c) ? -1.f : ((s == 0 || s == c || s == c - 1) ? 1.0e4f : v);
            sc[q * 64 + s] = my[j]; }
        __syncthreads();
        int rank[8];
#pragma unroll
        for (int j = 0; j < 8; ++j) rank[j] = 0;
        for (int s2 = 0; s2 < 64; ++s2) { const float v = sc[q * 64 + s2];
#pragma unroll
            for (int j = 0; j < 8; ++j) rank[j] += (v > my[j] || (v == my[j] && s2 < part * 8 + j)) ? 1 : 0; }
        unsigned bits = 0;
#pragma unroll
        for (int j = 0; j < 8; ++j) if (part * 8 + j <= c && rank[j] < 16) bits |= 1u << j;
        unsigned lo = (part < 4) ? (bits << (8 * part)) : 0u, hi = (part >= 4) ? (bits << (8 * (part - 4))) : 0u;
        lo |= __shfl_xor(lo, 1); hi |= __shfl_xor(hi, 1); lo |= __shfl_xor(lo, 2); hi |= __shfl_xor(hi, 2); lo |= __shfl_xor(lo, 4); hi |= __shfl_xor(hi, 4);
        if (part == 0) selL[q] = ((unsigned long long)hi << 32) | lo;
        __syncthreads();
    }
    const unsigned long long sel = ((LAS unsigned long long*)(L + AL_SEL))[32 * qh + r];
    {
        const bf16_t* ks = z + (size_t)b * T * ZP + Z_NKV + ((1 * 2 + 0) * 2 + g) * 64;
        const bf16_t* vs = z + (size_t)b * T * ZP + Z_NKV + ((1 * 2 + 1) * 2 + g) * 64;
        float m = -INFINITY, l = 0.f;
#pragma unroll
        for (int i = 0; i < 16; ++i) { o0[i] = 0.f; o1[i] = 0.f; }
        attn_branch<MODE_SLC>(L, ks, ZP, vs, ZP, nullptr, 0, 0, c + 1, qf, qpos, active, 0, c, c, sel, m, l, o0, o1, 0.f, 0.f, impw, wsf, tid);
        branch_finish(out0, out1, o0, o1, l, g_slc, wsf, r, h);
    }
    {
        const bf16_t* kw = z + (size_t)b * T * ZP + Z_NKV + ((2 * 2 + 0) * 2 + g) * 64;
        const bf16_t* vw = z + (size_t)b * T * ZP + Z_NKV + ((2 * 2 + 1) * 2 + g) * 64;
        float m = -INFINITY, l = 0.f;
#pragma unroll
        for (int i = 0; i < 16; ++i) { o0[i] = 0.f; o1[i] = 0.f; }
        const int tb = c >= 8 ? c - 8 : 0;
        attn_branch<MODE_WIN>(L, kw, ZP, vw, ZP, nullptr, 0, tb, c + 1, qf, qpos, active, tb, c, c, 0ull, m, l, o0, o1, 0.f, 0.f, impw, wsf, tid);
        branch_finish(out0, out1, o0, o1, l, g_win, wsf, r, h);
    }
    if (active) {
        bf16_t* op = mix + ((size_t)b * T + q0 + 32 * qh) * D + head * 64 + r;
#pragma unroll
        for (int i = 0; i < 16; ++i) { const int qq = crow(i, h); op[(size_t)qq * D] = (bf16_t)f2bf(out0[i]); op[(size_t)qq * D + 32] = (bf16_t)f2bf(out1[i]); }
    }
}

__device__ __forceinline__ void mla_unit(const Params& P, LAS unsigned char* L, int b, int hd, int qb) {
    const int tid = tid_(), lane = tid & 63, wave = __builtin_amdgcn_readfirstlane(tid >> 6), r = lane & 31, h = lane >> 5;
    unsigned char* ws = P.ws;
    const bf16_t* z = (const bf16_t*)(ws + WS_Z);
    const bf16_t* qm = (const bf16_t*)(ws + WS_QM);
    const bf16_t* kvm = (const bf16_t*)(ws + WS_KVM);
    bf16_t* mix = (bf16_t*)(ws + WS_MIX);
    const int q0 = 256 * qb, qpos = q0 + 32 * wave + r;
    const size_t qrow = (size_t)b * T + qpos;
    LAS float* wsf = (LAS float*)(L + AL_WSF) + wave * 64;
    bf16x8 qf[6];
#pragma unroll
    for (int cc = 0; cc < 6; ++cc) qf[cc] = *(const bf16x8*)(qm + qrow * QMP + hd * 96 + 16 * cc + 8 * h);
    f32x16 o0, o1, out0, out1;
#pragma unroll
    for (int i = 0; i < 16; ++i) { o0[i] = 0.f; o1[i] = 0.f; }
    float m = -INFINITY, l = 0.f;
    const bf16_t* kS = kvm + (size_t)b * T * KVP + hd * 64;
    const bf16_t* vS = kvm + (size_t)b * T * KVP + 384 + hd * 64;
    const bf16_t* rS = z + (size_t)b * T * ZP + Z_KR;
    const int nt = 4 * qb + 4, whi = (q0 + 32 * wave + 31) >> 6;
    attn_branch<MODE_MLA>(L, kS, KVP, vS, KVP, rS, ZP, 0, nt, qf, qpos, true, 0, whi, 0, 0ull, m, l, o0, o1, 0.f, 0.f, wsf, wsf, tid);
    { const float lt = l + __shfl_xor(l, 32); const float f = lt > 0.f ? 1.f / lt : 0.f;
      if (h == 0) wsf[r] = f;
      asm volatile("" ::: "memory");
#pragma unroll
      for (int i = 0; i < 16; ++i) { const float a = wsf[crow(i, h)]; out0[i] = o0[i] * a; out1[i] = o1[i] * a; } }
    bf16_t* op = mix + ((size_t)b * T + q0 + 32 * wave) * D + 384 + hd * 64 + r;
#pragma unroll
    for (int i = 0; i < 16; ++i) { const int qq = crow(i, h); op[(size_t)qq * D] = (bf16_t)f2bf(out0[i]); op[(size_t)qq * D + 32] = (bf16_t)f2bf(out1[i]); }
}

constexpr int N_NSA_UNITS = NB * 2 * 64, N_MLA_UNITS = NB * 6 * 16;
__device__ __forceinline__ void attention_phase(const Params& P, int layer, LAS unsigned char* L) {
    unsigned* ctr = (unsigned*)(P.ws + WS_CTL) + 64 * layer;
    LAS unsigned* bc = (LAS unsigned*)(L + AL_BC);
    for (;;) {
        if (tid_() == 0) bc[0] = __hip_atomic_fetch_add(ctr, 1u, __ATOMIC_RELAXED, __HIP_MEMORY_SCOPE_AGENT);
        __syncthreads();
        const unsigned u = bc[0];
        __syncthreads();
        if (u >= (unsigned)(N_NSA_UNITS + N_MLA_UNITS)) break;
#ifndef ATT_MASK
#define ATT_MASK 3
#endif
        if (u < (unsigned)N_NSA_UNITS) { if (ATT_MASK & 1) { const int c = 63 - (int)(u >> 4), bg = u & 15; nsa_unit(P, L, bg >> 1, bg & 1, c); } }
        else if (ATT_MASK & 2) { const int v = (int)u - N_NSA_UNITS; const int qb = 15 - v / 48, bh = v % 48; mla_unit(P, L, bh / 6, bh % 6, qb); }
    }
}

__device__ __forceinline__ void final_phase(const Params& P) {
    const int tid = tid_(), bid = bid_(), gdim = gdim_(), lane = tid & 63, wave = tid >> 6;
    const float* ss = (const float*)(P.ws + WS_SS) + (size_t)8 * M; const float* gf = P.in[17];
    for (int r = bid * 8 + wave; r < M; r += gdim * 8) {
        const float rs = rsqrtf(ss[r] * (1.0f / 1024.0f) + EPS);
        f32x4* xr = (f32x4*)(P.out + (size_t)r * D) + lane;
#pragma unroll
        for (int j = 0; j < 4; ++j) { const f32x4 gv = *((const f32x4*)gf + lane + 64 * j); xr[64 * j] = xr[64 * j] * rs * gv; }
    }
}

__device__ __forceinline__ unsigned char* ws_of(const Params& P) { unsigned char* w = P.ws; asm volatile("" : "+s"(w)); return w; }
#ifndef PMASK
#define PMASK 0xffffffffu
#endif
__global__ void __launch_bounds__(512) trunk_fwd(Params P, int ph_lo, int ph_hi) {
    extern __shared__ __attribute__((aligned(16))) unsigned char lds_raw[];
    LAS unsigned char* lds = (LAS unsigned char*)lds_raw;
    cg::grid_group grid = cg::this_grid();
    for (int ph = ph_lo; ph < ph_hi; ++ph) {
        const int l = (ph - 1) / 6, k = (ph == 0) ? 0 : ((ph == 1 + 6 * DEPTH) ? 7 : 1 + (ph - 1) % 6);
        unsigned char* ws = ws_of(P);
        float* ssb = (float*)(ws + WS_SS);
        if (k == 0) { if (PMASK & 1u) prologue(P, lds); }
        else if (k == 1) { if (PMASK & 2u) {
            const float* ropec = (const float*)(ws + WS_ROPE);
            EpiInProj E{(bf16_t*)(ws + WS_Z), (l == 0) ? ssb : ssb + (size_t)4 * M, ssb + (size_t)(1 + 4 * l) * M, ssb + (size_t)(2 + 4 * l) * M, ropec, ropec + (size_t)M * 16};
            run_gemm(lds, (const bf16_t*)(ws + WS_XB), D, (const bf16_t*)(ws + WS_WIN) + (size_t)l * ZP * D, ZP, D, E); } }
        else if (k == 2) {
            if (PMASK & 4u) { const float* ropec = (const float*)(ws + WS_ROPE); EpiQup E{(bf16_t*)(ws + WS_QM), ssb + (size_t)(1 + 4 * l) * M, ropec, ropec + (size_t)M * 16};
                run_gemm(lds, (const bf16_t*)(ws + WS_Z) + Z_CQ, ZP, (const bf16_t*)(ws + WS_WQUP) + (size_t)l * 768 * 256, 768, 256, E); }
            if (PMASK & 8u) { unsigned char* ws2 = ws_of(P); EpiKVup E{(bf16_t*)(ws2 + WS_KVM), (const float*)(ws2 + WS_SS) + (size_t)(2 + 4 * l) * M};
                run_gemm(lds, (const bf16_t*)(ws2 + WS_Z) + Z_CKV, ZP, (const bf16_t*)(ws2 + WS_WKVUP) + (size_t)l * 768 * 128, 768, 128, E); }
            if (PMASK & 16u) compress_phase(P, l, lds);
            if (PMASK & 32u) pool_phase(P, l);
        }
        else if (k == 3) { if (PMASK & 64u) attention_phase(P, l, lds); }
        else if (k == 4) { if (PMASK & 128u) { EpiResid E{l == 0 ? P.in[0] : P.out, P.out, (bf16_t*)(ws + WS_XB), ssb + (size_t)(3 + 4 * l) * M};
            run_gemm(lds, (const bf16_t*)(ws + WS_MIX), D, (const bf16_t*)(ws + WS_WOUT) + (size_t)l * D * D, D, D, E); } }
        else if (k == 5) { if (PMASK & 256u) { EpiFF1 E{(bf16_t*)(ws + WS_H), ssb + (size_t)(3 + 4 * l) * M};
            run_gemm(lds, (const bf16_t*)(ws + WS_XB), D, (const bf16_t*)(ws + WS_WFF1) + (size_t)l * FF * D, FF, D, E); } }
        else if (k == 6) { if (PMASK & 512u) { EpiResid E{P.out, P.out, (bf16_t*)(ws + WS_XB), ssb + (size_t)(4 + 4 * l) * M};
            run_gemm(lds, (const bf16_t*)(ws + WS_H), FF, (const bf16_t*)(ws + WS_WFF2) + (size_t)l * D * FF, D, FF, E); } }
        else { if (PMASK & 1024u) final_phase(P); }
        if (ph + 1 < ph_hi) grid.sync();
    }
}
constexpr int N_PHASES = 1 + 6 * DEPTH + 1;

#ifndef MK_MULTI
#define MK_MULTI 0
#endif
extern "C" void kernel_launch(void* const* d_in, const int* in_sizes, int n_in, void* d_out, int out_size, void* d_ws, size_t ws_size, hipStream_t stream) {
    static int grid_blocks = 0;
    if (grid_blocks == 0) {
        if (n_in != 18 || out_size != M * D || ws_size < WS_END) { fprintf(stderr, "kernel_launch: unexpected shapes (n_in %d out %d ws %zu)\n", n_in, out_size, ws_size); grid_blocks = -1; return; }
        int dev = 0, cus = 0, per_cu = 0;
        hipGetDevice(&dev);
        hipDeviceGetAttribute(&cus, hipDeviceAttributeMultiprocessorCount, dev);
        if (hipFuncSetAttribute((const void*)trunk_fwd, hipFuncAttributeMaxDynamicSharedMemorySize, LDS_BYTES) != hipSuccess) { fprintf(stderr, "kernel_launch: hipFuncSetAttribute failed\n"); grid_blocks = -1; return; }
        if (hipOccupancyMaxActiveBlocksPerMultiprocessor(&per_cu, (const void*)trunk_fwd, 512, LDS_BYTES) != hipSuccess || per_cu < 1) { fprintf(stderr, "kernel_launch: occupancy query gave %d\n", per_cu); per_cu = 1; }
        (void)hipGetLastError();
        grid_blocks = cus * per_cu;
    }
    if (grid_blocks < 0) return;
    Params p{};
    for (int i = 0; i < 18; ++i) p.in[i] = (const float*)d_in[i];
    p.out = (float*)d_out; p.ws = (unsigned char*)d_ws;
#if MK_MULTI
    for (int k = 0; k < N_PHASES; ++k) { int lo = k, hi = k + 1; hipLaunchKernelGGL(trunk_fwd, dim3(grid_blocks), dim3(512), LDS_BYTES, stream, p, lo, hi); }
#else
    int lo = 0, hi = N_PHASES;
    void* args[] = {&p, &lo, &hi};
    hipError_t e = hipLaunchCooperativeKernel((const void*)trunk_fwd, dim3(grid_blocks), dim3(512), args, LDS_BYTES, stream);
    if (e != hipSuccess) fprintf(stderr, "cooperative launch failed: %s (grid %d)\n", hipGetErrorString(e), grid_blocks);
#endif
}
```

```cpp
#include <hip/hip_runtime.h>
#include <hip/hip_cooperative_groups.h>
#include <cstdio>
#include <cstdint>
namespace cg = cooperative_groups;

namespace pg8 {
#define PG8_LAS __attribute__((address_space(3)))
typedef unsigned short bf16_t;
typedef short bf16x8 __attribute__((ext_vector_type(8)));
typedef float f32x4 __attribute__((ext_vector_type(4)));
typedef unsigned u32x4 __attribute__((ext_vector_type(4)));
constexpr int BM = 256, BK = 64, HALF = 128, HTB = HALF * BK * 2  , STAGE_BYTES = 8 * HTB, NXCD = 8, WGM = 8;

__host__ __device__ __forceinline__ int lds_byte(int r, int c) { const int st = (r >> 4) * 2 + (c >> 5), rr = r & 15, cc = c & 31, ob = rr * 64 + cc * 2; return st * 1024 + (ob ^ (((ob >> 9) & 1) << 5)); }
__host__ __device__ __forceinline__ void stage_rc(int b, int& R, int& C) { const int st = b / 1024, sb = b % 1024, swz = sb ^ (((sb >> 9) & 1) << 5); R = (st >> 1) * 16 + swz / 64; C = (st & 1) * 32 + (swz % 64) / 2; }
__host__ __device__ __forceinline__ int perm32(int rho) { const int n = rho >> 4, i = rho & 15; return 8 * (i >> 2) + 4 * n + (i & 3); }

struct Unit { int pm, pn; };
struct Gemm { const bf16_t* A; const bf16_t* Bt; int M, N, K, lda; };
struct StaticOrder {
    int nM, nN, nwg, G, c;
    __host__ __device__ void init(int M, int N, int G_, int c_) { nM = M / BM; nN = N / BM; nwg = nM * nN; G = G_; c = c_; }
    __host__ __device__ bool next(int i, Unit& u) const {
        const long L = (long)i * G + c; if (L >= nwg) return false;
        int wgid = (int)L; { const int q = nwg / NXCD, r = nwg % NXCD, xcd = wgid % NXCD, off = wgid / NXCD; wgid = (xcd < r ? xcd * (q + 1) : r * (q + 1) + (xcd - r) * q) + off; }
        const int nig = WGM * nN, gid = wgid / nig, fm = gid * WGM, gsz = (nM - fm) < WGM ? (nM - fm) : WGM;
        u.pm = fm + ((wgid % nig) % gsz); u.pn = (wgid % nig) / gsz; return true;
    }
    __device__ __forceinline__ void a_ready(const Unit&) const {}
    __device__ __forceinline__ void done(const Unit&) const {}
};
__device__ __forceinline__ unsigned cvt_pk_bf16(float lo, float hi) { unsigned r; asm volatile("v_cvt_pk_bf16_f32 %0, %1, %2" : "=v"(r) : "v"(lo), "v"(hi)); return r; }
template <class Epi, class Sched, bool ALIGN_EPI = false, bool SP2 = false>
__device__ __forceinline__ void gemm_phase(PG8_LAS unsigned char* lds, const Gemm g, const Sched& S, const Epi& E) {
    int tid = threadIdx.x; asm volatile("" : "+v"(tid)); const int wid = __builtin_amdgcn_readfirstlane(tid >> 6), lane = tid & 63, wr = wid >> 2, wc = wid & 3, fr = lane & 15, fq = lane >> 4;
    const int K = g.K, nt = K / BK;
    unsigned voffA[2], voffB[2];
#pragma unroll
    for (int i = 0; i < 2; ++i) { int R, C; stage_rc(tid * 16 + i * 8192, R, C); const int Rb = Epi::PERM ? ((R & ~31) + perm32(R & 31)) : R;
        voffA[i] = (unsigned)(R * g.lda + C) * 2u; voffB[i] = (unsigned)(Rb * K + C) * 2u; }
    const size_t kstep = (size_t)(BK * 2);
    const size_t hstepB = (size_t)HALF * K * 2, hstepA = (size_t)HALF * g.lda * 2;
    const size_t tstepB = 2 * hstepB, tstepA = 2 * hstepA;
    const unsigned ldsw = (unsigned)wid * 1024u;
    const int aoff = lds_byte(wr * 64 + fr, fq * 8), boff = lds_byte(wc * 32 + fr, fq * 8);
#define PG8_SA(b, h) (((b) * 2 + (h)) * HTB)
#define PG8_SB(b, h) ((4 + (b) * 2 + (h)) * HTB)
#define PG8_STAGE(bufoff, gbase, voff) do { _Pragma("unroll") for (int _i = 0; _i < 2; ++_i) \
        __builtin_amdgcn_global_load_lds((const unsigned*)((const char*)(gbase) + (voff)[_i]), (PG8_LAS unsigned*)(lds + (bufoff) + ldsw + _i * 8192), 16, 0, 0); } while (0)
#define PG8_LDA(dst, b, h) do { _Pragma("unroll") for (int m = 0; m < 4; ++m) _Pragma("unroll") for (int k = 0; k < 2; ++k) dst[m][k] = *(const PG8_LAS bf16x8*)(lds + PG8_SA(b, h) + aoff + m * 2048 + k * 1024); } while (0)
#define PG8_LDB(dst, b, h) do { _Pragma("unroll") for (int n = 0; n < 2; ++n) _Pragma("unroll") for (int k = 0; k < 2; ++k) dst[n][k] = *(const PG8_LAS bf16x8*)(lds + PG8_SB(b, h) + boff + n * 2048 + k * 1024); } while (0)
#define PG8_MMA(ai, bj, At, Bt) do { __builtin_amdgcn_s_setprio(1); _Pragma("unroll") for (int m = 0; m < 4; ++m) _Pragma("unroll") for (int n = 0; n < 2; ++n) _Pragma("unroll") for (int k = 0; k < 2; ++k) \
        acc[ai][bj][m][n] = __builtin_amdgcn_mfma_f32_16x16x32_bf16(Bt[n][k], At[m][k], acc[ai][bj][m][n], 0, 0, 0); __builtin_amdgcn_s_setprio(0); } while (0)
#define PG8_WAIT_V(n) asm volatile("s_waitcnt vmcnt(" #n ")" ::: "memory")
#define PG8_WAIT_L(n) asm volatile("s_waitcnt lgkmcnt(" #n ")" ::: "memory")
#define PG8_BAR __builtin_amdgcn_s_barrier()
#define PG8_SCHED __builtin_amdgcn_sched_barrier(0)
    Unit cur, nxt; int ui = 0;
    if (!S.next(0, cur)) return;
    f32x4 acc[2][2][4][2];
#pragma unroll
    for (int a = 0; a < 2; ++a)
#pragma unroll
        for (int b = 0; b < 2; ++b)
#pragma unroll
            for (int m = 0; m < 4; ++m)
#pragma unroll
                for (int n = 0; n < 2; ++n) acc[a][b][m][n] = (f32x4){0.f, 0.f, 0.f, 0.f};
    bf16x8 At[4][2], B0[2][2], B1[2][2];
    const char* cA = (const char*)g.A + (size_t)cur.pm * tstepA; const char* cB = (const char*)g.Bt + (size_t)cur.pn * tstepB;
    S.a_ready(cur);
    if constexpr (SP2) {
        PG8_STAGE(PG8_SB(0, 0), cB, voffB); PG8_STAGE(PG8_SB(0, 1), cB + hstepB, voffB); PG8_STAGE(PG8_SA(0, 0), cA, voffA); PG8_STAGE(PG8_SA(0, 1), cA + hstepA, voffA);
        if (wr == 1) PG8_BAR;
        PG8_WAIT_V(2); PG8_BAR;
        PG8_STAGE(PG8_SB(1, 0), cB + kstep, voffB); PG8_STAGE(PG8_SA(1, 0), cA + kstep, voffA); PG8_STAGE(PG8_SB(1, 1), cB + hstepB + kstep, voffB);
        PG8_WAIT_V(6); PG8_BAR;
    } else {
        PG8_STAGE(PG8_SB(0, 0), cB, voffB); PG8_STAGE(PG8_SA(0, 0), cA, voffA); PG8_STAGE(PG8_SB(0, 1), cB + hstepB, voffB); PG8_STAGE(PG8_SA(0, 1), cA + hstepA, voffA);
        if (wr == 1) PG8_BAR;
        PG8_WAIT_V(4); PG8_BAR;
        PG8_STAGE(PG8_SB(1, 0), cB + kstep, voffB); PG8_STAGE(PG8_SA(1, 0), cA + kstep, voffA); PG8_STAGE(PG8_SB(1, 1), cB + hstepB + kstep, voffB);
        PG8_WAIT_V(6); PG8_BAR;
    }
    for (;;) {
        const bool has_next = S.next(ui + 1, nxt);
        const char* nA = has_next ? (const char*)g.A + (size_t)nxt.pm * tstepA : cA; const char* nB = has_next ? (const char*)g.Bt + (size_t)nxt.pn * tstepB : cB;
        for (int t = 0; t < nt; t += 2) {
            const bool last = (t == nt - 2);
            const char* a1 = cA + (size_t)(t + 1) * kstep;
            const char* a2 = last ? nA : cA + (size_t)(t + 2) * kstep; const char* b2 = last ? nB : cB + (size_t)(t + 2) * kstep;
            const char* a3 = a2 + kstep; const char* b3 = b2 + kstep;
            if (last && has_next) S.a_ready(nxt);
            if constexpr (SP2) {
            PG8_LDB(B0, 0, 0); PG8_LDB(B1, 0, 1); PG8_SCHED; PG8_LDA(At, 0, 0); PG8_STAGE(PG8_SA(1, 1), a1 + hstepA, voffA);
            PG8_WAIT_V(8); PG8_WAIT_L(0); PG8_BAR; PG8_MMA(0, 0, At, B0); PG8_MMA(0, 1, At, B1); PG8_BAR; PG8_SCHED;
            PG8_LDA(At, 0, 1); PG8_STAGE(PG8_SB(0, 0), b2, voffB); PG8_STAGE(PG8_SB(0, 1), b2 + hstepB, voffB); PG8_STAGE(PG8_SA(0, 0), a2, voffA);
            PG8_WAIT_V(8); PG8_WAIT_L(0); PG8_BAR; PG8_MMA(1, 0, At, B0); PG8_MMA(1, 1, At, B1); PG8_BAR; PG8_SCHED;
            PG8_LDB(B0, 1, 0); PG8_LDB(B1, 1, 1); PG8_SCHED; PG8_LDA(At, 1, 0); PG8_STAGE(PG8_SA(0, 1), a2 + hstepA, voffA);
            PG8_WAIT_V(8); PG8_WAIT_L(0); PG8_BAR; PG8_MMA(0, 0, At, B0); PG8_MMA(0, 1, At, B1); PG8_BAR; PG8_SCHED;
            PG8_LDA(At, 1, 1); PG8_STAGE(PG8_SB(1, 0), b3, voffB); PG8_STAGE(PG8_SB(1, 1), b3 + hstepB, voffB); PG8_STAGE(PG8_SA(1, 0), a3, voffA);
            PG8_WAIT_V(8); PG8_WAIT_L(0); PG8_BAR; PG8_MMA(1, 0, At, B0); PG8_MMA(1, 1, At, B1); PG8_BAR; PG8_SCHED;
            } else {
            PG8_LDB(B0, 0, 0); PG8_SCHED; PG8_LDA(At, 0, 0); PG8_STAGE(PG8_SA(1, 1), a1 + hstepA, voffA);
            PG8_WAIT_L(8); PG8_BAR; PG8_WAIT_L(0); PG8_MMA(0, 0, At, B0); PG8_BAR; PG8_SCHED;
            PG8_LDB(B1, 0, 1); PG8_STAGE(PG8_SB(0, 0), b2, voffB);
            PG8_BAR; PG8_WAIT_L(0); PG8_MMA(0, 1, At, B1); PG8_BAR;
            PG8_LDA(At, 0, 1); PG8_STAGE(PG8_SA(0, 0), a2, voffA);
            PG8_BAR; PG8_WAIT_L(0); PG8_MMA(1, 0, At, B0); PG8_BAR; PG8_SCHED;
            PG8_STAGE(PG8_SB(0, 1), b2 + hstepB, voffB);
            PG8_WAIT_V(6); PG8_BAR; PG8_MMA(1, 1, At, B1); PG8_BAR;
            PG8_LDB(B0, 1, 0); PG8_SCHED; PG8_LDA(At, 1, 0); PG8_STAGE(PG8_SA(0, 1), a2 + hstepA, voffA);
            PG8_WAIT_L(8); PG8_BAR; PG8_WAIT_L(0); PG8_MMA(0, 0, At, B0); PG8_BAR; PG8_SCHED;
            PG8_LDB(B1, 1, 1); PG8_STAGE(PG8_SB(1, 0), b3, voffB);
            PG8_BAR; PG8_WAIT_L(0); PG8_MMA(0, 1, At, B1); PG8_BAR;
            PG8_LDA(At, 1, 1); PG8_STAGE(PG8_SA(1, 0), a3, voffA);
            PG8_BAR; PG8_WAIT_L(0); PG8_MMA(1, 0, At, B0); PG8_BAR; PG8_SCHED;
            PG8_STAGE(PG8_SB(1, 1), b3 + hstepB, voffB);
            PG8_WAIT_V(6); PG8_BAR; PG8_MMA(1, 1, At, B1); PG8_BAR;
            }
        }
        if constexpr (ALIGN_EPI) { if (wr == 0) PG8_BAR; }
        if constexpr (!Epi::AFTER_DRAIN) { E(acc, cur, wr, wc, fr, fq); S.done(cur); }
        if (!has_next) break;
#pragma unroll
        for (int a = 0; a < 2; ++a)
#pragma unroll
            for (int b = 0; b < 2; ++b)
#pragma unroll
                for (int m = 0; m < 4; ++m)
#pragma unroll
                    for (int n = 0; n < 2; ++n) acc[a][b][m][n] = (f32x4){0.f, 0.f, 0.f, 0.f};
        cur = nxt; cA = nA; cB = nB; ++ui;
        if constexpr (ALIGN_EPI) { if (wr == 1) PG8_BAR; }
    }
    PG8_WAIT_V(0);
    if constexpr (!ALIGN_EPI) { if (wr == 0) PG8_BAR; }
    PG8_BAR;
    if constexpr (Epi::AFTER_DRAIN) { E.fused(acc, cur, wr, wc, fr, fq, lds, wid, lane); S.done(cur); }
#undef PG8_SA
#undef PG8_SB
#undef PG8_STAGE
#undef PG8_LDA
#undef PG8_LDB
#undef PG8_MMA
#undef PG8_WAIT_V
#undef PG8_WAIT_L
#undef PG8_BAR
#undef PG8_SCHED
}
}


#define LAS __attribute__((address_space(3)))
typedef unsigned short bf16_t;
typedef short bf16x8 __attribute__((ext_vector_type(8)));
typedef short s16x4 __attribute__((ext_vector_type(4)));
typedef float f32x4 __attribute__((ext_vector_type(4)));
typedef float f32x16 __attribute__((ext_vector_type(16)));
typedef unsigned u32x4 __attribute__((ext_vector_type(4)));
typedef unsigned u32x2 __attribute__((ext_vector_type(2)));
typedef float f32x2_t __attribute__((ext_vector_type(2)));
typedef __bf16 bf16x2_t __attribute__((ext_vector_type(2)));
typedef short v4i16_t __attribute__((ext_vector_type(4)));

constexpr int NB = 8, T = 4096, M = NB * T, D = 1024, FF = 4096, DEPTH = 2;
constexpr int P_IN = 1842, NZ = 2048, ZP = 2112;
constexpr int Z_CQ = 0, Z_CKV = 256, Z_KR = 384, Z_GATE = 416, Z_NQ = 512, Z_NKV = 896, Z_PU = 1664;
constexpr int QMP = 768, KVP = 768;
constexpr float EPS = 1e-6f;
constexpr float LOG2E = 1.4426950408889634f;
constexpr float NSA_QS = 0.125f * LOG2E;
constexpr float MLA_QS = 0.10206207261596575f * LOG2E;

constexpr size_t MiB = 1u << 20;
constexpr size_t WS_CTL = 0;
constexpr size_t WS_SS = 1 * MiB;
constexpr size_t WS_ROPE = 3 * MiB;
constexpr size_t WS_BIASP = 7 * MiB;
constexpr size_t WS_KCMP = 7 * MiB + 512 * 1024;
constexpr size_t WS_WIN = 10 * MiB, WS_WOUT = 18 * MiB, WS_WFF1 = 22 * MiB, WS_WFF2 = 38 * MiB, WS_WQUP = 54 * MiB, WS_WKVUP = 55 * MiB;
constexpr size_t WS_W1T = 56 * MiB, WS_W2T = 57 * MiB, WS_WPT = 57 * MiB + 512 * 1024;
constexpr size_t WS_XB = 64 * MiB, WS_MIX = 128 * MiB, WS_H = 192 * MiB, WS_Z = 192 * MiB, WS_QM = 324 * MiB, WS_KVM = 372 * MiB, WS_XPART = 448 * MiB, WS_CPART = 458 * MiB, WS_END = 460 * MiB;

constexpr int LDS_BYTES = 147456;

struct Params { const float* in[18]; float* out; unsigned char* ws; };

__device__ __forceinline__ unsigned f2bf(float f) { unsigned u = __builtin_bit_cast(unsigned, f); return (u + 0x7fffu + ((u >> 16) & 1u)) >> 16; }
__device__ __forceinline__ unsigned pk2(float lo, float hi) { f32x2_t v = {lo, hi}; bf16x2_t b = __builtin_convertvector(v, bf16x2_t); return __builtin_bit_cast(unsigned, b); }
__device__ __forceinline__ float bf2f(unsigned short b) { return __builtin_bit_cast(float, (unsigned)b << 16); }
__device__ __forceinline__ float wave_sum(float v) {
#pragma unroll
    for (int o = 1; o < 64; o <<= 1) v += __shfl_xor(v, o);
    return v;
}
__device__ __forceinline__ int crow(int r, int h) { return (r & 3) + 8 * (r >> 2) + 4 * h; }
__device__ __forceinline__ void atomic_addf(float* p, float v) { __hip_atomic_fetch_add(p, v, __ATOMIC_RELAXED, __HIP_MEMORY_SCOPE_AGENT); }
__device__ __forceinline__ float fast_exp2(float x) { return __builtin_amdgcn_exp2f(x); }

__device__ __forceinline__ int tid_() { int t = threadIdx.x; asm volatile("" : "+v"(t)); return t; }
__device__ __forceinline__ int bid_() { int t = blockIdx.x; asm volatile("" : "+s"(t)); return t; }
__device__ __forceinline__ int gdim_() { int t = gridDim.x; asm volatile("" : "+s"(t)); return t; }
#ifndef PROBE_T
#define PROBE_T 0
#endif
#ifndef PROBE_BLK
#define PROBE_BLK 0
#endif
#ifndef PROBE_TID
#define PROBE_TID 0
#endif
#ifndef PROBE_MUL
#define PROBE_MUL 3
#endif
#if PROBE_T
#define PT_LDS ((LAS unsigned char*)0)
#define PT_BEGIN(tag) unsigned long long pt_t0_ = 0; if ((tag) == PROBE_T) { __builtin_amdgcn_sched_barrier(0); pt_t0_ = __builtin_amdgcn_s_memtime(); __builtin_amdgcn_sched_barrier(0); }
#define PT_END(tag) do { if ((tag) == PROBE_T) { __builtin_amdgcn_sched_barrier(0); const unsigned long long pt_t1_ = __builtin_amdgcn_s_memtime(); __builtin_amdgcn_sched_barrier(0); if (bid_() == PROBE_BLK && tid_() == PROBE_TID) { LAS unsigned* pa_ = (LAS unsigned*)(PT_LDS + LDS_BYTES - 32); pa_[0] += (unsigned)(pt_t1_ - pt_t0_); } } } while (0)
#else
#define PT_BEGIN(tag) do {} while (0)
#define PT_END(tag) do {} while (0)
#endif
#define EPI_LOOP_ROWS  _Pragma("unroll") for (int ai = 0; ai < 2; ++ai) _Pragma("unroll") for (int m = 0; m < 4; ++m) if (epi_fence())
__device__ __forceinline__ bool epi_fence() { asm volatile("" ::: "memory"); return true; }
__device__ __forceinline__ float row_sum16(const float* part, int row) {
    const f32x4* p = (const f32x4*)(part + (size_t)row * 16); const f32x4 a = p[0], b = p[1], c = p[2], d = p[3];
    return (((a[0] + a[1]) + (a[2] + a[3])) + ((b[0] + b[1]) + (b[2] + b[3]))) + (((c[0] + c[1]) + (c[2] + c[3])) + ((d[0] + d[1]) + (d[2] + d[3])));
}
__device__ __forceinline__ float row_sum4(const float* part, int row) { const f32x4 a = *(const f32x4*)(part + (size_t)row * 4); return (a[0] + a[1]) + (a[2] + a[3]); }
template <int NPART>
__device__ __forceinline__ LAS float* epi_row_scales(const float* part, int pm, int wr, int wc, int fr, int fq, float inv_n, float mul) {
    LAS float* sc = (LAS float*)(size_t)131072 + (wr * 4 + wc) * 128;
    const int lane = fq * 16 + fr;
#pragma unroll
    for (int a = 0; a < 2; ++a) {
        const int row = pm * 256 + a * 128 + wr * 64 + lane;
        const float sm = (NPART == 16) ? row_sum16(part, row) : row_sum4(part, row);
        sc[a * 64 + lane] = rsqrtf(sm * inv_n + EPS) * mul;
    }
    asm volatile("" ::: "memory");
    return sc;
}
__device__ __forceinline__ void st_bf4(bf16_t* p, f32x4 v) { u32x2 w; w.x = pk2(v[0], v[1]); w.y = pk2(v[2], v[3]); *(u32x2*)p = w; }
__device__ __forceinline__ float dot4(f32x4 v) { return (v[0] * v[0] + v[1] * v[1]) + (v[2] * v[2] + v[3] * v[3]); }

struct EpiInProj {
    static constexpr bool PERM = true, AFTER_DRAIN = false;
    bf16_t* z; const float* ss_x; float* ss_cq; float* ss_ckv; const float* ropec; const float* ropes;
    __device__ __forceinline__ void operator()(const f32x4 (&acc)[2][2][4][2], const pg8::Unit& u, int wr, int wc, int fr, int fq) const {
        const int pn = u.pn;
        LAS float* sc = epi_row_scales<16>(ss_x, u.pm, wr, wc, fr, fq, 1.0f / 1024.0f, 1.0f);
        EPI_LOOP_ROWS {
            const int row = u.pm * 256 + ai * 128 + wr * 64 + m * 16 + fr;
            const float rs = sc[ai * 64 + m * 16 + fr];
            float sq = 0.f;
#pragma unroll
            for (int bj = 0; bj < 2; ++bj) {
                f32x4 v0 = acc[ai][bj][m][0] * rs, v1 = acc[ai][bj][m][1] * rs;
                const int cb = pn * 256 + bj * 128 + wc * 32;
                if (pn == 0 || (pn == 1 && bj == 0)) sq += dot4(v0) + dot4(v1);
                if (pn == 1 && bj == 1 && wc == 0) {
                    const float* cp = ropec + (size_t)row * 16 + 8 * (fq & 1); const float* sp = ropes + (size_t)row * 16 + 8 * (fq & 1);
                    const f32x4 c0 = *(const f32x4*)cp, c1 = *(const f32x4*)(cp + 4), s0 = *(const f32x4*)sp, s1 = *(const f32x4*)(sp + 4);
                    const float sg = (fq < 2) ? -1.f : 1.f;
                    f32x4 p0v, p1v;
#pragma unroll
                    for (int j = 0; j < 4; ++j) { p0v[j] = __shfl_xor(v0[j], 32); p1v[j] = __shfl_xor(v1[j], 32); }
                    v0 = v0 * c0 + p0v * s0 * sg; v1 = v1 * c1 + p1v * s1 * sg;
                }
                if (cb >= Z_NQ && cb < Z_NKV) { v0 = v0 * NSA_QS; v1 = v1 * NSA_QS; }
                u32x4 w; w.x = pk2(v0[0], v0[1]); w.y = pk2(v0[2], v0[3]); w.z = pk2(v1[0], v1[1]); w.w = pk2(v1[2], v1[3]);
                *(u32x4*)(z + (size_t)row * ZP + cb + 8 * fq) = w;
            }
            if (pn <= 1) {
                sq += __shfl_xor(sq, 16); sq += __shfl_xor(sq, 32);
                if (fq == 0) (pn == 0 ? ss_cq : ss_ckv)[(size_t)row * 4 + wc] = sq;
            }
        }
    }
};

struct EpiQup {
    static constexpr bool PERM = true, AFTER_DRAIN = false;
    bf16_t* qm; const float* ss_cq; const float* ropec; const float* ropes;
    __device__ __forceinline__ void operator()(const f32x4 (&acc)[2][2][4][2], const pg8::Unit& u, int wr, int wc, int fr, int fq) const {
        LAS float* sc = epi_row_scales<4>(ss_cq, u.pm, wr, wc, fr, fq, 1.0f / 256.0f, MLA_QS);
        EPI_LOOP_ROWS {
            const int row = u.pm * 256 + ai * 128 + wr * 64 + m * 16 + fr;
            const float rs = sc[ai * 64 + m * 16 + fr];
#pragma unroll
            for (int bj = 0; bj < 2; ++bj) {
                f32x4 v0 = acc[ai][bj][m][0] * rs, v1 = acc[ai][bj][m][1] * rs;
                const int gi = u.pn * 8 + bj * 4 + wc;
                if (gi % 3 == 2) {
                    const float* cp = ropec + (size_t)row * 16 + 8 * (fq & 1); const float* sp = ropes + (size_t)row * 16 + 8 * (fq & 1);
                    const f32x4 c0 = *(const f32x4*)cp, c1 = *(const f32x4*)(cp + 4), s0 = *(const f32x4*)sp, s1 = *(const f32x4*)(sp + 4);
                    const float sg = (fq < 2) ? -1.f : 1.f;
                    f32x4 p0v, p1v;
#pragma unroll
                    for (int j = 0; j < 4; ++j) { p0v[j] = __shfl_xor(v0[j], 32); p1v[j] = __shfl_xor(v1[j], 32); }
                    v0 = v0 * c0 + p0v * s0 * sg; v1 = v1 * c1 + p1v * s1 * sg;
                }
                u32x4 w; w.x = pk2(v0[0], v0[1]); w.y = pk2(v0[2], v0[3]); w.z = pk2(v1[0], v1[1]); w.w = pk2(v1[2], v1[3]);
                *(u32x4*)(qm + (size_t)row * QMP + gi * 32 + 8 * fq) = w;
            }
        }
    }
};

struct EpiKVup {
    static constexpr bool PERM = true, AFTER_DRAIN = false;
    bf16_t* kvm; const float* ss_ckv;
    __device__ __forceinline__ void operator()(const f32x4 (&acc)[2][2][4][2], const pg8::Unit& u, int wr, int wc, int fr, int fq) const {
        LAS float* sc = epi_row_scales<4>(ss_ckv, u.pm, wr, wc, fr, fq, 1.0f / 128.0f, 1.0f);
        EPI_LOOP_ROWS {
            const int row = u.pm * 256 + ai * 128 + wr * 64 + m * 16 + fr;
            const float rs = sc[ai * 64 + m * 16 + fr];
#pragma unroll
            for (int bj = 0; bj < 2; ++bj) {
                const f32x4 v0 = acc[ai][bj][m][0] * rs, v1 = acc[ai][bj][m][1] * rs;
                u32x4 w; w.x = pk2(v0[0], v0[1]); w.y = pk2(v0[2], v0[3]); w.z = pk2(v1[0], v1[1]); w.w = pk2(v1[2], v1[3]);
                *(u32x4*)(kvm + (size_t)row * KVP + u.pn * 256 + bj * 128 + wc * 32 + 8 * fq) = w;
            }
        }
    }
};

struct EpiResid {
    static constexpr bool PERM = true, AFTER_DRAIN = false;
    bf16_t* xb; float* ss;
    __device__ __forceinline__ void operator()(const f32x4 (&acc)[2][2][4][2], const pg8::Unit& u, int wr, int wc, int fr, int fq) const {
        EPI_LOOP_ROWS {
            const int row = u.pm * 256 + ai * 128 + wr * 64 + m * 16 + fr;
            float sq = 0.f;
#pragma unroll
            for (int bj = 0; bj < 2; ++bj) {
                bf16_t* p = xb + (size_t)row * D + u.pn * 256 + bj * 128 + wc * 32 + 8 * fq;
                const u32x4 a = *(const u32x4*)p;
                f32x4 v0, v1;
                v0[0] = __builtin_bit_cast(float, a.x << 16); v0[1] = __builtin_bit_cast(float, a.x & 0xffff0000u); v0[2] = __builtin_bit_cast(float, a.y << 16); v0[3] = __builtin_bit_cast(float, a.y & 0xffff0000u);
                v1[0] = __builtin_bit_cast(float, a.z << 16); v1[1] = __builtin_bit_cast(float, a.z & 0xffff0000u); v1[2] = __builtin_bit_cast(float, a.w << 16); v1[3] = __builtin_bit_cast(float, a.w & 0xffff0000u);
                v0 = v0 + acc[ai][bj][m][0]; v1 = v1 + acc[ai][bj][m][1];
                u32x4 w; w.x = pk2(v0[0], v0[1]); w.y = pk2(v0[2], v0[3]); w.z = pk2(v1[0], v1[1]); w.w = pk2(v1[2], v1[3]);
                *(u32x4*)p = w;
                sq += dot4(v0) + dot4(v1);
            }
            sq += __shfl_xor(sq, 16); sq += __shfl_xor(sq, 32);
            if (fq == 0) ss[(size_t)row * 16 + u.pn * 4 + wc] = sq;
        }
    }
};

struct EpiFF1 {
    static constexpr bool PERM = true, AFTER_DRAIN = false;
    bf16_t* h; const float* ss;
    __device__ __forceinline__ void operator()(const f32x4 (&acc)[2][2][4][2], const pg8::Unit& u, int wr, int wc, int fr, int fq) const {
        LAS float* sc = epi_row_scales<16>(ss, u.pm, wr, wc, fr, fq, 1.0f / 1024.0f, 1.0f);
        EPI_LOOP_ROWS {
            const int row = u.pm * 256 + ai * 128 + wr * 64 + m * 16 + fr;
            const float rs = sc[ai * 64 + m * 16 + fr];
#pragma unroll
            for (int bj = 0; bj < 2; ++bj) {
                f32x4 v0 = acc[ai][bj][m][0] * rs, v1 = acc[ai][bj][m][1] * rs;
#pragma unroll
                for (int j = 0; j < 4; ++j) { const float a = fmaxf(v0[j], 0.f), b = fmaxf(v1[j], 0.f); v0[j] = a * a; v1[j] = b * b; }
                u32x4 w; w.x = pk2(v0[0], v0[1]); w.y = pk2(v0[2], v0[3]); w.z = pk2(v1[0], v1[1]); w.w = pk2(v1[2], v1[3]);
                *(u32x4*)(h + (size_t)row * FF + u.pn * 256 + bj * 128 + wc * 32 + 8 * fq) = w;
            }
        }
    }
};

template <class Epi>
__device__ __forceinline__ void run_gemm(LAS unsigned char* lds, const bf16_t* A, int lda, const bf16_t* Bt, int N, int K, const Epi& E, bool mirror = false) {
    asm volatile("" : "+s"(N), "+s"(K), "+s"(lda));
    const int gd = gdim_(), bi = bid_();
    pg8::Gemm g{A, Bt, M, N, K, lda}; pg8::StaticOrder S; S.init(M, N, gd, mirror ? gd - 1 - bi : bi);
    pg8::gemm_phase<Epi, pg8::StaticOrder, true, true>(lds, g, S, E);
}

__device__ __forceinline__ int colmap(int mode, int n) {
    if (mode == 0) return n;
    if (mode == 1) {
        if (n < 256) return 1170 + n;
        if (n < 384) return 1426 + (n - 256);
        if (n < 416) return 1554 + (n - 384);
        if (n < 434) return 1152 + (n - 416);
        if (n < 512) return -1;
        if (n < 896) return n - 512;
        if (n < 1664) return 384 + (n - 896);
        if (n < 1920) return 1586 + (n - 1664);
        return -1;
    }
    if (mode == 2) {
        if (n < 384) return (n >> 6) * 128 + (n & 63);
        return ((n - 384) >> 6) * 128 + 64 + ((n - 384) & 63);
    }
    return n < 576 ? n : -1;
}
__device__ __forceinline__ void convert_tile(const float* src, int srcPitch, int K, bf16_t* dst, const float* rowscale, int mode, int n0, int k0, LAS float* tile, int tid) {
#pragma unroll
    for (int i = 0; i < 8; ++i) {
        const int kk = (tid >> 6) + 8 * i, nn = tid & 63; const int sc = colmap(mode, n0 + nn);
        float v = 0.f;
        if (sc >= 0) { v = src[(size_t)(k0 + kk) * srcPitch + sc]; if (rowscale) v *= rowscale[k0 + kk]; }
        tile[kk * 65 + nn] = v;
    }
    __syncthreads();
    { const int nn = tid >> 3, kc = (tid & 7) * 8; const LAS float* s = tile + kc * 65 + nn;
      u32x4 o; o.x = pk2(s[0], s[65]); o.y = pk2(s[2 * 65], s[3 * 65]); o.z = pk2(s[4 * 65], s[5 * 65]); o.w = pk2(s[6 * 65], s[7 * 65]);
      *(u32x4*)(dst + (size_t)(n0 + nn) * K + k0 + kc) = o; }
    __syncthreads();
}

__device__ __forceinline__ void prologue(const Params& P, LAS unsigned char* lds) {
    const int tid = tid_(), bid = bid_(), gdim = gdim_(), lane = tid & 63, wave = tid >> 6;
    const int gw = bid * 8 + wave, NGW = gdim * 8;
    unsigned char* ws = P.ws;
    if (bid == 0) { for (int i = tid; i < 2048; i += 512) ((unsigned*)(ws + WS_CTL))[i] = 0u; }
    { const float* x = P.in[0]; bf16_t* xb = (bf16_t*)(ws + WS_XB); float* ss0 = (float*)(ws + WS_XPART);
      for (int r = gw; r < M; r += 2 * NGW) {
          const int r2 = r + NGW;
          const f32x4* xr = (const f32x4*)(x + (size_t)r * D) + lane; const f32x4* xr2 = (const f32x4*)(x + (size_t)(r2 < M ? r2 : r) * D) + lane;
          f32x4 v[4], w[4]; float sa = 0.f, sb = 0.f;
#pragma unroll
          for (int j = 0; j < 4; ++j) { v[j] = xr[64 * j]; w[j] = xr2[64 * j]; }
#pragma unroll
          for (int j = 0; j < 4; ++j) { sa += dot4(v[j]); sb += dot4(w[j]); }
          sa = wave_sum(sa); sb = wave_sum(sb);
          if (lane < 16) ss0[(size_t)r * 16 + lane] = (lane == 0) ? sa : 0.f;
          u32x2* o = (u32x2*)(xb + (size_t)r * D) + lane;
#pragma unroll
          for (int j = 0; j < 4; ++j) { u32x2 t; t.x = pk2(v[j][0], v[j][1]); t.y = pk2(v[j][2], v[j][3]); o[64 * j] = t; }
          if (r2 < M) {
              if (lane < 16) ss0[(size_t)r2 * 16 + lane] = (lane == 0) ? sb : 0.f;
              u32x2* o2 = (u32x2*)(xb + (size_t)r2 * D) + lane;
#pragma unroll
              for (int j = 0; j < 4; ++j) { u32x2 t; t.x = pk2(w[j][0], w[j][1]); t.y = pk2(w[j][2], w[j][3]); o2[64 * j] = t; }
          }
      } }
    { const int* pos = (const int*)P.in[1]; float* rc = (float*)(ws + WS_ROPE); float* rsn = rc + (size_t)M * 16;
      const float INV[16] = {1.0f, 0.5623413324356079f, 0.3162277638912201f, 0.17782793939113617f, 0.10000000149011612f, 0.05623413249850273f, 0.03162277489900589f, 0.017782794311642647f,
                             0.009999999776482582f, 0.005623413249850273f, 0.003162277629598975f, 0.0017782794311642647f, 0.0010000000474974513f, 0.000562341301701963f, 0.0003162277571391314f, 0.00017782794020604342f};
      for (int i = bid * 512 + tid; i < M * 16; i += gdim * 512) {
          const int r = i >> 4, k = i & 15; float inv = INV[0];
#pragma unroll
          for (int q = 1; q < 16; ++q) inv = (k == q) ? INV[q] : inv;
          const float ang = (float)pos[r] * inv;
          double rev = (double)ang * 0.15915494309189535; rev -= floor(rev);
          const float fr = (float)rev;
          rc[i] = __builtin_amdgcn_cosf(fr); rsn[i] = __builtin_amdgcn_sinf(fr);
      } }
    { float* bp = (float*)(ws + WS_BIASP);
      for (int it = gw; it < DEPTH * 2 * 32; it += NGW) {
          const int lk = it >> 5, ch = it & 31; const float* pp = P.in[4] + (size_t)lk * 2048 + ch * 64; const float* w1 = P.in[5] + (size_t)lk * 2048 * 64 + (size_t)ch * 64 * 64;
          float s = 0.f;
          for (int k = 0; k < 64; ++k) s += pp[k] * w1[k * 64 + lane];
          bp[it * 64 + lane] = s;
      } }
    { LAS float* tile = (LAS float*)lds;
      constexpr int C_IN = 32 * 16, C_OUT = 16 * 16, C_F1 = 64 * 16, C_F2 = 16 * 64, C_QU = 12 * 4, C_KV = 12 * 2, C_W1 = 2 * 32, C_W2 = 2, C_WP = 4;
      constexpr int PER_L = C_IN + C_OUT + C_F1 + C_F2 + C_QU + C_KV + C_W1 + C_W2 + C_WP;
      for (int it = bid; it < DEPTH * PER_L; it += gdim) {
          const int l = it / PER_L; int r = it % PER_L;
          if (r < C_IN) { convert_tile(P.in[3] + (size_t)l * D * P_IN, P_IN, D, (bf16_t*)(ws + WS_WIN) + (size_t)l * NZ * D, P.in[2] + l * D, 1, (r >> 4) * 64, (r & 15) * 64, tile, tid); continue; } r -= C_IN;
          if (r < C_OUT) { convert_tile(P.in[13] + (size_t)l * D * D, D, D, (bf16_t*)(ws + WS_WOUT) + (size_t)l * D * D, nullptr, 0, (r >> 4) * 64, (r & 15) * 64, tile, tid); continue; } r -= C_OUT;
          if (r < C_F1) { convert_tile(P.in[15] + (size_t)l * D * FF, FF, D, (bf16_t*)(ws + WS_WFF1) + (size_t)l * FF * D, P.in[14] + l * D, 0, (r >> 4) * 64, (r & 15) * 64, tile, tid); continue; } r -= C_F1;
          if (r < C_F2) { convert_tile(P.in[16] + (size_t)l * FF * D, D, FF, (bf16_t*)(ws + WS_WFF2) + (size_t)l * D * FF, nullptr, 0, (r >> 6) * 64, (r & 63) * 64, tile, tid); continue; } r -= C_F2;
          if (r < C_QU) { convert_tile(P.in[8] + (size_t)l * 256 * 576, 576, 256, (bf16_t*)(ws + WS_WQUP) + (size_t)l * 768 * 256, P.in[7] + l * 256, 3, (r >> 2) * 64, (r & 3) * 64, tile, tid); continue; } r -= C_QU;
          if (r < C_KV) { convert_tile(P.in[10] + (size_t)l * 128 * 768, 768, 128, (bf16_t*)(ws + WS_WKVUP) + (size_t)l * 768 * 128, P.in[9] + l * 128, 2, (r >> 1) * 64, (r & 1) * 64, tile, tid); continue; } r -= C_KV;
          if (r < C_W1) { const int kv = r >> 5, kt = r & 31; convert_tile(P.in[5] + (size_t)(l * 2 + kv) * 2048 * 64, 64, 2048, (bf16_t*)(ws + WS_W1T) + (size_t)(l * 2 + kv) * 64 * 2048, nullptr, 0, 0, kt * 64, tile, tid); continue; } r -= C_W1;
          if (r < C_W2) { convert_tile(P.in[6] + (size_t)(l * 2 + r) * 64 * 64, 64, 64, (bf16_t*)(ws + WS_W2T) + (size_t)(l * 2 + r) * 64 * 64, nullptr, 0, 0, 0, tile, tid); continue; } r -= C_W2;
          convert_tile(P.in[11] + (size_t)(l * 4 + r) * 64 * 64, 64, 64, (bf16_t*)(ws + WS_WPT) + (size_t)(l * 4 + r) * 64 * 64, nullptr, 0, 0, 0, tile, tid);
      } }
}

#define MFMA16(a, b, c) __builtin_amdgcn_mfma_f32_16x16x32_bf16((a), (b), (c), 0, 0, 0)
#define MFMA32(a, b, c) __builtin_amdgcn_mfma_f32_32x32x16_bf16((a), (b), (c), 0, 0, 0)

__device__ __forceinline__ float gelu_tanh(float x) {
    const float u = 0.7978845608028654f * (x + 0.044715f * x * x * x);
    const float e = __expf(2.f * u);
    const float th = 1.f - 2.f / (e + 1.f);
    return 0.5f * x * (1.f + th);
}

__device__ __forceinline__ void compress_phase(const Params& P, int layer, LAS unsigned char* lds) {
    const int tid = tid_(), bid = bid_(), gdim = gdim_(), lane = tid & 63, wave = tid >> 6, sub = wave >> 2, et = wave & 3;
    const int l16 = lane & 15, quad = lane >> 4;
    unsigned char* ws = P.ws;
    const bf16_t* z = (const bf16_t*)(ws + WS_Z);
    bf16_t* kc = (bf16_t*)(ws + WS_KCMP);
    const float* bp = (const float*)(ws + WS_BIASP);
    LAS bf16_t* hb = (LAS bf16_t*)lds + sub * (16 * 72);
    for (int bi = bid; bi < 256; bi += gdim) {
        const int id = bi * 2 + sub, kv = id >> 8, rest = id & 255, b = rest >> 5, g = (rest >> 4) & 1, n0 = (rest & 15) * 16;
        const bf16_t* w1t = (const bf16_t*)(ws + WS_W1T) + ((size_t)(layer * 2 + kv) * 64 + 16 * et + l16) * 2048 + 8 * quad;
        const bf16_t* w2t = (const bf16_t*)(ws + WS_W2T) + ((size_t)(layer * 2 + kv) * 64 + 16 * et + l16) * 64 + 8 * quad;
        const int n = n0 + l16;
        const bf16_t* zc = z + Z_NKV + (kv * 2 + g) * 64 + 8 * quad;
        f32x4 acc = {0.f, 0.f, 0.f, 0.f};
#pragma unroll 4
        for (int l = 0; l < 32; ++l) {
            int tok = 16 * n + l; tok = tok > T - 1 ? T - 1 : tok;
            const bf16_t* ar = zc + (size_t)(b * T + tok) * ZP;
#pragma unroll
            for (int dh = 0; dh < 2; ++dh) {
                const bf16x8 a = *(const bf16x8*)(ar + 32 * dh);
                const bf16x8 bb = *(const bf16x8*)(w1t + l * 64 + 32 * dh);
                acc = MFMA16(a, bb, acc);
            }
        }
        float bsum = 0.f;
        for (int ch = 0; ch < 32; ++ch) bsum += bp[((size_t)(layer * 2 + kv) * 32 + ch) * 64 + 16 * et + l16];
#pragma unroll
        for (int j = 0; j < 4; ++j) hb[(4 * quad + j) * 72 + 16 * et + l16] = (bf16_t)f2bf(gelu_tanh(acc[j] + bsum));
        __syncthreads();
        f32x4 acc2 = {0.f, 0.f, 0.f, 0.f};
#pragma unroll
        for (int ks = 0; ks < 2; ++ks) {
            const bf16x8 a = *(const LAS bf16x8*)(hb + l16 * 72 + 32 * ks + 8 * quad);
            const bf16x8 bb = *(const bf16x8*)(w2t + 32 * ks);
            acc2 = MFMA16(a, bb, acc2);
        }
#pragma unroll
        for (int j = 0; j < 4; ++j) {
            const int nr = n0 + 4 * quad + j;
            kc[((size_t)((kv * NB + b) * 2 + g) * 256 + nr) * 64 + 16 * et + l16] = (bf16_t)(nr < 255 ? f2bf(acc2[j]) : 0u);
        }
        __syncthreads();
    }
}

__device__ __forceinline__ void pool_phase(const Params& P, int layer) {
    const int tid = tid_(), bid = bid_(), gdim = gdim_(), lane = tid & 63, wave = tid >> 6, l16 = lane & 15, quad = lane >> 4;
    unsigned char* ws = P.ws;
    const bf16_t* z = (const bf16_t*)(ws + WS_Z);
    bf16_t* mix = (bf16_t*)(ws + WS_MIX);
    const float* psc = P.in[12] + layer * 256;
    for (int wi = bid * 8 + wave; wi < (M / 16) * 4; wi += gdim * 8) {
        const int tt = wi >> 2, gi = wi & 3, w = 2 << gi;
        const int row = tt * 16 + l16, t = row & (T - 1);
        const int cnt = (t + 1 < w) ? t + 1 : w; const float icnt = 1.0f / (float)cnt;
        const bf16_t* wpt = (const bf16_t*)(ws + WS_WPT) + ((size_t)(layer * 4 + gi) * 64 + l16) * 64 + 8 * quad;
        f32x4 acc[4];
#pragma unroll
        for (int dt = 0; dt < 4; ++dt) acc[dt] = (f32x4){0.f, 0.f, 0.f, 0.f};
#pragma unroll
        for (int ks = 0; ks < 2; ++ks) {
            const bf16_t* ur = z + (size_t)row * ZP + Z_PU + gi * 64 + 32 * ks + 8 * quad;
            float s[8];
#pragma unroll
            for (int j = 0; j < 8; ++j) s[j] = 0.f;
            for (int i = 0; i < w; ++i) {
                if (i < cnt) {
                    const bf16x8 v = *(const bf16x8*)(ur - (size_t)i * ZP);
#pragma unroll
                    for (int j = 0; j < 8; ++j) s[j] += bf2f((unsigned short)v[j]);
                }
            }
            const bf16x8 u0 = *(const bf16x8*)ur;
            u32x4 pa;
            pa.x = pk2(s[0] * icnt - bf2f((unsigned short)u0[0]), s[1] * icnt - bf2f((unsigned short)u0[1]));
            pa.y = pk2(s[2] * icnt - bf2f((unsigned short)u0[2]), s[3] * icnt - bf2f((unsigned short)u0[3]));
            pa.z = pk2(s[4] * icnt - bf2f((unsigned short)u0[4]), s[5] * icnt - bf2f((unsigned short)u0[5]));
            pa.w = pk2(s[6] * icnt - bf2f((unsigned short)u0[6]), s[7] * icnt - bf2f((unsigned short)u0[7]));
            const bf16x8 a = __builtin_bit_cast(bf16x8, pa);
#pragma unroll
            for (int dt = 0; dt < 4; ++dt) {
                const bf16x8 bb = *(const bf16x8*)(wpt + (size_t)dt * 16 * 64 + 32 * ks);
                acc[dt] = MFMA16(a, bb, acc[dt]);
            }
        }
#pragma unroll
        for (int dt = 0; dt < 4; ++dt) {
            const float sc = psc[gi * 64 + 16 * dt + l16];
#pragma unroll
            for (int j = 0; j < 4; ++j) mix[(size_t)(tt * 16 + 4 * quad + j) * D + 768 + gi * 64 + 16 * dt + l16] = (bf16_t)f2bf(acc[dt][j] * sc);
        }
    }
}

#ifndef SLC_ELEM_MASK
#define SLC_ELEM_MASK 0
#endif
#ifndef USE_NEGM
#define USE_NEGM 1
#endif
#ifndef KPREF
#define KPREF 1
#endif
#ifndef STAGGER
#define STAGGER 0
#endif
constexpr int AG = 4, NSA_G = 2;
constexpr int AL_WSF = 0, AL_BC = 2048, AL_T0 = 2304, AL_VSZ = 9216;
constexpr int AL_IMP = AL_T0 + AG * 2 * 9216, AL_SCORE = AL_IMP + 6 * 8192, AL_SEL = AL_SCORE + 16384;
static_assert(AL_SEL + 512 <= LDS_BYTES - 64 && AL_T0 + AG * (13312 + 9216) <= LDS_BYTES - 64, "attention LDS map");
constexpr int VPB = 144;

__device__ __forceinline__ s16x4 vtr(const LAS unsigned char* p) { return __builtin_bit_cast(s16x4, __builtin_amdgcn_ds_read_tr16_b64_v4i16((LAS v4i16_t*)p)); }

template <int NDC, int KPB>
__device__ __forceinline__ void qk_tile(f32x16& p0, f32x16& p1, const LAS unsigned char* Kt, const bf16x8* qf, const f32x16& cinit, int r, int h) {
    const LAS unsigned char* kb = Kt + r * KPB + h * 16;
    bf16x8 ka[NDC], kc[NDC];
#pragma unroll
    for (int c = 0; c < NDC; ++c) { ka[c] = *(const LAS bf16x8*)(kb + c * 32); kc[c] = *(const LAS bf16x8*)(kb + 32 * KPB + c * 32); }
    if constexpr (NDC == 4) asm volatile("" : "+v"(ka[0]), "+v"(ka[1]), "+v"(ka[2]), "+v"(ka[3]), "+v"(kc[0]), "+v"(kc[1]), "+v"(kc[2]), "+v"(kc[3]));
    else asm volatile("" : "+v"(ka[0]), "+v"(ka[1]), "+v"(ka[2]), "+v"(ka[3]), "+v"(ka[4]), "+v"(ka[5]), "+v"(kc[0]), "+v"(kc[1]), "+v"(kc[2]), "+v"(kc[3]), "+v"(kc[4]), "+v"(kc[5]));
    p0 = MFMA32(ka[0], qf[0], cinit); p1 = MFMA32(kc[0], qf[0], cinit);
#pragma unroll
    for (int c = 1; c < NDC; ++c) { p0 = MFMA32(ka[c], qf[c], p0); p1 = MFMA32(kc[c], qf[c], p1); }
}

template <int NDC, int KPB>
__device__ __forceinline__ void k_load(bf16x8 (&kf)[2 * NDC], const LAS unsigned char* Kt, int r, int h) {
    const LAS unsigned char* kb = Kt + r * KPB + h * 16;
#pragma unroll
    for (int c = 0; c < NDC; ++c) { kf[2 * c] = *(const LAS bf16x8*)(kb + c * 32); kf[2 * c + 1] = *(const LAS bf16x8*)(kb + 32 * KPB + c * 32); }
}
template <int NDC>
__device__ __forceinline__ void qk_mma(f32x16& p0, f32x16& p1, bf16x8 (&kf)[2 * NDC], const bf16x8* qf, const f32x16& cinit) {
    if constexpr (NDC == 4) asm volatile("" : "+v"(kf[0]), "+v"(kf[1]), "+v"(kf[2]), "+v"(kf[3]), "+v"(kf[4]), "+v"(kf[5]), "+v"(kf[6]), "+v"(kf[7]));
    else asm volatile("" : "+v"(kf[0]), "+v"(kf[1]), "+v"(kf[2]), "+v"(kf[3]), "+v"(kf[4]), "+v"(kf[5]), "+v"(kf[6]), "+v"(kf[7]), "+v"(kf[8]), "+v"(kf[9]), "+v"(kf[10]), "+v"(kf[11]));
    __builtin_amdgcn_s_setprio(1);
    p0 = MFMA32(kf[0], qf[0], cinit); p1 = MFMA32(kf[1], qf[0], cinit);
#pragma unroll
    for (int c = 1; c < NDC; ++c) { p0 = MFMA32(kf[2 * c], qf[c], p0); p1 = MFMA32(kf[2 * c + 1], qf[c], p1); }
    __builtin_amdgcn_s_setprio(0);
}
__device__ __forceinline__ bf16x8 pack8(const f32x16& p, int s, unsigned pmask) {
    u32x4 w; w.x = pk2(p[8 * s], p[8 * s + 1]) & pmask; w.y = pk2(p[8 * s + 2], p[8 * s + 3]) & pmask; w.z = pk2(p[8 * s + 4], p[8 * s + 5]) & pmask; w.w = pk2(p[8 * s + 6], p[8 * s + 7]) & pmask;
    return __builtin_bit_cast(bf16x8, w);
}

__device__ __forceinline__ void pv_load(s16x4 (&vf)[16], const LAS unsigned char* Vt, int lane) {
    const int i16 = lane & 15, q4 = i16 >> 2, p4 = i16 & 3, blk = (lane >> 4) & 1, h = lane >> 5;
    const LAS unsigned char* vb = Vt + (4 * h + q4) * VPB + blk * 32 + p4 * 8;
#pragma unroll
    for (int ks = 0; ks < 4; ++ks) {
        vf[4 * ks + 0] = vtr(vb + (16 * ks) * VPB); vf[4 * ks + 1] = vtr(vb + (16 * ks + 8) * VPB);
        vf[4 * ks + 2] = vtr(vb + (16 * ks) * VPB + 64); vf[4 * ks + 3] = vtr(vb + (16 * ks + 8) * VPB + 64);
    }
}
__device__ __forceinline__ void pv_pin(s16x4 (&vf)[16], f32x16& p0, f32x16& p1) {
    asm volatile("s_nop 15\n\ts_nop 7" : "+v"(p0), "+v"(p1));
    asm volatile("" : "+v"(vf[0]), "+v"(vf[1]), "+v"(vf[2]), "+v"(vf[3]), "+v"(vf[4]), "+v"(vf[5]), "+v"(vf[6]), "+v"(vf[7]),
                      "+v"(vf[8]), "+v"(vf[9]), "+v"(vf[10]), "+v"(vf[11]), "+v"(vf[12]), "+v"(vf[13]), "+v"(vf[14]), "+v"(vf[15]));
}
template <bool MASKED>
__device__ __forceinline__ void pv_mma(f32x16& o0, f32x16& o1, const f32x16& p0, const f32x16& p1, const s16x4 (&vf)[16], unsigned pmask) {
#pragma unroll
    for (int ks = 0; ks < 4; ++ks) {
        const bf16x8 pa = (ks < 2) ? pack8(p0, ks & 1, MASKED ? pmask : 0xffffffffu) : pack8(p1, ks & 1, MASKED ? pmask : 0xffffffffu);
        const bf16x8 v0 = __builtin_shufflevector(vf[4 * ks + 0], vf[4 * ks + 1], 0, 1, 2, 3, 4, 5, 6, 7);
        const bf16x8 v1 = __builtin_shufflevector(vf[4 * ks + 2], vf[4 * ks + 3], 0, 1, 2, 3, 4, 5, 6, 7);
        __builtin_amdgcn_s_setprio(1);
        o0 = MFMA32(pa, v0, o0);
        o1 = MFMA32(pa, v1, o1);
        __builtin_amdgcn_s_setprio(0);
    }
}

__device__ __forceinline__ float max3f(float a, float b, float c) { float r; asm("v_max3_f32 %0, %1, %2, %3" : "=v"(r) : "v"(a), "v"(b), "v"(c)); return r; }
__device__ __forceinline__ float tile_rowmax(const f32x16& p0, const f32x16& p1) {
    float a = max3f(p0[0], p0[1], p1[0]), b = max3f(p0[2], p0[3], p1[1]); a = max3f(a, p1[2], p1[3]);
#pragma unroll
    for (int i = 4; i < 16; i += 4) { a = max3f(a, p0[i], p0[i + 1]); b = max3f(b, p0[i + 2], p0[i + 3]); a = max3f(a, p1[i], p1[i + 1]); b = max3f(b, p1[i + 2], p1[i + 3]); }
    float m; asm("v_max_f32_e32 %0, %1, %2" : "=v"(m) : "v"(a), "v"(b));
    const auto rr = __builtin_amdgcn_permlane32_swap(__float_as_uint(m), __float_as_uint(m), false, false);
    float res; asm("v_max_f32_e32 %0, %1, %2" : "=v"(res) : "v"(__uint_as_float(rr[0])), "v"(__uint_as_float(rr[1])));
    return res;
}

template <bool IMPR>
__device__ __forceinline__ void softmax_step(f32x16& p0, f32x16& p1, bool lane_on, float& mref, f32x16& negm, float& l, f32x16& o0, f32x16& o1, LAS float* wsf, int r, int h, LAS float* impw) {
    float rm = tile_rowmax(p0, p1);
    rm = lane_on ? rm : -INFINITY;
    if (__any(rm > 6.0f)) {
        const float dl = fmaxf(rm, 0.f);
        mref += dl;
        const float alpha = fast_exp2(-dl);
        l *= alpha;
        if (h == 0) wsf[r] = alpha;
        asm volatile("" ::: "memory");
#pragma unroll
        for (int i = 0; i < 16; ++i) { const float a = wsf[crow(i, h)]; o0[i] *= a; o1[i] *= a; p0[i] -= dl; p1[i] -= dl; negm[i] = -mref; }
        if (IMPR) {
            asm volatile("" ::: "memory");
#pragma unroll 8
            for (int j = 0; j < 32; ++j) impw[r * 64 + 2 * j + h] *= alpha;
            asm volatile("" ::: "memory");
        }
    }
    float s0 = 0.f, s1 = 0.f, s2 = 0.f, s3 = 0.f;
#pragma unroll
    for (int i = 0; i < 16; i += 2) { p0[i] = fast_exp2(p0[i]); p1[i] = fast_exp2(p1[i]); p0[i + 1] = fast_exp2(p0[i + 1]); p1[i + 1] = fast_exp2(p1[i + 1]); s0 += p0[i]; s1 += p1[i]; s2 += p0[i + 1]; s3 += p1[i + 1]; }
    l += lane_on ? ((s0 + s1) + (s2 + s3)) : 0.f;
}

enum { MODE_MLA = 0, MODE_WIN = 1, MODE_SLC = 2, MODE_CMP1 = 3, MODE_CMP2 = 4 };

template <int MODE>
__device__ __forceinline__ void attn_tile(bf16x8 (&kpre)[(MODE == MODE_MLA) ? 12 : 8], bool have_pre, const LAS unsigned char* Knext, const LAS unsigned char* Kt, const LAS unsigned char* Vt, int t, int ti, const bf16x8* qf, int qpos, int cblk, unsigned long long sel,
                                          float& mref, f32x16& negm, float& l, f32x16& o0, f32x16& o1, float pscale, float pgate, LAS float* impw, LAS float* wsf, int lane) {
    constexpr int KPB = (MODE == MODE_MLA) ? 208 : 144;
    constexpr int NDC = (MODE == MODE_MLA) ? 6 : 4;
    const int r = lane & 31, h = lane >> 5;
    bool on = true;
    if (MODE == MODE_SLC) { on = (sel >> t) & 1ull; if (!__any((int)on)) return; }
    f32x16 p0, p1;
    PT_BEGIN(11);
    if (!have_pre) k_load<NDC, KPB>(kpre, Kt, r, h);
    if (MODE == MODE_CMP1) { f32x16 zz; for (int i = 0; i < 16; ++i) zz[i] = 0.f; qk_mma<NDC>(p0, p1, kpre, qf, zz); }
    else qk_mma<NDC>(p0, p1, kpre, qf, negm);
    if (Knext) k_load<NDC, KPB>(kpre, Knext, r, h);
    s16x4 vf[16];
    if (MODE != MODE_CMP1) pv_load(vf, Vt, lane);
    pv_pin(vf, p0, p1);
    const int kb = 64 * t + 4 * h;
    if (MODE == MODE_MLA) {
        if (64 * t + 63 > (qpos - r)) {
#pragma unroll
            for (int i = 0; i < 16; ++i) { const int kv = kb + (i & 3) + 8 * (i >> 2); if (kv > qpos) p0[i] = -INFINITY; if (kv + 32 > qpos) p1[i] = -INFINITY; }
        }
    } else if (MODE == MODE_WIN) {
        if (t == cblk || t == cblk - 8) {
#pragma unroll
            for (int i = 0; i < 16; ++i) { const int kv = kb + (i & 3) + 8 * (i >> 2);
                if (kv > qpos || kv <= qpos - 512) p0[i] = -INFINITY; if (kv + 32 > qpos || kv + 32 <= qpos - 512) p1[i] = -INFINITY; }
        }
    } else if (MODE == MODE_SLC) {
#if SLC_ELEM_MASK
        if (t == cblk || !__all((int)on)) {
#pragma unroll
            for (int i = 0; i < 16; ++i) { const int kv = kb + (i & 3) + 8 * (i >> 2); if (!on || kv > qpos) p0[i] = -INFINITY; if (!on || kv + 32 > qpos) p1[i] = -INFINITY; }
        }
        on = true;
#else
        if (t == cblk) {
#pragma unroll
            for (int i = 0; i < 16; ++i) { const int kv = kb + (i & 3) + 8 * (i >> 2); if (kv > qpos) p0[i] = -INFINITY; if (kv + 32 > qpos) p1[i] = -INFINITY; }
        }
#endif
    } else {
#pragma unroll
        for (int i = 0; i < 16; ++i) { const int kv = kb + (i & 3) + 8 * (i >> 2);
            if (16 * kv + 31 > qpos) p0[i] = -INFINITY; if (16 * (kv + 32) + 31 > qpos) p1[i] = -INFINITY; }
    }
    PT_END(11);
    if (MODE == MODE_CMP1) {
        const float rm = tile_rowmax(p0, p1);
        const float mnew = fmaxf(mref, rm);
        const float ms = (mnew == -INFINITY) ? 0.f : mnew;
        const float alpha = (mnew == -INFINITY) ? 1.f : fast_exp2(mref - mnew);
        float sm = 0.f;
#pragma unroll
        for (int i = 0; i < 16; ++i) sm += fast_exp2(p0[i] - ms) + fast_exp2(p1[i] - ms);
        l = l * alpha + sm; mref = mnew;
    } else if (MODE == MODE_CMP2) {
        softmax_step<true>(p0, p1, true, mref, negm, l, o0, o1, wsf, r, h, impw);
        LAS float* iw = impw + r * 64 + 16 * ti + h;
#pragma unroll
        for (int k = 0; k < 4; ++k) { iw[2 * k] += (p0[4 * k] + p0[4 * k + 1]) + (p0[4 * k + 2] + 0.5f * p0[4 * k + 3]); iw[8 + 2 * k] += (p1[4 * k] + p1[4 * k + 1]) + (p1[4 * k + 2] + 0.5f * p1[4 * k + 3]); }
        asm volatile("" ::: "memory");
#pragma unroll
        for (int k = 0; k < 4; ++k) { iw[2 * k + 1] += 0.5f * p0[4 * k + 3]; if (16 * ti + h + 8 + 2 * k + 1 < 64) iw[8 + 2 * k + 1] += 0.5f * p1[4 * k + 3]; }
        asm volatile("" ::: "memory");
        pv_mma<false>(o0, o1, p0, p1, vf, 0xffffffffu);
    } else {
        { PT_BEGIN(12);
        softmax_step<false>(p0, p1, on, mref, negm, l, o0, o1, wsf, r, h, impw);
        PT_END(12); }
        { PT_BEGIN(13);
        pv_mma<MODE == MODE_SLC>(o0, o1, p0, p1, vf, on ? 0xffffffffu : 0u);
        PT_END(13); }
    }
}

template <int MODE, int G>
__device__ __forceinline__ void attn_branch(LAS unsigned char* L, const bf16_t* kS, int kP, const bf16_t* vS, int vP, const bf16_t* rS, int rP,
                                            int t0, int t1, bool preloaded, const bf16x8* qf, int qpos, bool active, int wlo, int whi, int cblk, unsigned long long sel,
                                            float& mref, f32x16& negm, float& l, f32x16& o0, f32x16& o1, float pscale, float pgate, LAS float* impw, LAS float* wsf, int tid) {
    constexpr int KPB = (MODE == MODE_MLA) ? 208 : 144;
    constexpr int KSZ = 64 * KPB;
    constexpr bool DB = (2 * G <= AG);
    const int lane = tid & 63;
    const int srow = tid >> 3, sch = tid & 7;
    const int nsteps = (t1 - t0 + G - 1) / G;
    u32x4 kreg[G], vreg[G], rreg[G];
    bf16x8 kpre[(MODE == MODE_MLA) ? 12 : 8];
#define AB_LOAD(s_) do { _Pragma("unroll") for (int j_ = 0; j_ < G; ++j_) { const int t_ = t0 + (s_) * G + j_; if (t_ < t1) { \
        const size_t row_ = (size_t)t_ * 64 + srow; kreg[j_] = *(const u32x4*)(kS + row_ * kP + sch * 8); vreg[j_] = *(const u32x4*)(vS + row_ * vP + sch * 8); \
        if (MODE == MODE_MLA) { if (tid < 256) rreg[j_] = *(const u32x4*)(rS + ((size_t)t_ * 64 + (tid >> 2)) * rP + (tid & 3) * 8); } } } } while (0)
#define AB_STORE(s_) do { _Pragma("unroll") for (int j_ = 0; j_ < G; ++j_) { const int t_ = t0 + (s_) * G + j_; if (t_ < t1) { const int jj_ = (DB ? ((s_) & 1) * G : 0) + j_; \
        *(LAS u32x4*)(L + AL_T0 + jj_ * KSZ + srow * KPB + sch * 16) = kreg[j_]; *(LAS u32x4*)(L + AL_T0 + AG * KSZ + jj_ * AL_VSZ + srow * VPB + sch * 16) = vreg[j_]; \
        if (MODE == MODE_MLA) { if (tid < 256) *(LAS u32x4*)(L + AL_T0 + jj_ * KSZ + (tid >> 2) * KPB + 128 + (tid & 3) * 16) = rreg[j_]; } } } } while (0)
    if (!preloaded && nsteps > 0) { AB_LOAD(0); AB_STORE(0); }
    __syncthreads();
    for (int s = 0; s < nsteps; ++s) {
        if (s + 1 < nsteps) AB_LOAD(s + 1);
        PT_BEGIN(7);
        if (STAGGER && (tid >> 8)) __builtin_amdgcn_s_sleep(STAGGER);
        bool have_pre = false;
        const int jb = DB ? (s & 1) * G : 0;
#pragma unroll
        for (int j = 0; j < G; ++j) {
            const int t = t0 + s * G + j;
            const bool run = active && t < t1 && t >= wlo && t <= whi && (MODE != MODE_SLC || __any((int)((sel >> t) & 1ull)));
            const int tn = t + 1;
            const bool runn = KPREF && (j + 1 < G) && active && tn < t1 && tn >= wlo && tn <= whi && (MODE != MODE_SLC || __any((int)((sel >> tn) & 1ull)));
            if (run)
                attn_tile<MODE>(kpre, have_pre, runn ? (const LAS unsigned char*)(L + AL_T0 + (jb + j + 1) * KSZ) : (const LAS unsigned char*)nullptr, L + AL_T0 + (jb + j) * KSZ, L + AL_T0 + AG * KSZ + (jb + j) * AL_VSZ, t, t - t0, qf, qpos, cblk, sel, mref, negm, l, o0, o1, pscale, pgate, impw, wsf, lane);
            have_pre = run && runn;
        }
        PT_END(7);
        if (DB) {
            if (s + 1 < nsteps) AB_STORE(s + 1);
            __syncthreads();
        } else {
            __syncthreads();
            if (s + 1 < nsteps) { AB_STORE(s + 1); __syncthreads(); }
        }
    }
#undef AB_LOAD
#undef AB_STORE
}

__device__ __forceinline__ void branch_finish(f32x16& out0, f32x16& out1, const f32x16& o0, const f32x16& o1, float l, float gate, LAS float* wsf, int r, int h) {
    const float lt = l + __shfl_xor(l, 32);
    const float f = lt > 0.f ? gate / lt : 0.f;
    if (h == 0) wsf[r] = f;
    asm volatile("" ::: "memory");
#pragma unroll
    for (int i = 0; i < 16; ++i) { const float a = wsf[crow(i, h)]; out0[i] += o0[i] * a; out1[i] += o1[i] * a; }
    asm volatile("" ::: "memory");
}

__device__ __forceinline__ void branch_finish_lds(LAS float* obuf, bool active, const f32x16& o0, const f32x16& o1, float l, float gate, LAS float* wsf, int r, int h) {
    const float lt = l + __shfl_xor(l, 32);
    const float f = lt > 0.f ? gate / lt : 0.f;
    if (h == 0) wsf[r] = f;
    asm volatile("" ::: "memory");
    if (active) {
#pragma unroll
        for (int i = 0; i < 16; ++i) { const int qq = crow(i, h); const float a = wsf[qq]; obuf[qq * 64] += o0[i] * a; obuf[qq * 64 + 32] += o1[i] * a; }
    }
    asm volatile("" ::: "memory");
}
__device__ __forceinline__ float sigmoidf_(float x) { return 1.f / (1.f + __expf(-x)); }

__device__ __forceinline__ void nsa_unit(const Params& P, LAS unsigned char* L, int b, int g, int c) {
    const int tid = tid_(), lane = tid & 63, wave = __builtin_amdgcn_readfirstlane(tid >> 6), r = lane & 31, h = lane >> 5;
    unsigned char* ws = P.ws;
    const bf16_t* z = (const bf16_t*)(ws + WS_Z);
    const bf16_t* kcmp = (const bf16_t*)(ws + WS_KCMP);
    bf16_t* mix = (bf16_t*)(ws + WS_MIX);
    const bool active = wave < 6;
    const int hh = active ? (wave >> 1) : 0, qh = wave & 1, head = 3 * g + hh;
    const int q0 = 64 * c, qpos = q0 + 32 * qh + r;
    const size_t qrow = (size_t)b * T + qpos;
    LAS float* wsf = (LAS float*)(L + AL_WSF) + wave * 64;
    LAS float* impw = (LAS float*)(L + AL_IMP) + (active ? wave : 0) * 2048;
    bf16x8 qf[4];
#pragma unroll
    for (int cc = 0; cc < 4; ++cc) qf[cc] = *(const bf16x8*)(z + qrow * ZP + Z_NQ + head * 64 + 16 * cc + 8 * h);
    const bf16_t* gp = z + qrow * ZP + Z_GATE + head * 3;
    const float g_cmp = sigmoidf_(bf2f(gp[0])), g_slc = sigmoidf_(bf2f(gp[1])), g_win = sigmoidf_(bf2f(gp[2]));
    f32x16 out0, out1, o0, o1, negm;
#pragma unroll
    for (int i = 0; i < 16; ++i) { out0[i] = 0.f; out1[i] = 0.f; o0[i] = 0.f; o1[i] = 0.f; negm[i] = 0.f; }
    const int ntc = (4 * c + 3 + 63) >> 6;
    const bf16_t* kc = kcmp + (size_t)((0 * NB + b) * 2 + g) * 256 * 64;
    const bf16_t* vc = kcmp + (size_t)((1 * NB + b) * 2 + g) * 256 * 64;
    float m1 = 0.f, l1 = 0.f;
    PT_BEGIN(3);
    if (active) { for (int i = lane; i < 2048; i += 64) impw[i] = 0.f; }
    attn_branch<MODE_CMP2, AG>(L, kc, 64, vc, 64, nullptr, 0, 0, ntc, false, qf, qpos, active, 0, ntc, c, 0ull, m1, negm, l1, o0, o1, 0.f, 0.f, impw, wsf, tid);
    { const float lt = l1 + __shfl_xor(l1, 32); const float inv = lt > 0.f ? 1.f / lt : 0.f;
      if (h == 0) wsf[32 + r] = inv;
      branch_finish(out0, out1, o0, o1, l1, g_cmp, wsf, r, h); }
    __syncthreads();
    PT_END(3);
    {
        PT_BEGIN(4);
        LAS float* imp = (LAS float*)(L + AL_IMP); LAS float* sc = (LAS float*)(L + AL_SCORE); LAS unsigned long long* selL = (LAS unsigned long long*)(L + AL_SEL);
        const int q = tid >> 3, part = tid & 7;
        float my[8];
#pragma unroll
        for (int j = 0; j < 8; ++j) { const int s = part * 8 + j; const int o = (q >> 5) * 2048 + (q & 31) * 64 + s;
            const LAS float* wl = (const LAS float*)(L + AL_WSF) + (q >> 5) * 64 + 32 + (q & 31);
            const float v = (imp[o] * wl[0] + imp[o + 2 * 2048] * wl[2 * 64]) + imp[o + 4 * 2048] * wl[4 * 64];
            my[j] = (s > c) ? -1.f : ((s == 0 || s == c || s == c - 1) ? 1.0e4f : v);
            sc[q * 64 + s] = my[j]; }
        __syncthreads();
        int rank[8];
#pragma unroll
        for (int j = 0; j < 8; ++j) rank[j] = 0;
        if (c >= 16) {
            for (int s2 = 0; s2 <= c; ++s2) { const float v = sc[q * 64 + s2];
#pragma unroll
                for (int j = 0; j < 8; ++j) rank[j] += (v > my[j] || (v == my[j] && s2 < part * 8 + j)) ? 1 : 0; }
        }
        unsigned bits = 0;
#pragma unroll
        for (int j = 0; j < 8; ++j) if (part * 8 + j <= c && rank[j] < 16) bits |= 1u << j;
        unsigned lo = (part < 4) ? (bits << (8 * part)) : 0u, hi = (part >= 4) ? (bits << (8 * (part - 4))) : 0u;
        lo |= __shfl_xor(lo, 1); hi |= __shfl_xor(hi, 1); lo |= __shfl_xor(lo, 2); hi |= __shfl_xor(hi, 2); lo |= __shfl_xor(lo, 4); hi |= __shfl_xor(hi, 4);
        if (part == 0) selL[q] = ((unsigned long long)hi << 32) | lo;
        __syncthreads();
        PT_END(4);
    }
    const unsigned long long sel = ((LAS unsigned long long*)(L + AL_SEL))[32 * qh + r];
    LAS float* obuf = impw + r;
    if (active) {
#pragma unroll
        for (int i = 0; i < 16; ++i) { obuf[crow(i, h) * 64] = out0[i]; obuf[crow(i, h) * 64 + 32] = out1[i]; }
    }
    {
        const bf16_t* ks = z + (size_t)b * T * ZP + Z_NKV + ((1 * 2 + 0) * 2 + g) * 64;
        const bf16_t* vs = z + (size_t)b * T * ZP + Z_NKV + ((1 * 2 + 1) * 2 + g) * 64;
        float m = 0.f, l = 0.f;
#pragma unroll
        for (int i = 0; i < 16; ++i) { o0[i] = 0.f; o1[i] = 0.f; }
        PT_BEGIN(5);
        attn_branch<MODE_SLC, NSA_G>(L, ks, ZP, vs, ZP, nullptr, 0, 0, c + 1, false, qf, qpos, active, 0, c, c, sel, m, negm, l, o0, o1, 0.f, 0.f, impw, wsf, tid);
        branch_finish_lds(obuf, active, o0, o1, l, g_slc, wsf, r, h);
        PT_END(5);
    }
    {
        const bf16_t* kw = z + (size_t)b * T * ZP + Z_NKV + ((2 * 2 + 0) * 2 + g) * 64;
        const bf16_t* vw = z + (size_t)b * T * ZP + Z_NKV + ((2 * 2 + 1) * 2 + g) * 64;
        float m = 0.f, l = 0.f;
#pragma unroll
        for (int i = 0; i < 16; ++i) { o0[i] = 0.f; o1[i] = 0.f; negm[i] = 0.f; }
        const int tb = c >= 8 ? c - 8 : 0;
        PT_BEGIN(6);
        attn_branch<MODE_WIN, NSA_G>(L, kw, ZP, vw, ZP, nullptr, 0, tb, c + 1, false, qf, qpos, active, tb, c, c, 0ull, m, negm, l, o0, o1, 0.f, 0.f, impw, wsf, tid);
        branch_finish_lds(obuf, active, o0, o1, l, g_win, wsf, r, h);
        PT_END(6);
    }
    if (active) {
        bf16_t* op = mix + ((size_t)b * T + q0 + 32 * qh) * D + head * 64 + r;
#pragma unroll
        for (int i = 0; i < 16; ++i) { const int qq = crow(i, h); op[(size_t)qq * D] = (bf16_t)f2bf(obuf[qq * 64]); op[(size_t)qq * D + 32] = (bf16_t)f2bf(obuf[qq * 64 + 32]); }
    }
    __syncthreads();
}

__device__ __forceinline__ void mla_unit(const Params& P, LAS unsigned char* L, int b, int hd, int qb) {
    const int tid = tid_(), lane = tid & 63, wave = __builtin_amdgcn_readfirstlane(tid >> 6), r = lane & 31, h = lane >> 5;
    unsigned char* ws = P.ws;
    const bf16_t* z = (const bf16_t*)(ws + WS_Z);
    const bf16_t* qm = (const bf16_t*)(ws + WS_QM);
    const bf16_t* kvm = (const bf16_t*)(ws + WS_KVM);
    bf16_t* mix = (bf16_t*)(ws + WS_MIX);
    const int q0 = 256 * qb, qpos = q0 + 32 * wave + r;
    const size_t qrow = (size_t)b * T + qpos;
    LAS float* wsf = (LAS float*)(L + AL_WSF) + wave * 64;
    bf16x8 qf[6];
#pragma unroll
    for (int cc = 0; cc < 6; ++cc) qf[cc] = *(const bf16x8*)(qm + qrow * QMP + hd * 96 + 16 * cc + 8 * h);
    f32x16 o0, o1, out0, out1, negm;
#pragma unroll
    for (int i = 0; i < 16; ++i) { o0[i] = 0.f; o1[i] = 0.f; negm[i] = 0.f; }
    float m = 0.f, l = 0.f;
    const bf16_t* kS = kvm + (size_t)b * T * KVP + hd * 64;
    const bf16_t* vS = kvm + (size_t)b * T * KVP + 384 + hd * 64;
    const bf16_t* rS = z + (size_t)b * T * ZP + Z_KR;
    const int nt = 4 * qb + 4, whi = (q0 + 32 * wave + 31) >> 6;
    attn_branch<MODE_MLA, 2>(L, kS, KVP, vS, KVP, rS, ZP, 0, nt, false, qf, qpos, true, 0, whi, 0, 0ull, m, negm, l, o0, o1, 0.f, 0.f, wsf, wsf, tid);
    { const float lt = l + __shfl_xor(l, 32); const float f = lt > 0.f ? 1.f / lt : 0.f;
      if (h == 0) wsf[r] = f;
      asm volatile("" ::: "memory");
#pragma unroll
      for (int i = 0; i < 16; ++i) { const float a = wsf[crow(i, h)]; out0[i] = o0[i] * a; out1[i] = o1[i] * a; } }
    bf16_t* op = mix + ((size_t)b * T + q0 + 32 * wave) * D + 384 + hd * 64 + r;
#pragma unroll
    for (int i = 0; i < 16; ++i) { const int qq = crow(i, h); op[(size_t)qq * D] = (bf16_t)f2bf(out0[i]); op[(size_t)qq * D + 32] = (bf16_t)f2bf(out1[i]); }
}

constexpr int Q_NSA = 128, Q_MLA = 96, Q_UNITS = Q_NSA + Q_MLA;
__device__ const unsigned char Q_ORDER[Q_UNITS] = {63, 127, 62, 126, 61, 125, 60, 124, 59, 123, 58, 122, 57, 121, 56, 120, 55, 119, 54, 118, 53, 117, 52, 116, 51, 115, 50, 114, 49, 113, 48, 112, 47, 111, 46, 110, 45, 109, 44, 108, 43, 107, 42, 106, 41, 105, 40, 104, 39, 103, 38, 102, 37, 101, 36, 100, 35, 99, 34, 98, 33, 97, 32, 96, 31, 95, 30, 94, 29, 93, 143, 159, 175, 191, 207, 223, 28, 92, 27, 91, 26, 90, 142, 158, 174, 190, 206, 222, 25, 89, 24, 88, 23, 87, 141, 157, 173, 189, 205, 221, 22, 86, 21, 85, 140, 156, 172, 188, 204, 220, 20, 84, 19, 83, 18, 82, 139, 155, 171, 187, 203, 219, 17, 81, 16, 80, 138, 154, 170, 186, 202, 218, 15, 79, 14, 78, 13, 77, 137, 153, 169, 185, 201, 217, 12, 76, 11, 75, 136, 152, 168, 184, 200, 216, 10, 74, 9, 73, 8, 72, 135, 151, 167, 183, 199, 215, 7, 71, 134, 150, 166, 182, 198, 214, 6, 70, 5, 69, 133, 149, 165, 181, 197, 213, 4, 68, 132, 148, 164, 180, 196, 212, 3, 67, 131, 147, 163, 179, 195, 211, 2, 66, 1, 65, 130, 146, 162, 178, 194, 210, 0, 64, 129, 145, 161, 177, 193, 209, 128, 144, 160, 176, 192, 208};
__device__ __forceinline__ unsigned xcc_id_() { return (unsigned)__builtin_amdgcn_s_getreg((3 << 11) | 20) & 0x7u; }
__device__ __forceinline__ void attention_phase(const Params& P, int layer, LAS unsigned char* L, int rep) {
    unsigned* ctr = (unsigned*)(P.ws + WS_CTL) + 1024 * rep + 512 * layer;
    LAS unsigned* bc = (LAS unsigned*)(L + AL_BC);
    const int x = (int)xcc_id_();
    for (int dx = 0; dx < 8; ++dx) {
        const int q = (x + dx) & 7;
        for (;;) {
            if (tid_() == 0) bc[0] = __hip_atomic_fetch_add(ctr + 64 * q, 1u, __ATOMIC_RELAXED, __HIP_MEMORY_SCOPE_AGENT);
            __syncthreads();
            const unsigned u = bc[0];
            __syncthreads();
            if (u >= (unsigned)Q_UNITS) break;
            PT_BEGIN(u < (unsigned)Q_NSA ? 1 : 2);
            const unsigned e = Q_ORDER[u];
            if (!(e & 0x80u)) { const int bg = 2 * q + (int)((e >> 6) & 1u), c = (int)(e & 63u); nsa_unit(P, L, bg >> 1, bg & 1, c); }
            else { const int hd = (int)((e >> 4) & 7u), qb = (int)(e & 15u); mla_unit(P, L, q, hd, qb); }
            PT_END(u < (unsigned)Q_NSA ? 1 : 2);
        }
    }
#if PROBE_T && PROBE_T < 20
    if (bid_() == PROBE_BLK && tid_() == 0) { LAS unsigned* pa_ = (LAS unsigned*)(PT_LDS + LDS_BYTES - 32); const unsigned long long w = (unsigned long long)pa_[0] * PROBE_MUL; pa_[0] = 0u;
        const unsigned long long t0 = __builtin_amdgcn_s_memtime(); while (__builtin_amdgcn_s_memtime() - t0 < w) __builtin_amdgcn_s_sleep(8); }
    __syncthreads();
#endif
}

__device__ __forceinline__ void final_phase(const Params& P) {
    const int tid = tid_(), bid = bid_(), gdim = gdim_(), lane = tid & 63, wave = tid >> 6;
    const float* ss = (const float*)(P.ws + WS_XPART) + (size_t)4 * M * 16; const float* gf = P.in[17];
    const bf16_t* xb = (const bf16_t*)(P.ws + WS_XB);
    for (int r = bid * 8 + wave; r < M; r += gdim * 8) {
        const float rs = rsqrtf(row_sum16(ss, r) * (1.0f / 1024.0f) + EPS);
        const u32x2* xr = (const u32x2*)(xb + (size_t)r * D) + lane;
        f32x4* orow = (f32x4*)(P.out + (size_t)r * D) + lane;
#pragma unroll
        for (int j = 0; j < 4; ++j) { const f32x4 gv = *((const f32x4*)gf + lane + 64 * j); const u32x2 a = xr[64 * j];
            f32x4 v; v[0] = __builtin_bit_cast(float, a.x << 16); v[1] = __builtin_bit_cast(float, a.x & 0xffff0000u); v[2] = __builtin_bit_cast(float, a.y << 16); v[3] = __builtin_bit_cast(float, a.y & 0xffff0000u);
            orow[64 * j] = v * rs * gv; }
    }
}

#define XB_TMO      128
#define XB_XCNT(j)  (256  + 64 * (j))
#define XB_XSUB(j)  (1280 + 64 * (j))
#define XB_XGEN(j)  (2304 + 64 * (j))
#define XB_TOP      3328
#define XB_TOPGEN   3392
#define XCD_BAR_WORDS 3456
#define XB_SPIN_CAP (1u << 18)

__device__ __forceinline__ unsigned xb_ld(unsigned* p)              { return __hip_atomic_load(p, __ATOMIC_RELAXED, __HIP_MEMORY_SCOPE_AGENT); }
__device__ __forceinline__ unsigned xb_add(unsigned* p, unsigned v) { return __hip_atomic_fetch_add(p, v, __ATOMIC_RELAXED, __HIP_MEMORY_SCOPE_AGENT); }
__device__ __forceinline__ unsigned xb_xcc_id() { return (unsigned)__builtin_amdgcn_s_getreg((3 << 11) | 20) & 0xFu; }
#define XB_SPIN(cond, bar) do { unsigned _sp = 0; while (cond) { __builtin_amdgcn_s_sleep(1); \
    if ((++_sp & 255u) == 0u) { if (xb_ld(&(bar)[XB_TMO])) break; if (_sp > XB_SPIN_CAP) { atomicAdd(&(bar)[XB_TMO], 1u); break; } } } } while (0)

struct XcdBarrier {
    unsigned* bar; unsigned x;
    volatile LAS unsigned* st;
};

__device__ __forceinline__ XcdBarrier xcd_barrier_post(unsigned* bar, volatile LAS unsigned* st) {
    XcdBarrier b; b.bar = bar; b.x = xb_xcc_id(); b.st = st;
    if (threadIdx.x == 0) (void)xb_add(&bar[XB_XCNT(b.x)], 1u);
    return b;
}
__device__ __forceinline__ void xcd_barrier_complete(unsigned* bar, unsigned x, unsigned& nloc, unsigned& nx) {
    const unsigned G = gridDim.x * gridDim.y * gridDim.z;
    unsigned sum, cnt, mine, sp = 0u;
    for (;;) {
        sum = 0u; cnt = 0u; mine = 0u;
#pragma unroll
        for (unsigned j = 0; j < 16; ++j) { const unsigned c = xb_ld(&bar[XB_XCNT(j)]); sum += c; cnt += (c > 0u) ? 1u : 0u; mine = (j == x) ? c : mine; }
        if (sum == G) break;
        __builtin_amdgcn_s_sleep(1);
        if ((++sp & 255u) == 0u) { if (xb_ld(&bar[XB_TMO])) break; if (sp > XB_SPIN_CAP) { atomicAdd(&bar[XB_TMO], 1u); break; } }
    }
    nloc = mine > 0u ? mine : 1u; nx = cnt > 0u ? cnt : 1u;
}

__device__ __forceinline__ void xcd_barrier(const XcdBarrier& b) {
    asm volatile("s_waitcnt vmcnt(0)" ::: "memory");
    __syncthreads();
    if (threadIdx.x == 0) {
        unsigned* bar = b.bar;
        __builtin_amdgcn_s_waitcnt(0);
        unsigned nloc = b.st[0], nx = b.st[1];
        if (nloc == 0u) { xcd_barrier_complete(bar, b.x, nloc, nx); b.st[0] = nloc; b.st[1] = nx; }
        const unsigned old = xb_add(&bar[XB_XSUB(b.x)], 1u);
        const unsigned gen = old / nloc;
        if (old + 1u == (gen + 1u) * nloc) {
            __builtin_amdgcn_fence(__ATOMIC_RELEASE, "agent");
            asm volatile("s_waitcnt vmcnt(0)" ::: "memory");
            const unsigned og = xb_add(&bar[XB_TOP], 1u);
            const unsigned tg = og / nx;
            if (og + 1u == (tg + 1u) * nx) xb_add(&bar[XB_TOPGEN], 1u);
            else XB_SPIN(xb_ld(&bar[XB_TOPGEN]) == tg, bar);
            __builtin_amdgcn_fence(__ATOMIC_ACQUIRE, "agent");
            xb_add(&bar[XB_XGEN(b.x)], 1u);
            asm volatile("s_waitcnt vmcnt(0)" ::: "memory");
        } else {
            XB_SPIN(xb_ld(&bar[XB_XGEN(b.x)]) == gen, bar);
            __builtin_amdgcn_fence(__ATOMIC_ACQUIRE, "agent");
            asm volatile("s_waitcnt vmcnt(0)" ::: "memory");
        }
    }
    __syncthreads();
}

__device__ __forceinline__ unsigned char* ws_of(const Params& P) { unsigned char* w = P.ws; asm volatile("" : "+s"(w)); return w; }
#ifndef PMASK
#define PMASK 0xffffffffu
#endif
#ifndef PROBE_K
#define PROBE_K 0
#endif
constexpr int N_PHASES_C = 1 + 6 * DEPTH + 1;
__global__ void __launch_bounds__(512) trunk_fwd(Params P, int ph_lo, int ph_hi) {
    extern __shared__ __attribute__((aligned(16))) unsigned char lds_raw[];
    LAS unsigned char* lds = (LAS unsigned char*)lds_raw;
    cg::grid_group grid = cg::this_grid();
    volatile LAS unsigned* bst = (volatile LAS unsigned*)(lds + LDS_BYTES - 64);
    if (threadIdx.x < 16) bst[threadIdx.x] = 0u;
    __syncthreads();
    XcdBarrier bar = xcd_barrier_post((unsigned*)(P.ws + WS_CTL) + 4096, bst);
    if (ph_lo < 0) grid.sync();
    for (int ph = ph_lo; ph < ph_hi; ++ph) {
        const int l = (ph - 1) / 6, k = (ph == 0) ? 0 : ((ph == 1 + 6 * DEPTH) ? 7 : 1 + (ph - 1) % 6);
        PT_BEGIN(20 + k);
        unsigned char* ws = ws_of(P);
        float* xpb = (float*)(ws + WS_XPART); float* cpb = (float*)(ws + WS_CPART);
        if (k == 0) { if (PMASK & 1u) prologue(P, lds); }
        else if (k == 1) { if (PMASK & 2u) {
            const float* ropec = (const float*)(ws + WS_ROPE);
            EpiInProj E{(bf16_t*)(ws + WS_Z), (l == 0) ? xpb : xpb + (size_t)2 * M * 16, cpb + (size_t)(2 * l) * M * 4, cpb + (size_t)(2 * l + 1) * M * 4, ropec, ropec + (size_t)M * 16};
            run_gemm(lds, (const bf16_t*)(ws + WS_XB), D, (const bf16_t*)(ws + WS_WIN) + (size_t)l * NZ * D, NZ, D, E); } }
        else if (k == 2) {
            if (PMASK & 4u) { const float* ropec = (const float*)(ws + WS_ROPE); EpiQup E{(bf16_t*)(ws + WS_QM), cpb + (size_t)(2 * l) * M * 4, ropec, ropec + (size_t)M * 16};
                run_gemm(lds, (const bf16_t*)(ws + WS_Z) + Z_CQ, ZP, (const bf16_t*)(ws + WS_WQUP) + (size_t)l * 768 * 256, 768, 256, E); }
            if (PMASK & 8u) { unsigned char* ws2 = ws_of(P); EpiKVup E{(bf16_t*)(ws2 + WS_KVM), (const float*)(ws2 + WS_CPART) + (size_t)(2 * l + 1) * M * 4};
                run_gemm(lds, (const bf16_t*)(ws2 + WS_Z) + Z_CKV, ZP, (const bf16_t*)(ws2 + WS_WKVUP) + (size_t)l * 768 * 128, 768, 128, E, true); }
            if (PMASK & 16u) compress_phase(P, l, lds);
            if (PMASK & 32u) pool_phase(P, l);
#if PROBE_K == 21
            compress_phase(P, l, lds);
#endif
#if PROBE_K == 22
            pool_phase(P, l);
#endif
        }
        else if (k == 3) { if (PMASK & 64u) { attention_phase(P, l, lds, 0);
#if PROBE_K == 3
            attention_phase(P, l, lds, 1);
#endif
        } }
        else if (k == 4) { if (PMASK & 128u) { EpiResid E{(bf16_t*)(ws + WS_XB), xpb + (size_t)(1 + 2 * l) * M * 16};
            run_gemm(lds, (const bf16_t*)(ws + WS_MIX), D, (const bf16_t*)(ws + WS_WOUT) + (size_t)l * D * D, D, D, E); } }
        else if (k == 5) { if (PMASK & 256u) { EpiFF1 E{(bf16_t*)(ws + WS_H), xpb + (size_t)(1 + 2 * l) * M * 16};
            run_gemm(lds, (const bf16_t*)(ws + WS_XB), D, (const bf16_t*)(ws + WS_WFF1) + (size_t)l * FF * D, FF, D, E); } }
        else if (k == 6) { if (PMASK & 512u) { EpiResid E{(bf16_t*)(ws + WS_XB), xpb + (size_t)(2 + 2 * l) * M * 16};
            run_gemm(lds, (const bf16_t*)(ws + WS_H), FF, (const bf16_t*)(ws + WS_WFF2) + (size_t)l * D * FF, D, FF, E); } }
        else { if (PMASK & 1024u) final_phase(P); }
        if (ph + 1 < ph_hi) xcd_barrier(bar);
        PT_END(20 + k);
#if PROBE_T >= 20
        if (ph == N_PHASES_C - 2) { if (bid_() == PROBE_BLK && tid_() == 0) { LAS unsigned* pa_ = (LAS unsigned*)(PT_LDS + LDS_BYTES - 32); const unsigned long long w = (unsigned long long)pa_[0] * PROBE_MUL; pa_[0] = 0u;
            const unsigned long long t0 = __builtin_amdgcn_s_memtime(); while (__builtin_amdgcn_s_memtime() - t0 < w) __builtin_amdgcn_s_sleep(8); }
            __syncthreads(); xcd_barrier(bar); }
#endif
    }
#if PROBE_T == 27
    if (bid_() == PROBE_BLK && tid_() == 0) { LAS unsigned* pa_ = (LAS unsigned*)(PT_LDS + LDS_BYTES - 32); const unsigned long long w = (unsigned long long)pa_[0] * PROBE_MUL;
        const unsigned long long t0 = __builtin_amdgcn_s_memtime(); while (__builtin_amdgcn_s_memtime() - t0 < w) __builtin_amdgcn_s_sleep(8); }
#endif
}
constexpr int N_PHASES = 1 + 6 * DEPTH + 1;

#ifndef MK_MULTI
#define MK_MULTI 0
#endif
extern "C" void kernel_launch(void* const* d_in, const int* in_sizes, int n_in, void* d_out, int out_size, void* d_ws, size_t ws_size, hipStream_t stream) {
    static int grid_blocks = 0;
    if (grid_blocks == 0) {
        if (n_in != 18 || out_size != M * D || ws_size < WS_END) { fprintf(stderr, "kernel_launch: unexpected shapes (n_in %d out %d ws %zu)\n", n_in, out_size, ws_size); grid_blocks = -1; return; }
        int dev = 0, cus = 0, per_cu = 0;
        hipGetDevice(&dev);
        hipDeviceGetAttribute(&cus, hipDeviceAttributeMultiprocessorCount, dev);
        if (hipFuncSetAttribute((const void*)trunk_fwd, hipFuncAttributeMaxDynamicSharedMemorySize, LDS_BYTES) != hipSuccess) { fprintf(stderr, "kernel_launch: hipFuncSetAttribute failed\n"); grid_blocks = -1; return; }
        if (hipOccupancyMaxActiveBlocksPerMultiprocessor(&per_cu, (const void*)trunk_fwd, 512, LDS_BYTES) != hipSuccess || per_cu < 1) { fprintf(stderr, "kernel_launch: occupancy query gave %d\n", per_cu); per_cu = 1; }
        (void)hipGetLastError();
        grid_blocks = cus * per_cu;
    }
    if (grid_blocks < 0) return;
    Params p{};
    for (int i = 0; i < 18; ++i) p.in[i] = (const float*)d_in[i];
    p.out = (float*)d_out; p.ws = (unsigned char*)d_ws;
    if (hipMemsetAsync(d_ws, 0, 65536, stream) != hipSuccess) { fprintf(stderr, "kernel_launch: memset failed\n"); return; }
    int lo = 0, hi = N_PHASES;
    void* args[] = {&p, &lo, &hi};
    hipError_t e = hipLaunchCooperativeKernel((const void*)trunk_fwd, dim3(grid_blocks), dim3(512), args, LDS_BYTES, stream);
    if (e != hipSuccess) fprintf(stderr, "cooperative launch failed: %s (grid %d)\n", hipGetErrorString(e), grid_blocks);
}
```

```cpp
#include <hip/hip_runtime.h>
#include <hip/hip_cooperative_groups.h>
#include <cstdio>
#include <cstdint>
namespace cg = cooperative_groups;

namespace pg8 {
#define PG8_LAS __attribute__((address_space(3)))
typedef unsigned short bf16_t;
typedef short bf16x8 __attribute__((ext_vector_type(8)));
typedef float f32x4 __attribute__((ext_vector_type(4)));
typedef unsigned u32x4 __attribute__((ext_vector_type(4)));
constexpr int BM = 256, BK = 64, HALF = 128, HTB = HALF * BK * 2  , STAGE_BYTES = 8 * HTB, NXCD = 8, WGM = 8;

__host__ __device__ __forceinline__ int lds_byte(int r, int c) { const int st = (r >> 4) * 2 + (c >> 5), rr = r & 15, cc = c & 31, ob = rr * 64 + cc * 2; return st * 1024 + (ob ^ (((ob >> 9) & 1) << 5)); }
__host__ __device__ __forceinline__ void stage_rc(int b, int& R, int& C) { const int st = b / 1024, sb = b % 1024, swz = sb ^ (((sb >> 9) & 1) << 5); R = (st >> 1) * 16 + swz / 64; C = (st & 1) * 32 + (swz % 64) / 2; }
__host__ __device__ __forceinline__ int perm32(int rho) { const int n = rho >> 4, i = rho & 15; return 8 * (i >> 2) + 4 * n + (i & 3); }

struct Unit { int pm, pn; };
struct Gemm { const bf16_t* A; const bf16_t* Bt; int M, N, K, lda; };
struct StaticOrder {
    int nM, nN, nwg, G, c;
    __host__ __device__ void init(int M, int N, int G_, int c_) { nM = M / BM; nN = N / BM; nwg = nM * nN; G = G_; c = c_; }
    __host__ __device__ bool next(int i, Unit& u) const {
        const long L = (long)i * G + c; if (L >= nwg) return false;
        int wgid = (int)L; { const int q = nwg / NXCD, r = nwg % NXCD, xcd = wgid % NXCD, off = wgid / NXCD; wgid = (xcd < r ? xcd * (q + 1) : r * (q + 1) + (xcd - r) * q) + off; }
        const int nig = WGM * nN, gid = wgid / nig, fm = gid * WGM, gsz = (nM - fm) < WGM ? (nM - fm) : WGM;
        u.pm = fm + ((wgid % nig) % gsz); u.pn = (wgid % nig) / gsz; return true;
    }
    __device__ __forceinline__ void a_ready(const Unit&) const {}
    __device__ __forceinline__ void done(const Unit&) const {}
};
__device__ __forceinline__ unsigned cvt_pk_bf16(float lo, float hi) { unsigned r; asm volatile("v_cvt_pk_bf16_f32 %0, %1, %2" : "=v"(r) : "v"(lo), "v"(hi)); return r; }
template <class Epi, class Sched, bool ALIGN_EPI = false, bool SP2 = false>
__device__ __forceinline__ void gemm_phase(PG8_LAS unsigned char* lds, const Gemm g, const Sched& S, const Epi& E) {
    int tid = threadIdx.x; asm volatile("" : "+v"(tid)); const int wid = __builtin_amdgcn_readfirstlane(tid >> 6), lane = tid & 63, wr = wid >> 2, wc = wid & 3, fr = lane & 15, fq = lane >> 4;
    const int K = g.K, nt = K / BK;
    unsigned voffA[2], voffB[2];
#pragma unroll
    for (int i = 0; i < 2; ++i) { int R, C; stage_rc(tid * 16 + i * 8192, R, C); const int Rb = Epi::PERM ? ((R & ~31) + perm32(R & 31)) : R;
        voffA[i] = (unsigned)(R * g.lda + C) * 2u; voffB[i] = (unsigned)(Rb * K + C) * 2u; }
    const size_t kstep = (size_t)(BK * 2);
    const size_t hstepB = (size_t)HALF * K * 2, hstepA = (size_t)HALF * g.lda * 2;
    const size_t tstepB = 2 * hstepB, tstepA = 2 * hstepA;
    const unsigned ldsw = (unsigned)wid * 1024u;
    const int aoff = lds_byte(wr * 64 + fr, fq * 8), boff = lds_byte(wc * 32 + fr, fq * 8);
#define PG8_SA(b, h) (((b) * 2 + (h)) * HTB)
#define PG8_SB(b, h) ((4 + (b) * 2 + (h)) * HTB)
#define PG8_STAGE(bufoff, gbase, voff) do { _Pragma("unroll") for (int _i = 0; _i < 2; ++_i) \
        __builtin_amdgcn_global_load_lds((const unsigned*)((const char*)(gbase) + (voff)[_i]), (PG8_LAS unsigned*)(lds + (bufoff) + ldsw + _i * 8192), 16, 0, 0); } while (0)
#define PG8_LDA(dst, b, h) do { _Pragma("unroll") for (int m = 0; m < 4; ++m) _Pragma("unroll") for (int k = 0; k < 2; ++k) dst[m][k] = *(const PG8_LAS bf16x8*)(lds + PG8_SA(b, h) + aoff + m * 2048 + k * 1024); } while (0)
#define PG8_LDB(dst, b, h) do { _Pragma("unroll") for (int n = 0; n < 2; ++n) _Pragma("unroll") for (int k = 0; k < 2; ++k) dst[n][k] = *(const PG8_LAS bf16x8*)(lds + PG8_SB(b, h) + boff + n * 2048 + k * 1024); } while (0)
#define PG8_MMA(ai, bj, At, Bt) do { __builtin_amdgcn_s_setprio(1); _Pragma("unroll") for (int m = 0; m < 4; ++m) _Pragma("unroll") for (int n = 0; n < 2; ++n) _Pragma("unroll") for (int k = 0; k < 2; ++k) \
        acc[ai][bj][m][n] = __builtin_amdgcn_mfma_f32_16x16x32_bf16(Bt[n][k], At[m][k], acc[ai][bj][m][n], 0, 0, 0); __builtin_amdgcn_s_setprio(0); } while (0)
#define PG8_WAIT_V(n) asm volatile("s_waitcnt vmcnt(" #n ")" ::: "memory")
#define PG8_WAIT_L(n) asm volatile("s_waitcnt lgkmcnt(" #n ")" ::: "memory")
#define PG8_BAR __builtin_amdgcn_s_barrier()
#define PG8_SCHED __builtin_amdgcn_sched_barrier(0)
    Unit cur, nxt; int ui = 0;
    if (!S.next(0, cur)) return;
    f32x4 acc[2][2][4][2];
#pragma unroll
    for (int a = 0; a < 2; ++a)
#pragma unroll
        for (int b = 0; b < 2; ++b)
#pragma unroll
            for (int m = 0; m < 4; ++m)
#pragma unroll
                for (int n = 0; n < 2; ++n) acc[a][b][m][n] = (f32x4){0.f, 0.f, 0.f, 0.f};
    bf16x8 At[4][2], B0[2][2], B1[2][2];
    const char* cA = (const char*)g.A + (size_t)cur.pm * tstepA; const char* cB = (const char*)g.Bt + (size_t)cur.pn * tstepB;
    S.a_ready(cur);
    if constexpr (SP2) {
        PG8_STAGE(PG8_SB(0, 0), cB, voffB); PG8_STAGE(PG8_SB(0, 1), cB + hstepB, voffB); PG8_STAGE(PG8_SA(0, 0), cA, voffA); PG8_STAGE(PG8_SA(0, 1), cA + hstepA, voffA);
        if (wr == 1) PG8_BAR;
        PG8_WAIT_V(2); PG8_BAR;
        PG8_STAGE(PG8_SB(1, 0), cB + kstep, voffB); PG8_STAGE(PG8_SA(1, 0), cA + kstep, voffA); PG8_STAGE(PG8_SB(1, 1), cB + hstepB + kstep, voffB);
        PG8_WAIT_V(6); PG8_BAR;
    } else {
        PG8_STAGE(PG8_SB(0, 0), cB, voffB); PG8_STAGE(PG8_SA(0, 0), cA, voffA); PG8_STAGE(PG8_SB(0, 1), cB + hstepB, voffB); PG8_STAGE(PG8_SA(0, 1), cA + hstepA, voffA);
        if (wr == 1) PG8_BAR;
        PG8_WAIT_V(4); PG8_BAR;
        PG8_STAGE(PG8_SB(1, 0), cB + kstep, voffB); PG8_STAGE(PG8_SA(1, 0), cA + kstep, voffA); PG8_STAGE(PG8_SB(1, 1), cB + hstepB + kstep, voffB);
        PG8_WAIT_V(6); PG8_BAR;
    }
    for (;;) {
        const bool has_next = S.next(ui + 1, nxt);
        const char* nA = has_next ? (const char*)g.A + (size_t)nxt.pm * tstepA : cA; const char* nB = has_next ? (const char*)g.Bt + (size_t)nxt.pn * tstepB : cB;
        for (int t = 0; t < nt; t += 2) {
            const bool last = (t == nt - 2);
            const char* a1 = cA + (size_t)(t + 1) * kstep;
            const char* a2 = last ? nA : cA + (size_t)(t + 2) * kstep; const char* b2 = last ? nB : cB + (size_t)(t + 2) * kstep;
            const char* a3 = a2 + kstep; const char* b3 = b2 + kstep;
            if (last && has_next) S.a_ready(nxt);
            if constexpr (SP2) {
            PG8_LDB(B0, 0, 0); PG8_LDB(B1, 0, 1); PG8_SCHED; PG8_LDA(At, 0, 0); PG8_STAGE(PG8_SA(1, 1), a1 + hstepA, voffA);
            PG8_WAIT_V(8); PG8_WAIT_L(0); PG8_BAR; PG8_MMA(0, 0, At, B0); PG8_MMA(0, 1, At, B1); PG8_BAR; PG8_SCHED;
            PG8_LDA(At, 0, 1); PG8_STAGE(PG8_SB(0, 0), b2, voffB); PG8_STAGE(PG8_SB(0, 1), b2 + hstepB, voffB); PG8_STAGE(PG8_SA(0, 0), a2, voffA);
            PG8_WAIT_V(8); PG8_WAIT_L(0); PG8_BAR; PG8_MMA(1, 0, At, B0); PG8_MMA(1, 1, At, B1); PG8_BAR; PG8_SCHED;
            PG8_LDB(B0, 1, 0); PG8_LDB(B1, 1, 1); PG8_SCHED; PG8_LDA(At, 1, 0); PG8_STAGE(PG8_SA(0, 1), a2 + hstepA, voffA);
            PG8_WAIT_V(8); PG8_WAIT_L(0); PG8_BAR; PG8_MMA(0, 0, At, B0); PG8_MMA(0, 1, At, B1); PG8_BAR; PG8_SCHED;
            PG8_LDA(At, 1, 1); PG8_STAGE(PG8_SB(1, 0), b3, voffB); PG8_STAGE(PG8_SB(1, 1), b3 + hstepB, voffB); PG8_STAGE(PG8_SA(1, 0), a3, voffA);
            PG8_WAIT_V(8); PG8_WAIT_L(0); PG8_BAR; PG8_MMA(1, 0, At, B0); PG8_MMA(1, 1, At, B1); PG8_BAR; PG8_SCHED;
            } else {
            PG8_LDB(B0, 0, 0); PG8_SCHED; PG8_LDA(At, 0, 0); PG8_STAGE(PG8_SA(1, 1), a1 + hstepA, voffA);
            PG8_WAIT_L(8); PG8_BAR; PG8_WAIT_L(0); PG8_MMA(0, 0, At, B0); PG8_BAR; PG8_SCHED;
            PG8_LDB(B1, 0, 1); PG8_STAGE(PG8_SB(0, 0), b2, voffB);
            PG8_BAR; PG8_WAIT_L(0); PG8_MMA(0, 1, At, B1); PG8_BAR;
            PG8_LDA(At, 0, 1); PG8_STAGE(PG8_SA(0, 0), a2, voffA);
            PG8_BAR; PG8_WAIT_L(0); PG8_MMA(1, 0, At, B0); PG8_BAR; PG8_SCHED;
            PG8_STAGE(PG8_SB(0, 1), b2 + hstepB, voffB);
            PG8_WAIT_V(6); PG8_BAR; PG8_MMA(1, 1, At, B1); PG8_BAR;
            PG8_LDB(B0, 1, 0); PG8_SCHED; PG8_LDA(At, 1, 0); PG8_STAGE(PG8_SA(0, 1), a2 + hstepA, voffA);
            PG8_WAIT_L(8); PG8_BAR; PG8_WAIT_L(0); PG8_MMA(0, 0, At, B0); PG8_BAR; PG8_SCHED;
            PG8_LDB(B1, 1, 1); PG8_STAGE(PG8_SB(1, 0), b3, voffB);
            PG8_BAR; PG8_WAIT_L(0); PG8_MMA(0, 1, At, B1); PG8_BAR;
            PG8_LDA(At, 1, 1); PG8_STAGE(PG8_SA(1, 0), a3, voffA);
            PG8_BAR; PG8_WAIT_L(0); PG8_MMA(1, 0, At, B0); PG8_BAR; PG8_SCHED;
            PG8_STAGE(PG8_SB(1, 1), b3 + hstepB, voffB);
            PG8_WAIT_V(6); PG8_BAR; PG8_MMA(1, 1, At, B1); PG8_BAR;
            }
        }
        if constexpr (ALIGN_EPI) { if (wr == 0) PG8_BAR; }
        if constexpr (!Epi::AFTER_DRAIN) { E(acc, cur, wr, wc, fr, fq); S.done(cur); }
        if (!has_next) break;
#pragma unroll
        for (int a = 0; a < 2; ++a)
#pragma unroll
            for (int b = 0; b < 2; ++b)
#pragma unroll
                for (int m = 0; m < 4; ++m)
#pragma unroll
                    for (int n = 0; n < 2; ++n) acc[a][b][m][n] = (f32x4){0.f, 0.f, 0.f, 0.f};
        cur = nxt; cA = nA; cB = nB; ++ui;
        if constexpr (ALIGN_EPI) { if (wr == 1) PG8_BAR; }
    }
    PG8_WAIT_V(0);
    if constexpr (!ALIGN_EPI) { if (wr == 0) PG8_BAR; }
    PG8_BAR;
    if constexpr (Epi::AFTER_DRAIN) { E.fused(acc, cur, wr, wc, fr, fq, lds, wid, lane); S.done(cur); }
#undef PG8_SA
#undef PG8_SB
#undef PG8_STAGE
#undef PG8_LDA
#undef PG8_LDB
#undef PG8_MMA
#undef PG8_WAIT_V
#undef PG8_WAIT_L
#undef PG8_BAR
#undef PG8_SCHED
}
}


#define LAS __attribute__((address_space(3)))
typedef unsigned short bf16_t;
typedef short bf16x8 __attribute__((ext_vector_type(8)));
typedef short s16x4 __attribute__((ext_vector_type(4)));
typedef float f32x4 __attribute__((ext_vector_type(4)));
typedef float f32x16 __attribute__((ext_vector_type(16)));
typedef unsigned u32x4 __attribute__((ext_vector_type(4)));
typedef unsigned u32x2 __attribute__((ext_vector_type(2)));
typedef float f32x2_t __attribute__((ext_vector_type(2)));
typedef __bf16 bf16x2_t __attribute__((ext_vector_type(2)));
typedef short v4i16_t __attribute__((ext_vector_type(4)));

constexpr int NB = 8, T = 4096, M = NB * T, D = 1024, FF = 4096, DEPTH = 2;
constexpr int P_IN = 1842, ZP = 2048;
constexpr int Z_CQ = 0, Z_CKV = 256, Z_KR = 384, Z_GATE = 416, Z_NQ = 512, Z_NKV = 896, Z_PU = 1664;
constexpr int QMP = 768, KVP = 768;
constexpr float EPS = 1e-6f;
constexpr float LOG2E = 1.4426950408889634f;
constexpr float NSA_QS = 0.125f * LOG2E;
constexpr float MLA_QS = 0.10206207261596575f * LOG2E;

constexpr size_t MiB = 1u << 20;
constexpr size_t WS_CTL = 0;
constexpr size_t WS_SS = 1 * MiB;
constexpr size_t WS_ROPE = 3 * MiB;
constexpr size_t WS_BIASP = 7 * MiB;
constexpr size_t WS_KCMP = 7 * MiB + 512 * 1024;
constexpr size_t WS_WIN = 10 * MiB, WS_WOUT = 18 * MiB, WS_WFF1 = 22 * MiB, WS_WFF2 = 38 * MiB, WS_WQUP = 54 * MiB, WS_WKVUP = 55 * MiB;
constexpr size_t WS_W1T = 56 * MiB, WS_W2T = 57 * MiB, WS_WPT = 57 * MiB + 512 * 1024;
constexpr size_t WS_XB = 64 * MiB, WS_MIX = 128 * MiB, WS_H = 192 * MiB, WS_Z = 192 * MiB, WS_QM = 320 * MiB, WS_KVM = 368 * MiB, WS_XPART = 448 * MiB, WS_CPART = 458 * MiB, WS_END = 460 * MiB;

constexpr int LDS_BYTES = 147456;

struct Params { const float* in[18]; float* out; unsigned char* ws; };

__device__ __forceinline__ unsigned f2bf(float f) { unsigned u = __builtin_bit_cast(unsigned, f); return (u + 0x7fffu + ((u >> 16) & 1u)) >> 16; }
__device__ __forceinline__ unsigned pk2(float lo, float hi) { f32x2_t v = {lo, hi}; bf16x2_t b = __builtin_convertvector(v, bf16x2_t); return __builtin_bit_cast(unsigned, b); }
__device__ __forceinline__ float bf2f(unsigned short b) { return __builtin_bit_cast(float, (unsigned)b << 16); }
__device__ __forceinline__ float wave_sum(float v) {
#pragma unroll
    for (int o = 1; o < 64; o <<= 1) v += __shfl_xor(v, o);
    return v;
}
__device__ __forceinline__ int crow(int r, int h) { return (r & 3) + 8 * (r >> 2) + 4 * h; }
__device__ __forceinline__ void atomic_addf(float* p, float v) { __hip_atomic_fetch_add(p, v, __ATOMIC_RELAXED, __HIP_MEMORY_SCOPE_AGENT); }
__device__ __forceinline__ float fast_exp2(float x) { return __builtin_amdgcn_exp2f(x); }

__device__ __forceinline__ int tid_() { int t = threadIdx.x; asm volatile("" : "+v"(t)); return t; }
__device__ __forceinline__ int bid_() { int t = blockIdx.x; asm volatile("" : "+s"(t)); return t; }
__device__ __forceinline__ int gdim_() { int t = gridDim.x; asm volatile("" : "+s"(t)); return t; }
#ifndef PROBE_T
#define PROBE_T 0
#endif
#ifndef PROBE_BLK
#define PROBE_BLK 0
#endif
#ifndef PROBE_TID
#define PROBE_TID 0
#endif
#ifndef PROBE_MUL
#define PROBE_MUL 3
#endif
#if PROBE_T
#define PT_LDS ((LAS unsigned char*)0)
#define PT_BEGIN(tag) unsigned long long pt_t0_ = 0; if ((tag) == PROBE_T) { __builtin_amdgcn_sched_barrier(0); pt_t0_ = __builtin_amdgcn_s_memtime(); __builtin_amdgcn_sched_barrier(0); }
#define PT_END(tag) do { if ((tag) == PROBE_T) { __builtin_amdgcn_sched_barrier(0); const unsigned long long pt_t1_ = __builtin_amdgcn_s_memtime(); __builtin_amdgcn_sched_barrier(0); if (bid_() == PROBE_BLK && tid_() == PROBE_TID) { LAS unsigned* pa_ = (LAS unsigned*)(PT_LDS + LDS_BYTES - 32); pa_[0] += (unsigned)(pt_t1_ - pt_t0_); } } } while (0)
#else
#define PT_BEGIN(tag) do {} while (0)
#define PT_END(tag) do {} while (0)
#endif
#define EPI_LOOP_ROWS  _Pragma("unroll") for (int ai = 0; ai < 2; ++ai) _Pragma("unroll") for (int m = 0; m < 4; ++m) if (epi_fence())
__device__ __forceinline__ bool epi_fence() { asm volatile("" ::: "memory"); return true; }
__device__ __forceinline__ float row_sum16(const float* part, int row) {
    const f32x4* p = (const f32x4*)(part + (size_t)row * 16); const f32x4 a = p[0], b = p[1], c = p[2], d = p[3];
    return (((a[0] + a[1]) + (a[2] + a[3])) + ((b[0] + b[1]) + (b[2] + b[3]))) + (((c[0] + c[1]) + (c[2] + c[3])) + ((d[0] + d[1]) + (d[2] + d[3])));
}
__device__ __forceinline__ float row_sum4(const float* part, int row) { const f32x4 a = *(const f32x4*)(part + (size_t)row * 4); return (a[0] + a[1]) + (a[2] + a[3]); }
template <int NPART>
__device__ __forceinline__ LAS float* epi_row_scales(const float* part, int pm, int wr, int wc, int fr, int fq, float inv_n, float mul) {
    LAS float* sc = (LAS float*)(size_t)131072 + (wr * 4 + wc) * 128;
    const int lane = fq * 16 + fr;
#pragma unroll
    for (int a = 0; a < 2; ++a) {
        const int row = pm * 256 + a * 128 + wr * 64 + lane;
        const float sm = (NPART == 16) ? row_sum16(part, row) : row_sum4(part, row);
        sc[a * 64 + lane] = rsqrtf(sm * inv_n + EPS) * mul;
    }
    asm volatile("" ::: "memory");
    return sc;
}
__device__ __forceinline__ void st_bf4(bf16_t* p, f32x4 v) { u32x2 w; w.x = pk2(v[0], v[1]); w.y = pk2(v[2], v[3]); *(u32x2*)p = w; }
__device__ __forceinline__ float dot4(f32x4 v) { return (v[0] * v[0] + v[1] * v[1]) + (v[2] * v[2] + v[3] * v[3]); }

struct EpiInProj {
    static constexpr bool PERM = true, AFTER_DRAIN = false;
    bf16_t* z; const float* ss_x; float* ss_cq; float* ss_ckv; const float* ropec; const float* ropes;
    __device__ __forceinline__ void operator()(const f32x4 (&acc)[2][2][4][2], const pg8::Unit& u, int wr, int wc, int fr, int fq) const {
        const int pn = u.pn;
        LAS float* sc = epi_row_scales<16>(ss_x, u.pm, wr, wc, fr, fq, 1.0f / 1024.0f, 1.0f);
        EPI_LOOP_ROWS {
            const int row = u.pm * 256 + ai * 128 + wr * 64 + m * 16 + fr;
            const float rs = sc[ai * 64 + m * 16 + fr];
            float sq = 0.f;
#pragma unroll
            for (int bj = 0; bj < 2; ++bj) {
                f32x4 v0 = acc[ai][bj][m][0] * rs, v1 = acc[ai][bj][m][1] * rs;
                const int cb = pn * 256 + bj * 128 + wc * 32;
                if (pn == 0 || (pn == 1 && bj == 0)) sq += dot4(v0) + dot4(v1);
                if (pn == 1 && bj == 1 && wc == 0) {
                    const float* cp = ropec + (size_t)row * 16 + 8 * (fq & 1); const float* sp = ropes + (size_t)row * 16 + 8 * (fq & 1);
                    const f32x4 c0 = *(const f32x4*)cp, c1 = *(const f32x4*)(cp + 4), s0 = *(const f32x4*)sp, s1 = *(const f32x4*)(sp + 4);
                    const float sg = (fq < 2) ? -1.f : 1.f;
                    f32x4 p0v, p1v;
#pragma unroll
                    for (int j = 0; j < 4; ++j) { p0v[j] = __shfl_xor(v0[j], 32); p1v[j] = __shfl_xor(v1[j], 32); }
                    v0 = v0 * c0 + p0v * s0 * sg; v1 = v1 * c1 + p1v * s1 * sg;
                }
                if (cb >= Z_NQ && cb < Z_NKV) { v0 = v0 * NSA_QS; v1 = v1 * NSA_QS; }
                u32x4 w; w.x = pk2(v0[0], v0[1]); w.y = pk2(v0[2], v0[3]); w.z = pk2(v1[0], v1[1]); w.w = pk2(v1[2], v1[3]);
                *(u32x4*)(z + (size_t)row * ZP + cb + 8 * fq) = w;
            }
            if (pn <= 1) {
                sq += __shfl_xor(sq, 16); sq += __shfl_xor(sq, 32);
                if (fq == 0) (pn == 0 ? ss_cq : ss_ckv)[(size_t)row * 4 + wc] = sq;
            }
        }
    }
};

struct EpiQup {
    static constexpr bool PERM = true, AFTER_DRAIN = false;
    bf16_t* qm; const float* ss_cq; const float* ropec; const float* ropes;
    __device__ __forceinline__ void operator()(const f32x4 (&acc)[2][2][4][2], const pg8::Unit& u, int wr, int wc, int fr, int fq) const {
        LAS float* sc = epi_row_scales<4>(ss_cq, u.pm, wr, wc, fr, fq, 1.0f / 256.0f, MLA_QS);
        EPI_LOOP_ROWS {
            const int row = u.pm * 256 + ai * 128 + wr * 64 + m * 16 + fr;
            const float rs = sc[ai * 64 + m * 16 + fr];
#pragma unroll
            for (int bj = 0; bj < 2; ++bj) {
                f32x4 v0 = acc[ai][bj][m][0] * rs, v1 = acc[ai][bj][m][1] * rs;
                const int gi = u.pn * 8 + bj * 4 + wc;
                if (gi % 3 == 2) {
                    const float* cp = ropec + (size_t)row * 16 + 8 * (fq & 1); const float* sp = ropes + (size_t)row * 16 + 8 * (fq & 1);
                    const f32x4 c0 = *(const f32x4*)cp, c1 = *(const f32x4*)(cp + 4), s0 = *(const f32x4*)sp, s1 = *(const f32x4*)(sp + 4);
                    const float sg = (fq < 2) ? -1.f : 1.f;
                    f32x4 p0v, p1v;
#pragma unroll
                    for (int j = 0; j < 4; ++j) { p0v[j] = __shfl_xor(v0[j], 32); p1v[j] = __shfl_xor(v1[j], 32); }
                    v0 = v0 * c0 + p0v * s0 * sg; v1 = v1 * c1 + p1v * s1 * sg;
                }
                u32x4 w; w.x = pk2(v0[0], v0[1]); w.y = pk2(v0[2], v0[3]); w.z = pk2(v1[0], v1[1]); w.w = pk2(v1[2], v1[3]);
                *(u32x4*)(qm + (size_t)row * QMP + gi * 32 + 8 * fq) = w;
            }
        }
    }
};

struct EpiKVup {
    static constexpr bool PERM = true, AFTER_DRAIN = false;
    bf16_t* kvm; const float* ss_ckv;
    __device__ __forceinline__ void operator()(const f32x4 (&acc)[2][2][4][2], const pg8::Unit& u, int wr, int wc, int fr, int fq) const {
        LAS float* sc = epi_row_scales<4>(ss_ckv, u.pm, wr, wc, fr, fq, 1.0f / 128.0f, 1.0f);
        EPI_LOOP_ROWS {
            const int row = u.pm * 256 + ai * 128 + wr * 64 + m * 16 + fr;
            const float rs = sc[ai * 64 + m * 16 + fr];
#pragma unroll
            for (int bj = 0; bj < 2; ++bj) {
                const f32x4 v0 = acc[ai][bj][m][0] * rs, v1 = acc[ai][bj][m][1] * rs;
                u32x4 w; w.x = pk2(v0[0], v0[1]); w.y = pk2(v0[2], v0[3]); w.z = pk2(v1[0], v1[1]); w.w = pk2(v1[2], v1[3]);
                *(u32x4*)(kvm + (size_t)row * KVP + u.pn * 256 + bj * 128 + wc * 32 + 8 * fq) = w;
            }
        }
    }
};

struct EpiResid {
    static constexpr bool PERM = true, AFTER_DRAIN = false;
    bf16_t* xb; float* ss;
    __device__ __forceinline__ void operator()(const f32x4 (&acc)[2][2][4][2], const pg8::Unit& u, int wr, int wc, int fr, int fq) const {
        EPI_LOOP_ROWS {
            const int row = u.pm * 256 + ai * 128 + wr * 64 + m * 16 + fr;
            float sq = 0.f;
#pragma unroll
            for (int bj = 0; bj < 2; ++bj) {
                bf16_t* p = xb + (size_t)row * D + u.pn * 256 + bj * 128 + wc * 32 + 8 * fq;
                const u32x4 a = *(const u32x4*)p;
                f32x4 v0, v1;
                v0[0] = __builtin_bit_cast(float, a.x << 16); v0[1] = __builtin_bit_cast(float, a.x & 0xffff0000u); v0[2] = __builtin_bit_cast(float, a.y << 16); v0[3] = __builtin_bit_cast(float, a.y & 0xffff0000u);
                v1[0] = __builtin_bit_cast(float, a.z << 16); v1[1] = __builtin_bit_cast(float, a.z & 0xffff0000u); v1[2] = __builtin_bit_cast(float, a.w << 16); v1[3] = __builtin_bit_cast(float, a.w & 0xffff0000u);
                v0 = v0 + acc[ai][bj][m][0]; v1 = v1 + acc[ai][bj][m][1];
                u32x4 w; w.x = pk2(v0[0], v0[1]); w.y = pk2(v0[2], v0[3]); w.z = pk2(v1[0], v1[1]); w.w = pk2(v1[2], v1[3]);
                *(u32x4*)p = w;
                sq += dot4(v0) + dot4(v1);
            }
            sq += __shfl_xor(sq, 16); sq += __shfl_xor(sq, 32);
            if (fq == 0) ss[(size_t)row * 16 + u.pn * 4 + wc] = sq;
        }
    }
};

struct EpiFF1 {
    static constexpr bool PERM = true, AFTER_DRAIN = false;
    bf16_t* h; const float* ss;
    __device__ __forceinline__ void operator()(const f32x4 (&acc)[2][2][4][2], const pg8::Unit& u, int wr, int wc, int fr, int fq) const {
        LAS float* sc = epi_row_scales<16>(ss, u.pm, wr, wc, fr, fq, 1.0f / 1024.0f, 1.0f);
        EPI_LOOP_ROWS {
            const int row = u.pm * 256 + ai * 128 + wr * 64 + m * 16 + fr;
            const float rs = sc[ai * 64 + m * 16 + fr];
#pragma unroll
            for (int bj = 0; bj < 2; ++bj) {
                f32x4 v0 = acc[ai][bj][m][0] * rs, v1 = acc[ai][bj][m][1] * rs;
#pragma unroll
                for (int j = 0; j < 4; ++j) { const float a = fmaxf(v0[j], 0.f), b = fmaxf(v1[j], 0.f); v0[j] = a * a; v1[j] = b * b; }
                u32x4 w; w.x = pk2(v0[0], v0[1]); w.y = pk2(v0[2], v0[3]); w.z = pk2(v1[0], v1[1]); w.w = pk2(v1[2], v1[3]);
                *(u32x4*)(h + (size_t)row * FF + u.pn * 256 + bj * 128 + wc * 32 + 8 * fq) = w;
            }
        }
    }
};

template <class Epi>
__device__ __forceinline__ void run_gemm(LAS unsigned char* lds, const bf16_t* A, int lda, const bf16_t* Bt, int N, int K, const Epi& E, bool mirror = false) {
    asm volatile("" : "+s"(N), "+s"(K), "+s"(lda));
    const int gd = gdim_(), bi = bid_();
    pg8::Gemm g{A, Bt, M, N, K, lda}; pg8::StaticOrder S; S.init(M, N, gd, mirror ? gd - 1 - bi : bi);
    pg8::gemm_phase<Epi, pg8::StaticOrder, true, true>(lds, g, S, E);
}

__device__ __forceinline__ int colmap(int mode, int n) {
    if (mode == 0) return n;
    if (mode == 1) {
        if (n < 256) return 1170 + n;
        if (n < 384) return 1426 + (n - 256);
        if (n < 416) return 1554 + (n - 384);
        if (n < 434) return 1152 + (n - 416);
        if (n < 512) return -1;
        if (n < 896) return n - 512;
        if (n < 1664) return 384 + (n - 896);
        if (n < 1920) return 1586 + (n - 1664);
        return -1;
    }
    if (mode == 2) {
        if (n < 384) return (n >> 6) * 128 + (n & 63);
        return ((n - 384) >> 6) * 128 + 64 + ((n - 384) & 63);
    }
    return n < 576 ? n : -1;
}
__device__ __forceinline__ void convert_tile(const float* src, int srcPitch, int K, bf16_t* dst, const float* rowscale, int mode, int n0, int k0, LAS float* tile, int tid) {
#pragma unroll
    for (int i = 0; i < 8; ++i) {
        const int kk = (tid >> 6) + 8 * i, nn = tid & 63; const int sc = colmap(mode, n0 + nn);
        float v = 0.f;
        if (sc >= 0) { v = src[(size_t)(k0 + kk) * srcPitch + sc]; if (rowscale) v *= rowscale[k0 + kk]; }
        tile[kk * 65 + nn] = v;
    }
    __syncthreads();
    { const int nn = tid >> 3, kc = (tid & 7) * 8; const LAS float* s = tile + kc * 65 + nn;
      u32x4 o; o.x = pk2(s[0], s[65]); o.y = pk2(s[2 * 65], s[3 * 65]); o.z = pk2(s[4 * 65], s[5 * 65]); o.w = pk2(s[6 * 65], s[7 * 65]);
      *(u32x4*)(dst + (size_t)(n0 + nn) * K + k0 + kc) = o; }
    __syncthreads();
}

__device__ __forceinline__ void prologue(const Params& P, LAS unsigned char* lds) {
    const int tid = tid_(), bid = bid_(), gdim = gdim_(), lane = tid & 63, wave = tid >> 6;
    const int gw = bid * 8 + wave, NGW = gdim * 8;
    unsigned char* ws = P.ws;
    if (bid == 0) { for (int i = tid; i < 2048; i += 512) ((unsigned*)(ws + WS_CTL))[i] = 0u; }
    { const float* x = P.in[0]; bf16_t* xb = (bf16_t*)(ws + WS_XB); float* ss0 = (float*)(ws + WS_XPART);
      for (int r = gw; r < M; r += 2 * NGW) {
          const int r2 = r + NGW;
          const f32x4* xr = (const f32x4*)(x + (size_t)r * D) + lane; const f32x4* xr2 = (const f32x4*)(x + (size_t)(r2 < M ? r2 : r) * D) + lane;
          f32x4 v[4], w[4]; float sa = 0.f, sb = 0.f;
#pragma unroll
          for (int j = 0; j < 4; ++j) { v[j] = xr[64 * j]; w[j] = xr2[64 * j]; }
#pragma unroll
          for (int j = 0; j < 4; ++j) { sa += dot4(v[j]); sb += dot4(w[j]); }
          sa = wave_sum(sa); sb = wave_sum(sb);
          if (lane < 16) ss0[(size_t)r * 16 + lane] = (lane == 0) ? sa : 0.f;
          u32x2* o = (u32x2*)(xb + (size_t)r * D) + lane;
#pragma unroll
          for (int j = 0; j < 4; ++j) { u32x2 t; t.x = pk2(v[j][0], v[j][1]); t.y = pk2(v[j][2], v[j][3]); o[64 * j] = t; }
          if (r2 < M) {
              if (lane < 16) ss0[(size_t)r2 * 16 + lane] = (lane == 0) ? sb : 0.f;
              u32x2* o2 = (u32x2*)(xb + (size_t)r2 * D) + lane;
#pragma unroll
              for (int j = 0; j < 4; ++j) { u32x2 t; t.x = pk2(w[j][0], w[j][1]); t.y = pk2(w[j][2], w[j][3]); o2[64 * j] = t; }
          }
      } }
    { const int* pos = (const int*)P.in[1]; float* rc = (float*)(ws + WS_ROPE); float* rsn = rc + (size_t)M * 16;
      const float INV[16] = {1.0f, 0.5623413324356079f, 0.3162277638912201f, 0.17782793939113617f, 0.10000000149011612f, 0.05623413249850273f, 0.03162277489900589f, 0.017782794311642647f,
                             0.009999999776482582f, 0.005623413249850273f, 0.003162277629598975f, 0.0017782794311642647f, 0.0010000000474974513f, 0.000562341301701963f, 0.0003162277571391314f, 0.00017782794020604342f};
      for (int i = bid * 512 + tid; i < M * 16; i += gdim * 512) {
          const int r = i >> 4, k = i & 15; float inv = INV[0];
#pragma unroll
          for (int q = 1; q < 16; ++q) inv = (k == q) ? INV[q] : inv;
          const float ang = (float)pos[r] * inv;
          double rev = (double)ang * 0.15915494309189535; rev -= floor(rev);
          const float fr = (float)rev;
          rc[i] = __builtin_amdgcn_cosf(fr); rsn[i] = __builtin_amdgcn_sinf(fr);
      } }
    { float* bp = (float*)(ws + WS_BIASP);
      for (int it = gw; it < DEPTH * 2 * 32; it += NGW) {
          const int lk = it >> 5, ch = it & 31; const float* pp = P.in[4] + (size_t)lk * 2048 + ch * 64; const float* w1 = P.in[5] + (size_t)lk * 2048 * 64 + (size_t)ch * 64 * 64;
          float s = 0.f;
          for (int k = 0; k < 64; ++k) s += pp[k] * w1[k * 64 + lane];
          bp[it * 64 + lane] = s;
      } }
    { LAS float* tile = (LAS float*)lds;
      constexpr int C_IN = 32 * 16, C_OUT = 16 * 16, C_F1 = 64 * 16, C_F2 = 16 * 64, C_QU = 12 * 4, C_KV = 12 * 2, C_W1 = 2 * 32, C_W2 = 2, C_WP = 4;
      constexpr int PER_L = C_IN + C_OUT + C_F1 + C_F2 + C_QU + C_KV + C_W1 + C_W2 + C_WP;
      for (int it = bid; it < DEPTH * PER_L; it += gdim) {
          const int l = it / PER_L; int r = it % PER_L;
          if (r < C_IN) { convert_tile(P.in[3] + (size_t)l * D * P_IN, P_IN, D, (bf16_t*)(ws + WS_WIN) + (size_t)l * ZP * D, P.in[2] + l * D, 1, (r >> 4) * 64, (r & 15) * 64, tile, tid); continue; } r -= C_IN;
          if (r < C_OUT) { convert_tile(P.in[13] + (size_t)l * D * D, D, D, (bf16_t*)(ws + WS_WOUT) + (size_t)l * D * D, nullptr, 0, (r >> 4) * 64, (r & 15) * 64, tile, tid); continue; } r -= C_OUT;
          if (r < C_F1) { convert_tile(P.in[15] + (size_t)l * D * FF, FF, D, (bf16_t*)(ws + WS_WFF1) + (size_t)l * FF * D, P.in[14] + l * D, 0, (r >> 4) * 64, (r & 15) * 64, tile, tid); continue; } r -= C_F1;
          if (r < C_F2) { convert_tile(P.in[16] + (size_t)l * FF * D, D, FF, (bf16_t*)(ws + WS_WFF2) + (size_t)l * D * FF, nullptr, 0, (r >> 6) * 64, (r & 63) * 64, tile, tid); continue; } r -= C_F2;
          if (r < C_QU) { convert_tile(P.in[8] + (size_t)l * 256 * 576, 576, 256, (bf16_t*)(ws + WS_WQUP) + (size_t)l * 768 * 256, P.in[7] + l * 256, 3, (r >> 2) * 64, (r & 3) * 64, tile, tid); continue; } r -= C_QU;
          if (r < C_KV) { convert_tile(P.in[10] + (size_t)l * 128 * 768, 768, 128, (bf16_t*)(ws + WS_WKVUP) + (size_t)l * 768 * 128, P.in[9] + l * 128, 2, (r >> 1) * 64, (r & 1) * 64, tile, tid); continue; } r -= C_KV;
          if (r < C_W1) { const int kv = r >> 5, kt = r & 31; convert_tile(P.in[5] + (size_t)(l * 2 + kv) * 2048 * 64, 64, 2048, (bf16_t*)(ws + WS_W1T) + (size_t)(l * 2 + kv) * 64 * 2048, nullptr, 0, 0, kt * 64, tile, tid); continue; } r -= C_W1;
          if (r < C_W2) { convert_tile(P.in[6] + (size_t)(l * 2 + r) * 64 * 64, 64, 64, (bf16_t*)(ws + WS_W2T) + (size_t)(l * 2 + r) * 64 * 64, nullptr, 0, 0, 0, tile, tid); continue; } r -= C_W2;
          convert_tile(P.in[11] + (size_t)(l * 4 + r) * 64 * 64, 64, 64, (bf16_t*)(ws + WS_WPT) + (size_t)(l * 4 + r) * 64 * 64, nullptr, 0, 0, 0, tile, tid);
      } }
}

#define MFMA16(a, b, c) __builtin_amdgcn_mfma_f32_16x16x32_bf16((a), (b), (c), 0, 0, 0)
#define MFMA32(a, b, c) __builtin_amdgcn_mfma_f32_32x32x16_bf16((a), (b), (c), 0, 0, 0)

__device__ __forceinline__ float gelu_tanh(float x) {
    const float u = 0.7978845608028654f * (x + 0.044715f * x * x * x);
    const float e = __expf(2.f * u);
    const float th = 1.f - 2.f / (e + 1.f);
    return 0.5f * x * (1.f + th);
}

__device__ __forceinline__ void compress_phase(const Params& P, int layer, LAS unsigned char* lds) {
    const int tid = tid_(), bid = bid_(), gdim = gdim_(), lane = tid & 63, wave = tid >> 6, sub = wave >> 2, et = wave & 3;
    const int l16 = lane & 15, quad = lane >> 4;
    unsigned char* ws = P.ws;
    const bf16_t* z = (const bf16_t*)(ws + WS_Z);
    bf16_t* kc = (bf16_t*)(ws + WS_KCMP);
    const float* bp = (const float*)(ws + WS_BIASP);
    LAS bf16_t* hb = (LAS bf16_t*)lds + sub * (16 * 72);
    for (int bi = bid; bi < 256; bi += gdim) {
        const int id = bi * 2 + sub, kv = id >> 8, rest = id & 255, b = rest >> 5, g = (rest >> 4) & 1, n0 = (rest & 15) * 16;
        const bf16_t* w1t = (const bf16_t*)(ws + WS_W1T) + ((size_t)(layer * 2 + kv) * 64 + 16 * et + l16) * 2048 + 8 * quad;
        const bf16_t* w2t = (const bf16_t*)(ws + WS_W2T) + ((size_t)(layer * 2 + kv) * 64 + 16 * et + l16) * 64 + 8 * quad;
        const int n = n0 + l16;
        const bf16_t* zc = z + Z_NKV + (kv * 2 + g) * 64 + 8 * quad;
        f32x4 acc = {0.f, 0.f, 0.f, 0.f};
#pragma unroll 4
        for (int l = 0; l < 32; ++l) {
            int tok = 16 * n + l; tok = tok > T - 1 ? T - 1 : tok;
            const bf16_t* ar = zc + (size_t)(b * T + tok) * ZP;
#pragma unroll
            for (int dh = 0; dh < 2; ++dh) {
                const bf16x8 a = *(const bf16x8*)(ar + 32 * dh);
                const bf16x8 bb = *(const bf16x8*)(w1t + l * 64 + 32 * dh);
                acc = MFMA16(a, bb, acc);
            }
        }
        float bsum = 0.f;
        for (int ch = 0; ch < 32; ++ch) bsum += bp[((size_t)(layer * 2 + kv) * 32 + ch) * 64 + 16 * et + l16];
#pragma unroll
        for (int j = 0; j < 4; ++j) hb[(4 * quad + j) * 72 + 16 * et + l16] = (bf16_t)f2bf(gelu_tanh(acc[j] + bsum));
        __syncthreads();
        f32x4 acc2 = {0.f, 0.f, 0.f, 0.f};
#pragma unroll
        for (int ks = 0; ks < 2; ++ks) {
            const bf16x8 a = *(const LAS bf16x8*)(hb + l16 * 72 + 32 * ks + 8 * quad);
            const bf16x8 bb = *(const bf16x8*)(w2t + 32 * ks);
            acc2 = MFMA16(a, bb, acc2);
        }
#pragma unroll
        for (int j = 0; j < 4; ++j) {
            const int nr = n0 + 4 * quad + j;
            kc[((size_t)((kv * NB + b) * 2 + g) * 256 + nr) * 64 + 16 * et + l16] = (bf16_t)(nr < 255 ? f2bf(acc2[j]) : 0u);
        }
        __syncthreads();
    }
}

__device__ __forceinline__ void pool_phase(const Params& P, int layer) {
    const int tid = tid_(), bid = bid_(), gdim = gdim_(), lane = tid & 63, wave = tid >> 6, l16 = lane & 15, quad = lane >> 4;
    unsigned char* ws = P.ws;
    const bf16_t* z = (const bf16_t*)(ws + WS_Z);
    bf16_t* mix = (bf16_t*)(ws + WS_MIX);
    const float* psc = P.in[12] + layer * 256;
    for (int wi = bid * 8 + wave; wi < (M / 16) * 4; wi += gdim * 8) {
        const int tt = wi >> 2, gi = wi & 3, w = 2 << gi;
        const int row = tt * 16 + l16, t = row & (T - 1);
        const int cnt = (t + 1 < w) ? t + 1 : w; const float icnt = 1.0f / (float)cnt;
        const bf16_t* wpt = (const bf16_t*)(ws + WS_WPT) + ((size_t)(layer * 4 + gi) * 64 + l16) * 64 + 8 * quad;
        f32x4 acc[4];
#pragma unroll
        for (int dt = 0; dt < 4; ++dt) acc[dt] = (f32x4){0.f, 0.f, 0.f, 0.f};
#pragma unroll
        for (int ks = 0; ks < 2; ++ks) {
            const bf16_t* ur = z + (size_t)row * ZP + Z_PU + gi * 64 + 32 * ks + 8 * quad;
            float s[8];
#pragma unroll
            for (int j = 0; j < 8; ++j) s[j] = 0.f;
            for (int i = 0; i < w; ++i) {
                if (i < cnt) {
                    const bf16x8 v = *(const bf16x8*)(ur - (size_t)i * ZP);
#pragma unroll
                    for (int j = 0; j < 8; ++j) s[j] += bf2f((unsigned short)v[j]);
                }
            }
            const bf16x8 u0 = *(const bf16x8*)ur;
            u32x4 pa;
            pa.x = pk2(s[0] * icnt - bf2f((unsigned short)u0[0]), s[1] * icnt - bf2f((unsigned short)u0[1]));
            pa.y = pk2(s[2] * icnt - bf2f((unsigned short)u0[2]), s[3] * icnt - bf2f((unsigned short)u0[3]));
            pa.z = pk2(s[4] * icnt - bf2f((unsigned short)u0[4]), s[5] * icnt - bf2f((unsigned short)u0[5]));
            pa.w = pk2(s[6] * icnt - bf2f((unsigned short)u0[6]), s[7] * icnt - bf2f((unsigned short)u0[7]));
            const bf16x8 a = __builtin_bit_cast(bf16x8, pa);
#pragma unroll
            for (int dt = 0; dt < 4; ++dt) {
                const bf16x8 bb = *(const bf16x8*)(wpt + (size_t)dt * 16 * 64 + 32 * ks);
                acc[dt] = MFMA16(a, bb, acc[dt]);
            }
        }
#pragma unroll
        for (int dt = 0; dt < 4; ++dt) {
            const float sc = psc[gi * 64 + 16 * dt + l16];
#pragma unroll
            for (int j = 0; j < 4; ++j) mix[(size_t)(tt * 16 + 4 * quad + j) * D + 768 + gi * 64 + 16 * dt + l16] = (bf16_t)f2bf(acc[dt][j] * sc);
        }
    }
}

#ifndef SLC_ELEM_MASK
#define SLC_ELEM_MASK 0
#endif
#ifndef USE_NEGM
#define USE_NEGM 1
#endif
#ifndef KPREF
#define KPREF 1
#endif
#ifndef STAGGER
#define STAGGER 0
#endif
constexpr int AG = 4, NSA_G = 2;
constexpr int AL_WSF = 0, AL_BC = 2048, AL_T0 = 2304, AL_VSZ = 9216;
constexpr int AL_IMP = AL_T0 + AG * 2 * 9216, AL_SCORE = AL_IMP + 6 * 8192, AL_SEL = AL_SCORE + 16384;
static_assert(AL_SEL + 512 <= LDS_BYTES - 64 && AL_T0 + AG * (13312 + 9216) <= LDS_BYTES - 64, "attention LDS map");
constexpr int VPB = 144;

__device__ __forceinline__ s16x4 vtr(const LAS unsigned char* p) { return __builtin_bit_cast(s16x4, __builtin_amdgcn_ds_read_tr16_b64_v4i16((LAS v4i16_t*)p)); }

template <int NDC, int KPB>
__device__ __forceinline__ void qk_tile(f32x16& p0, f32x16& p1, const LAS unsigned char* Kt, const bf16x8* qf, const f32x16& cinit, int r, int h) {
    const LAS unsigned char* kb = Kt + r * KPB + h * 16;
    bf16x8 ka[NDC], kc[NDC];
#pragma unroll
    for (int c = 0; c < NDC; ++c) { ka[c] = *(const LAS bf16x8*)(kb + c * 32); kc[c] = *(const LAS bf16x8*)(kb + 32 * KPB + c * 32); }
    if constexpr (NDC == 4) asm volatile("" : "+v"(ka[0]), "+v"(ka[1]), "+v"(ka[2]), "+v"(ka[3]), "+v"(kc[0]), "+v"(kc[1]), "+v"(kc[2]), "+v"(kc[3]));
    else asm volatile("" : "+v"(ka[0]), "+v"(ka[1]), "+v"(ka[2]), "+v"(ka[3]), "+v"(ka[4]), "+v"(ka[5]), "+v"(kc[0]), "+v"(kc[1]), "+v"(kc[2]), "+v"(kc[3]), "+v"(kc[4]), "+v"(kc[5]));
    p0 = MFMA32(ka[0], qf[0], cinit); p1 = MFMA32(kc[0], qf[0], cinit);
#pragma unroll
    for (int c = 1; c < NDC; ++c) { p0 = MFMA32(ka[c], qf[c], p0); p1 = MFMA32(kc[c], qf[c], p1); }
}

template <int NDC, int KPB>
__device__ __forceinline__ void k_load(bf16x8 (&kf)[2 * NDC], const LAS unsigned char* Kt, int r, int h) {
    const LAS unsigned char* kb = Kt + r * KPB + h * 16;
#pragma unroll
    for (int c = 0; c < NDC; ++c) { kf[2 * c] = *(const LAS bf16x8*)(kb + c * 32); kf[2 * c + 1] = *(const LAS bf16x8*)(kb + 32 * KPB + c * 32); }
}
template <int NDC>
__device__ __forceinline__ void qk_mma(f32x16& p0, f32x16& p1, bf16x8 (&kf)[2 * NDC], const bf16x8* qf, const f32x16& cinit) {
    if constexpr (NDC == 4) asm volatile("" : "+v"(kf[0]), "+v"(kf[1]), "+v"(kf[2]), "+v"(kf[3]), "+v"(kf[4]), "+v"(kf[5]), "+v"(kf[6]), "+v"(kf[7]));
    else asm volatile("" : "+v"(kf[0]), "+v"(kf[1]), "+v"(kf[2]), "+v"(kf[3]), "+v"(kf[4]), "+v"(kf[5]), "+v"(kf[6]), "+v"(kf[7]), "+v"(kf[8]), "+v"(kf[9]), "+v"(kf[10]), "+v"(kf[11]));
    __builtin_amdgcn_s_setprio(1);
    p0 = MFMA32(kf[0], qf[0], cinit); p1 = MFMA32(kf[1], qf[0], cinit);
#pragma unroll
    for (int c = 1; c < NDC; ++c) { p0 = MFMA32(kf[2 * c], qf[c], p0); p1 = MFMA32(kf[2 * c + 1], qf[c], p1); }
    __builtin_amdgcn_s_setprio(0);
}
__device__ __forceinline__ bf16x8 pack8(const f32x16& p, int s, unsigned pmask) {
    u32x4 w; w.x = pk2(p[8 * s], p[8 * s + 1]) & pmask; w.y = pk2(p[8 * s + 2], p[8 * s + 3]) & pmask; w.z = pk2(p[8 * s + 4], p[8 * s + 5]) & pmask; w.w = pk2(p[8 * s + 6], p[8 * s + 7]) & pmask;
    return __builtin_bit_cast(bf16x8, w);
}

__device__ __forceinline__ void pv_load(s16x4 (&vf)[16], const LAS unsigned char* Vt, int lane) {
    const int i16 = lane & 15, q4 = i16 >> 2, p4 = i16 & 3, blk = (lane >> 4) & 1, h = lane >> 5;
    const LAS unsigned char* vb = Vt + (4 * h + q4) * VPB + blk * 32 + p4 * 8;
#pragma unroll
    for (int ks = 0; ks < 4; ++ks) {
        vf[4 * ks + 0] = vtr(vb + (16 * ks) * VPB); vf[4 * ks + 1] = vtr(vb + (16 * ks + 8) * VPB);
        vf[4 * ks + 2] = vtr(vb + (16 * ks) * VPB + 64); vf[4 * ks + 3] = vtr(vb + (16 * ks + 8) * VPB + 64);
    }
}
__device__ __forceinline__ void pv_pin(s16x4 (&vf)[16], f32x16& p0, f32x16& p1) {
    asm volatile("s_nop 15\n\ts_nop 7" : "+v"(p0), "+v"(p1));
    asm volatile("" : "+v"(vf[0]), "+v"(vf[1]), "+v"(vf[2]), "+v"(vf[3]), "+v"(vf[4]), "+v"(vf[5]), "+v"(vf[6]), "+v"(vf[7]),
                      "+v"(vf[8]), "+v"(vf[9]), "+v"(vf[10]), "+v"(vf[11]), "+v"(vf[12]), "+v"(vf[13]), "+v"(vf[14]), "+v"(vf[15]));
}
template <bool MASKED>
__device__ __forceinline__ void pv_mma(f32x16& o0, f32x16& o1, const f32x16& p0, const f32x16& p1, const s16x4 (&vf)[16], unsigned pmask) {
#pragma unroll
    for (int ks = 0; ks < 4; ++ks) {
        const bf16x8 pa = (ks < 2) ? pack8(p0, ks & 1, MASKED ? pmask : 0xffffffffu) : pack8(p1, ks & 1, MASKED ? pmask : 0xffffffffu);
        const bf16x8 v0 = __builtin_shufflevector(vf[4 * ks + 0], vf[4 * ks + 1], 0, 1, 2, 3, 4, 5, 6, 7);
        const bf16x8 v1 = __builtin_shufflevector(vf[4 * ks + 2], vf[4 * ks + 3], 0, 1, 2, 3, 4, 5, 6, 7);
        __builtin_amdgcn_s_setprio(1);
        o0 = MFMA32(pa, v0, o0);
        o1 = MFMA32(pa, v1, o1);
        __builtin_amdgcn_s_setprio(0);
    }
}

__device__ __forceinline__ float max3f(float a, float b, float c) { float r; asm("v_max3_f32 %0, %1, %2, %3" : "=v"(r) : "v"(a), "v"(b), "v"(c)); return r; }
__device__ __forceinline__ float tile_rowmax(const f32x16& p0, const f32x16& p1) {
    float a = max3f(p0[0], p0[1], p1[0]), b = max3f(p0[2], p0[3], p1[1]); a = max3f(a, p1[2], p1[3]);
#pragma unroll
    for (int i = 4; i < 16; i += 4) { a = max3f(a, p0[i], p0[i + 1]); b = max3f(b, p0[i + 2], p0[i + 3]); a = max3f(a, p1[i], p1[i + 1]); b = max3f(b, p1[i + 2], p1[i + 3]); }
    float m; asm("v_max_f32_e32 %0, %1, %2" : "=v"(m) : "v"(a), "v"(b));
    const auto rr = __builtin_amdgcn_permlane32_swap(__float_as_uint(m), __float_as_uint(m), false, false);
    float res; asm("v_max_f32_e32 %0, %1, %2" : "=v"(res) : "v"(__uint_as_float(rr[0])), "v"(__uint_as_float(rr[1])));
    return res;
}

template <bool IMPR>
__device__ __forceinline__ void softmax_step(f32x16& p0, f32x16& p1, bool lane_on, float& mref, f32x16& negm, float& l, f32x16& o0, f32x16& o1, LAS float* wsf, int r, int h, LAS float* impw) {
    float rm = tile_rowmax(p0, p1);
    rm = lane_on ? rm : -INFINITY;
    if (__any(rm > 12.0f)) {
        const float dl = fmaxf(rm, 0.f);
        mref += dl;
        const float alpha = fast_exp2(-dl);
        l *= alpha;
        if (h == 0) wsf[r] = alpha;
        asm volatile("" ::: "memory");
#pragma unroll
        for (int i = 0; i < 16; ++i) { const float a = wsf[crow(i, h)]; o0[i] *= a; o1[i] *= a; p0[i] -= dl; p1[i] -= dl; negm[i] = -mref; }
        if (IMPR) {
            asm volatile("" ::: "memory");
#pragma unroll 8
            for (int j = 0; j < 32; ++j) impw[r * 64 + 2 * j + h] *= alpha;
            asm volatile("" ::: "memory");
        }
    }
    float s0 = 0.f, s1 = 0.f, s2 = 0.f, s3 = 0.f;
#pragma unroll
    for (int i = 0; i < 16; i += 2) { p0[i] = fast_exp2(p0[i]); p1[i] = fast_exp2(p1[i]); p0[i + 1] = fast_exp2(p0[i + 1]); p1[i + 1] = fast_exp2(p1[i + 1]); s0 += p0[i]; s1 += p1[i]; s2 += p0[i + 1]; s3 += p1[i + 1]; }
    l += lane_on ? ((s0 + s1) + (s2 + s3)) : 0.f;
}

enum { MODE_MLA = 0, MODE_WIN = 1, MODE_SLC = 2, MODE_CMP1 = 3, MODE_CMP2 = 4 };

template <int MODE>
__device__ __forceinline__ void attn_tile(bf16x8 (&kpre)[(MODE == MODE_MLA) ? 12 : 8], bool have_pre, const LAS unsigned char* Knext, const LAS unsigned char* Kt, const LAS unsigned char* Vt, int t, int ti, const bf16x8* qf, int qpos, int cblk, unsigned long long sel,
                                          float& mref, f32x16& negm, float& l, f32x16& o0, f32x16& o1, float pscale, float pgate, LAS float* impw, LAS float* wsf, int lane) {
    constexpr int KPB = (MODE == MODE_MLA) ? 208 : 144;
    constexpr int NDC = (MODE == MODE_MLA) ? 6 : 4;
    const int r = lane & 31, h = lane >> 5;
    bool on = true;
    if (MODE == MODE_SLC) { on = (sel >> t) & 1ull; if (!__any((int)on)) return; }
    f32x16 p0, p1;
    PT_BEGIN(11);
    if (!have_pre) k_load<NDC, KPB>(kpre, Kt, r, h);
    if (MODE == MODE_CMP1) { f32x16 zz; for (int i = 0; i < 16; ++i) zz[i] = 0.f; qk_mma<NDC>(p0, p1, kpre, qf, zz); }
    else qk_mma<NDC>(p0, p1, kpre, qf, negm);
    if (Knext) k_load<NDC, KPB>(kpre, Knext, r, h);
    s16x4 vf[16];
    if (MODE != MODE_CMP1) pv_load(vf, Vt, lane);
    pv_pin(vf, p0, p1);
    const int kb = 64 * t + 4 * h;
    if (MODE == MODE_MLA) {
        if (64 * t + 63 > (qpos - r)) {
#pragma unroll
            for (int i = 0; i < 16; ++i) { const int kv = kb + (i & 3) + 8 * (i >> 2); if (kv > qpos) p0[i] = -INFINITY; if (kv + 32 > qpos) p1[i] = -INFINITY; }
        }
    } else if (MODE == MODE_WIN) {
        if (t == cblk || t == cblk - 8) {
#pragma unroll
            for (int i = 0; i < 16; ++i) { const int kv = kb + (i & 3) + 8 * (i >> 2);
                if (kv > qpos || kv <= qpos - 512) p0[i] = -INFINITY; if (kv + 32 > qpos || kv + 32 <= qpos - 512) p1[i] = -INFINITY; }
        }
    } else if (MODE == MODE_SLC) {
#if SLC_ELEM_MASK
        if (t == cblk || !__all((int)on)) {
#pragma unroll
            for (int i = 0; i < 16; ++i) { const int kv = kb + (i & 3) + 8 * (i >> 2); if (!on || kv > qpos) p0[i] = -INFINITY; if (!on || kv + 32 > qpos) p1[i] = -INFINITY; }
        }
        on = true;
#else
        if (t == cblk) {
#pragma unroll
            for (int i = 0; i < 16; ++i) { const int kv = kb + (i & 3) + 8 * (i >> 2); if (kv > qpos) p0[i] = -INFINITY; if (kv + 32 > qpos) p1[i] = -INFINITY; }
        }
#endif
    } else {
#pragma unroll
        for (int i = 0; i < 16; ++i) { const int kv = kb + (i & 3) + 8 * (i >> 2);
            if (16 * kv + 31 > qpos) p0[i] = -INFINITY; if (16 * (kv + 32) + 31 > qpos) p1[i] = -INFINITY; }
    }
    PT_END(11);
    if (MODE == MODE_CMP1) {
        const float rm = tile_rowmax(p0, p1);
        const float mnew = fmaxf(mref, rm);
        const float ms = (mnew == -INFINITY) ? 0.f : mnew;
        const float alpha = (mnew == -INFINITY) ? 1.f : fast_exp2(mref - mnew);
        float sm = 0.f;
#pragma unroll
        for (int i = 0; i < 16; ++i) sm += fast_exp2(p0[i] - ms) + fast_exp2(p1[i] - ms);
        l = l * alpha + sm; mref = mnew;
    } else if (MODE == MODE_CMP2) {
        softmax_step<true>(p0, p1, true, mref, negm, l, o0, o1, wsf, r, h, impw);
        LAS float* iw = impw + r * 64 + 16 * ti + h;
#pragma unroll
        for (int k = 0; k < 4; ++k) { iw[2 * k] += (p0[4 * k] + p0[4 * k + 1]) + (p0[4 * k + 2] + 0.5f * p0[4 * k + 3]); iw[8 + 2 * k] += (p1[4 * k] + p1[4 * k + 1]) + (p1[4 * k + 2] + 0.5f * p1[4 * k + 3]); }
        asm volatile("" ::: "memory");
#pragma unroll
        for (int k = 0; k < 4; ++k) { iw[2 * k + 1] += 0.5f * p0[4 * k + 3]; if (16 * ti + h + 8 + 2 * k + 1 < 64) iw[8 + 2 * k + 1] += 0.5f * p1[4 * k + 3]; }
        asm volatile("" ::: "memory");
        pv_mma<false>(o0, o1, p0, p1, vf, 0xffffffffu);
    } else {
        { PT_BEGIN(12);
        softmax_step<false>(p0, p1, on, mref, negm, l, o0, o1, wsf, r, h, impw);
        PT_END(12); }
        { PT_BEGIN(13);
        pv_mma<MODE == MODE_SLC>(o0, o1, p0, p1, vf, on ? 0xffffffffu : 0u);
        PT_END(13); }
    }
}

template <int MODE, int G>
__device__ __forceinline__ void attn_branch(LAS unsigned char* L, const bf16_t* kS, int kP, const bf16_t* vS, int vP, const bf16_t* rS, int rP,
                                            int t0, int t1, bool preloaded, const bf16x8* qf, int qpos, bool active, int wlo, int whi, int cblk, unsigned long long sel,
                                            float& mref, f32x16& negm, float& l, f32x16& o0, f32x16& o1, float pscale, float pgate, LAS float* impw, LAS float* wsf, int tid) {
    constexpr int KPB = (MODE == MODE_MLA) ? 208 : 144;
    constexpr int KSZ = 64 * KPB;
    constexpr bool DB = (2 * G <= AG);
    const int lane = tid & 63;
    const int srow = tid >> 3, sch = tid & 7;
    const int nsteps = (t1 - t0 + G - 1) / G;
    u32x4 kreg[G], vreg[G], rreg[G];
    bf16x8 kpre[(MODE == MODE_MLA) ? 12 : 8];
#define AB_LOAD(s_) do { _Pragma("unroll") for (int j_ = 0; j_ < G; ++j_) { const int t_ = t0 + (s_) * G + j_; if (t_ < t1) { \
        const size_t row_ = (size_t)t_ * 64 + srow; kreg[j_] = *(const u32x4*)(kS + row_ * kP + sch * 8); vreg[j_] = *(const u32x4*)(vS + row_ * vP + sch * 8); \
        if (MODE == MODE_MLA) { if (tid < 256) rreg[j_] = *(const u32x4*)(rS + ((size_t)t_ * 64 + (tid >> 2)) * rP + (tid & 3) * 8); } } } } while (0)
#define AB_STORE(s_) do { _Pragma("unroll") for (int j_ = 0; j_ < G; ++j_) { const int t_ = t0 + (s_) * G + j_; if (t_ < t1) { const int jj_ = (DB ? ((s_) & 1) * G : 0) + j_; \
        *(LAS u32x4*)(L + AL_T0 + jj_ * KSZ + srow * KPB + sch * 16) = kreg[j_]; *(LAS u32x4*)(L + AL_T0 + AG * KSZ + jj_ * AL_VSZ + srow * VPB + sch * 16) = vreg[j_]; \
        if (MODE == MODE_MLA) { if (tid < 256) *(LAS u32x4*)(L + AL_T0 + jj_ * KSZ + (tid >> 2) * KPB + 128 + (tid & 3) * 16) = rreg[j_]; } } } } while (0)
    if (!preloaded && nsteps > 0) { AB_LOAD(0); AB_STORE(0); }
    __syncthreads();
    for (int s = 0; s < nsteps; ++s) {
        if (s + 1 < nsteps) AB_LOAD(s + 1);
        PT_BEGIN(7);
        if (STAGGER && (tid >> 8)) __builtin_amdgcn_s_sleep(STAGGER);
        bool have_pre = false;
        const int jb = DB ? (s & 1) * G : 0;
#pragma unroll
        for (int j = 0; j < G; ++j) {
            const int t = t0 + s * G + j;
            const bool run = active && t < t1 && t >= wlo && t <= whi && (MODE != MODE_SLC || __any((int)((sel >> t) & 1ull)));
            const int tn = t + 1;
            const bool runn = KPREF && (j + 1 < G) && active && tn < t1 && tn >= wlo && tn <= whi && (MODE != MODE_SLC || __any((int)((sel >> tn) & 1ull)));
            if (run)
                attn_tile<MODE>(kpre, have_pre, runn ? (const LAS unsigned char*)(L + AL_T0 + (jb + j + 1) * KSZ) : (const LAS unsigned char*)nullptr, L + AL_T0 + (jb + j) * KSZ, L + AL_T0 + AG * KSZ + (jb + j) * AL_VSZ, t, t - t0, qf, qpos, cblk, sel, mref, negm, l, o0, o1, pscale, pgate, impw, wsf, lane);
            have_pre = run && runn;
        }
        PT_END(7);
        if (DB) {
            if (s + 1 < nsteps) AB_STORE(s + 1);
            __syncthreads();
        } else {
            __syncthreads();
            if (s + 1 < nsteps) { AB_STORE(s + 1); __syncthreads(); }
        }
    }
#undef AB_LOAD
#undef AB_STORE
}

__device__ __forceinline__ void branch_finish(f32x16& out0, f32x16& out1, const f32x16& o0, const f32x16& o1, float l, float gate, LAS float* wsf, int r, int h) {
    const float lt = l + __shfl_xor(l, 32);
    const float f = lt > 0.f ? gate / lt : 0.f;
    if (h == 0) wsf[r] = f;
    asm volatile("" ::: "memory");
#pragma unroll
    for (int i = 0; i < 16; ++i) { const float a = wsf[crow(i, h)]; out0[i] += o0[i] * a; out1[i] += o1[i] * a; }
    asm volatile("" ::: "memory");
}

__device__ __forceinline__ void branch_finish_lds(LAS float* obuf, bool active, const f32x16& o0, const f32x16& o1, float l, float gate, LAS float* wsf, int r, int h) {
    const float lt = l + __shfl_xor(l, 32);
    const float f = lt > 0.f ? gate / lt : 0.f;
    if (h == 0) wsf[r] = f;
    asm volatile("" ::: "memory");
    if (active) {
#pragma unroll
        for (int i = 0; i < 16; ++i) { const int qq = crow(i, h); const float a = wsf[qq]; obuf[qq * 64] += o0[i] * a; obuf[qq * 64 + 32] += o1[i] * a; }
    }
    asm volatile("" ::: "memory");
}
__device__ __forceinline__ float sigmoidf_(float x) { return 1.f / (1.f + __expf(-x)); }

__device__ __forceinline__ void nsa_unit(const Params& P, LAS unsigned char* L, int b, int g, int c) {
    const int tid = tid_(), lane = tid & 63, wave = __builtin_amdgcn_readfirstlane(tid >> 6), r = lane & 31, h = lane >> 5;
    unsigned char* ws = P.ws;
    const bf16_t* z = (const bf16_t*)(ws + WS_Z);
    const bf16_t* kcmp = (const bf16_t*)(ws + WS_KCMP);
    bf16_t* mix = (bf16_t*)(ws + WS_MIX);
    const bool active = wave < 6;
    const int hh = active ? (wave >> 1) : 0, qh = wave & 1, head = 3 * g + hh;
    const int q0 = 64 * c, qpos = q0 + 32 * qh + r;
    const size_t qrow = (size_t)b * T + qpos;
    LAS float* wsf = (LAS float*)(L + AL_WSF) + wave * 64;
    LAS float* impw = (LAS float*)(L + AL_IMP) + (active ? wave : 0) * 2048;
    bf16x8 qf[4];
#pragma unroll
    for (int cc = 0; cc < 4; ++cc) qf[cc] = *(const bf16x8*)(z + qrow * ZP + Z_NQ + head * 64 + 16 * cc + 8 * h);
    const bf16_t* gp = z + qrow * ZP + Z_GATE + head * 3;
    const float g_cmp = sigmoidf_(bf2f(gp[0])), g_slc = sigmoidf_(bf2f(gp[1])), g_win = sigmoidf_(bf2f(gp[2]));
    f32x16 out0, out1, o0, o1, negm;
#pragma unroll
    for (int i = 0; i < 16; ++i) { out0[i] = 0.f; out1[i] = 0.f; o0[i] = 0.f; o1[i] = 0.f; negm[i] = 0.f; }
    const int ntc = (4 * c + 3 + 63) >> 6;
    const bf16_t* kc = kcmp + (size_t)((0 * NB + b) * 2 + g) * 256 * 64;
    const bf16_t* vc = kcmp + (size_t)((1 * NB + b) * 2 + g) * 256 * 64;
    float m1 = 0.f, l1 = 0.f;
    PT_BEGIN(3);
    if (active) { for (int i = lane; i < 2048; i += 64) impw[i] = 0.f; }
    attn_branch<MODE_CMP2, AG>(L, kc, 64, vc, 64, nullptr, 0, 0, ntc, false, qf, qpos, active, 0, ntc, c, 0ull, m1, negm, l1, o0, o1, 0.f, 0.f, impw, wsf, tid);
    { const float lt = l1 + __shfl_xor(l1, 32); const float inv = lt > 0.f ? 1.f / lt : 0.f;
      if (h == 0) wsf[32 + r] = inv;
      branch_finish(out0, out1, o0, o1, l1, g_cmp, wsf, r, h); }
    __syncthreads();
    PT_END(3);
    {
        PT_BEGIN(4);
        LAS float* imp = (LAS float*)(L + AL_IMP); LAS float* sc = (LAS float*)(L + AL_SCORE); LAS unsigned long long* selL = (LAS unsigned long long*)(L + AL_SEL);
        const int q = tid >> 3, part = tid & 7;
        float my[8];
#pragma unroll
        for (int j = 0; j < 8; ++j) { const int s = part * 8 + j; const int o = (q >> 5) * 2048 + (q & 31) * 64 + s;
            const LAS float* wl = (const LAS float*)(L + AL_WSF) + (q >> 5) * 64 + 32 + (q & 31);
            const float v = (imp[o] * wl[0] + imp[o + 2 * 2048] * wl[2 * 64]) + imp[o + 4 * 2048] * wl[4 * 64];
            my[j] = (s > c) ? -1.f : ((s == 0 || s == c || s == c - 1) ? 1.0e4f : v);
            sc[q * 64 + s] = my[j]; }
        __syncthreads();
        int rank[8];
#pragma unroll
        for (int j = 0; j < 8; ++j) rank[j] = 0;
        if (c >= 16) {
            for (int s2 = 0; s2 <= c; ++s2) { const float v = sc[q * 64 + s2];
#pragma unroll
                for (int j = 0; j < 8; ++j) rank[j] += (v > my[j] || (v == my[j] && s2 < part * 8 + j)) ? 1 : 0; }
        }
        unsigned bits = 0;
#pragma unroll
        for (int j = 0; j < 8; ++j) if (part * 8 + j <= c && rank[j] < 16) bits |= 1u << j;
        unsigned lo = (part < 4) ? (bits << (8 * part)) : 0u, hi = (part >= 4) ? (bits << (8 * (part - 4))) : 0u;
        lo |= __shfl_xor(lo, 1); hi |= __shfl_xor(hi, 1); lo |= __shfl_xor(lo, 2); hi |= __shfl_xor(hi, 2); lo |= __shfl_xor(lo, 4); hi |= __shfl_xor(hi, 4);
        if (part == 0) selL[q] = ((unsigned long long)hi << 32) | lo;
        __syncthreads();
        PT_END(4);
    }
    const unsigned long long sel = ((LAS unsigned long long*)(L + AL_SEL))[32 * qh + r];
    LAS float* obuf = impw + r;
    if (active) {
#pragma unroll
        for (int i = 0; i < 16; ++i) { obuf[crow(i, h) * 64] = out0[i]; obuf[crow(i, h) * 64 + 32] = out1[i]; }
    }
    {
        const bf16_t* ks = z + (size_t)b * T * ZP + Z_NKV + ((1 * 2 + 0) * 2 + g) * 64;
        const bf16_t* vs = z + (size_t)b * T * ZP + Z_NKV + ((1 * 2 + 1) * 2 + g) * 64;
        float m = 0.f, l = 0.f;
#pragma unroll
        for (int i = 0; i < 16; ++i) { o0[i] = 0.f; o1[i] = 0.f; }
        PT_BEGIN(5);
        attn_branch<MODE_SLC, NSA_G>(L, ks, ZP, vs, ZP, nullptr, 0, 0, c + 1, false, qf, qpos, active, 0, c, c, sel, m, negm, l, o0, o1, 0.f, 0.f, impw, wsf, tid);
        branch_finish_lds(obuf, active, o0, o1, l, g_slc, wsf, r, h);
        PT_END(5);
    }
    {
        const bf16_t* kw = z + (size_t)b * T * ZP + Z_NKV + ((2 * 2 + 0) * 2 + g) * 64;
        const bf16_t* vw = z + (size_t)b * T * ZP + Z_NKV + ((2 * 2 + 1) * 2 + g) * 64;
        float m = 0.f, l = 0.f;
#pragma unroll
        for (int i = 0; i < 16; ++i) { o0[i] = 0.f; o1[i] = 0.f; negm[i] = 0.f; }
        const int tb = c >= 8 ? c - 8 : 0;
        PT_BEGIN(6);
        attn_branch<MODE_WIN, NSA_G>(L, kw, ZP, vw, ZP, nullptr, 0, tb, c + 1, false, qf, qpos, active, tb, c, c, 0ull, m, negm, l, o0, o1, 0.f, 0.f, impw, wsf, tid);
        branch_finish_lds(obuf, active, o0, o1, l, g_win, wsf, r, h);
        PT_END(6);
    }
    if (active) {
        bf16_t* op = mix + ((size_t)b * T + q0 + 32 * qh) * D + head * 64 + r;
#pragma unroll
        for (int i = 0; i < 16; ++i) { const int qq = crow(i, h); op[(size_t)qq * D] = (bf16_t)f2bf(obuf[qq * 64]); op[(size_t)qq * D + 32] = (bf16_t)f2bf(obuf[qq * 64 + 32]); }
    }
    __syncthreads();
}

__device__ __forceinline__ void mla_unit(const Params& P, LAS unsigned char* L, int b, int hd, int qb) {
    const int tid = tid_(), lane = tid & 63, wave = __builtin_amdgcn_readfirstlane(tid >> 6), r = lane & 31, h = lane >> 5;
    unsigned char* ws = P.ws;
    const bf16_t* z = (const bf16_t*)(ws + WS_Z);
    const bf16_t* qm = (const bf16_t*)(ws + WS_QM);
    const bf16_t* kvm = (const bf16_t*)(ws + WS_KVM);
    bf16_t* mix = (bf16_t*)(ws + WS_MIX);
    const int q0 = 256 * qb, qpos = q0 + 32 * wave + r;
    const size_t qrow = (size_t)b * T + qpos;
    LAS float* wsf = (LAS float*)(L + AL_WSF) + wave * 64;
    bf16x8 qf[6];
#pragma unroll
    for (int cc = 0; cc < 6; ++cc) qf[cc] = *(const bf16x8*)(qm + qrow * QMP + hd * 96 + 16 * cc + 8 * h);
    f32x16 o0, o1, out0, out1, negm;
#pragma unroll
    for (int i = 0; i < 16; ++i) { o0[i] = 0.f; o1[i] = 0.f; negm[i] = 0.f; }
    float m = 0.f, l = 0.f;
    const bf16_t* kS = kvm + (size_t)b * T * KVP + hd * 64;
    const bf16_t* vS = kvm + (size_t)b * T * KVP + 384 + hd * 64;
    const bf16_t* rS = z + (size_t)b * T * ZP + Z_KR;
    const int nt = 4 * qb + 4, whi = (q0 + 32 * wave + 31) >> 6;
    attn_branch<MODE_MLA, 2>(L, kS, KVP, vS, KVP, rS, ZP, 0, nt, false, qf, qpos, true, 0, whi, 0, 0ull, m, negm, l, o0, o1, 0.f, 0.f, wsf, wsf, tid);
    { const float lt = l + __shfl_xor(l, 32); const float f = lt > 0.f ? 1.f / lt : 0.f;
      if (h == 0) wsf[r] = f;
      asm volatile("" ::: "memory");
#pragma unroll
      for (int i = 0; i < 16; ++i) { const float a = wsf[crow(i, h)]; out0[i] = o0[i] * a; out1[i] = o1[i] * a; } }
    bf16_t* op = mix + ((size_t)b * T + q0 + 32 * wave) * D + 384 + hd * 64 + r;
#pragma unroll
    for (int i = 0; i < 16; ++i) { const int qq = crow(i, h); op[(size_t)qq * D] = (bf16_t)f2bf(out0[i]); op[(size_t)qq * D + 32] = (bf16_t)f2bf(out1[i]); }
}

constexpr int Q_NSA = 128, Q_MLA = 96, Q_UNITS = Q_NSA + Q_MLA;
__device__ const unsigned char Q_ORDER[Q_UNITS] = {63, 127, 62, 126, 61, 125, 60, 124, 59, 123, 58, 122, 57, 121, 56, 120, 55, 119, 54, 118, 53, 117, 52, 116, 51, 115, 50, 114, 49, 113, 48, 112, 47, 111, 46, 110, 45, 109, 44, 108, 43, 107, 42, 106, 41, 105, 40, 104, 39, 103, 38, 102, 37, 101, 36, 100, 35, 99, 34, 98, 33, 97, 32, 96, 31, 95, 30, 94, 29, 93, 143, 159, 175, 191, 207, 223, 28, 92, 27, 91, 26, 90, 142, 158, 174, 190, 206, 222, 25, 89, 24, 88, 23, 87, 141, 157, 173, 189, 205, 221, 22, 86, 21, 85, 140, 156, 172, 188, 204, 220, 20, 84, 19, 83, 18, 82, 139, 155, 171, 187, 203, 219, 17, 81, 16, 80, 138, 154, 170, 186, 202, 218, 15, 79, 14, 78, 13, 77, 137, 153, 169, 185, 201, 217, 12, 76, 11, 75, 136, 152, 168, 184, 200, 216, 10, 74, 9, 73, 8, 72, 135, 151, 167, 183, 199, 215, 7, 71, 134, 150, 166, 182, 198, 214, 6, 70, 5, 69, 133, 149, 165, 181, 197, 213, 4, 68, 132, 148, 164, 180, 196, 212, 3, 67, 131, 147, 163, 179, 195, 211, 2, 66, 1, 65, 130, 146, 162, 178, 194, 210, 0, 64, 129, 145, 161, 177, 193, 209, 128, 144, 160, 176, 192, 208};
__device__ __forceinline__ unsigned xcc_id_() { return (unsigned)__builtin_amdgcn_s_getreg((3 << 11) | 20) & 0x7u; }
__device__ __forceinline__ void attention_phase(const Params& P, int layer, LAS unsigned char* L, int rep) {
    unsigned* ctr = (unsigned*)(P.ws + WS_CTL) + 1024 * rep + 512 * layer;
    LAS unsigned* bc = (LAS unsigned*)(L + AL_BC);
    const int x = (int)xcc_id_();
    for (int dx = 0; dx < 8; ++dx) {
        const int q = (x + dx) & 7;
        for (;;) {
            if (tid_() == 0) bc[0] = __hip_atomic_fetch_add(ctr + 64 * q, 1u, __ATOMIC_RELAXED, __HIP_MEMORY_SCOPE_AGENT);
            __syncthreads();
            const unsigned u = bc[0];
            __syncthreads();
            if (u >= (unsigned)Q_UNITS) break;
            PT_BEGIN(u < (unsigned)Q_NSA ? 1 : 2);
            const unsigned e = Q_ORDER[u];
            if (!(e & 0x80u)) { const int bg = 2 * q + (int)((e >> 6) & 1u), c = (int)(e & 63u); nsa_unit(P, L, bg >> 1, bg & 1, c); }
            else { const int hd = (int)((e >> 4) & 7u), qb = (int)(e & 15u); mla_unit(P, L, q, hd, qb); }
            PT_END(u < (unsigned)Q_NSA ? 1 : 2);
        }
    }
#if PROBE_T && PROBE_T < 20
    if (bid_() == PROBE_BLK && tid_() == 0) { LAS unsigned* pa_ = (LAS unsigned*)(PT_LDS + LDS_BYTES - 32); const unsigned long long w = (unsigned long long)pa_[0] * PROBE_MUL; pa_[0] = 0u;
        const unsigned long long t0 = __builtin_amdgcn_s_memtime(); while (__builtin_amdgcn_s_memtime() - t0 < w) __builtin_amdgcn_s_sleep(8); }
    __syncthreads();
#endif
}

__device__ __forceinline__ void final_phase(const Params& P) {
    const int tid = tid_(), bid = bid_(), gdim = gdim_(), lane = tid & 63, wave = tid >> 6;
    const float* ss = (const float*)(P.ws + WS_XPART) + (size_t)4 * M * 16; const float* gf = P.in[17];
    const bf16_t* xb = (const bf16_t*)(P.ws + WS_XB);
    for (int r = bid * 8 + wave; r < M; r += gdim * 8) {
        const float rs = rsqrtf(row_sum16(ss, r) * (1.0f / 1024.0f) + EPS);
        const u32x2* xr = (const u32x2*)(xb + (size_t)r * D) + lane;
        f32x4* orow = (f32x4*)(P.out + (size_t)r * D) + lane;
#pragma unroll
        for (int j = 0; j < 4; ++j) { const f32x4 gv = *((const f32x4*)gf + lane + 64 * j); const u32x2 a = xr[64 * j];
            f32x4 v; v[0] = __builtin_bit_cast(float, a.x << 16); v[1] = __builtin_bit_cast(float, a.x & 0xffff0000u); v[2] = __builtin_bit_cast(float, a.y << 16); v[3] = __builtin_bit_cast(float, a.y & 0xffff0000u);
            orow[64 * j] = v * rs * gv; }
    }
}

#define XB_TMO      128
#define XB_XCNT(j)  (256  + 64 * (j))
#define XB_XSUB(j)  (1280 + 64 * (j))
#define XB_XGEN(j)  (2304 + 64 * (j))
#define XB_TOP      3328
#define XB_TOPGEN   3392
#define XCD_BAR_WORDS 3456
#define XB_SPIN_CAP (1u << 18)

__device__ __forceinline__ unsigned xb_ld(unsigned* p)              { return __hip_atomic_load(p, __ATOMIC_RELAXED, __HIP_MEMORY_SCOPE_AGENT); }
__device__ __forceinline__ unsigned xb_add(unsigned* p, unsigned v) { return __hip_atomic_fetch_add(p, v, __ATOMIC_RELAXED, __HIP_MEMORY_SCOPE_AGENT); }
__device__ __forceinline__ unsigned xb_xcc_id() { return (unsigned)__builtin_amdgcn_s_getreg((3 << 11) | 20) & 0xFu; }
#define XB_SPIN(cond, bar) do { unsigned _sp = 0; while (cond) { __builtin_amdgcn_s_sleep(1); \
    if ((++_sp & 255u) == 0u) { if (xb_ld(&(bar)[XB_TMO])) break; if (_sp > XB_SPIN_CAP) { atomicAdd(&(bar)[XB_TMO], 1u); break; } } } } while (0)

struct XcdBarrier {
    unsigned* bar; unsigned x;
    volatile LAS unsigned* st;
};

__device__ __forceinline__ XcdBarrier xcd_barrier_post(unsigned* bar, volatile LAS unsigned* st) {
    XcdBarrier b; b.bar = bar; b.x = xb_xcc_id(); b.st = st;
    if (threadIdx.x == 0) (void)xb_add(&bar[XB_XCNT(b.x)], 1u);
    return b;
}
__device__ __forceinline__ void xcd_barrier_complete(unsigned* bar, unsigned x, unsigned& nloc, unsigned& nx) {
    const unsigned G = gridDim.x * gridDim.y * gridDim.z;
    unsigned sum, cnt, mine, sp = 0u;
    for (;;) {
        sum = 0u; cnt = 0u; mine = 0u;
#pragma unroll
        for (unsigned j = 0; j < 16; ++j) { const unsigned c = xb_ld(&bar[XB_XCNT(j)]); sum += c; cnt += (c > 0u) ? 1u : 0u; mine = (j == x) ? c : mine; }
        if (sum == G) break;
        __builtin_amdgcn_s_sleep(1);
        if ((++sp & 255u) == 0u) { if (xb_ld(&bar[XB_TMO])) break; if (sp > XB_SPIN_CAP) { atomicAdd(&bar[XB_TMO], 1u); break; } }
    }
    nloc = mine > 0u ? mine : 1u; nx = cnt > 0u ? cnt : 1u;
}

__device__ __forceinline__ void xcd_barrier(const XcdBarrier& b) {
    asm volatile("s_waitcnt vmcnt(0)" ::: "memory");
    __syncthreads();
    if (threadIdx.x == 0) {
        unsigned* bar = b.bar;
        __builtin_amdgcn_s_waitcnt(0);
        unsigned nloc = b.st[0], nx = b.st[1];
        if (nloc == 0u) { xcd_barrier_complete(bar, b.x, nloc, nx); b.st[0] = nloc; b.st[1] = nx; }
        const unsigned old = xb_add(&bar[XB_XSUB(b.x)], 1u);
        const unsigned gen = old / nloc;
        if (old + 1u == (gen + 1u) * nloc) {
            __builtin_amdgcn_fence(__ATOMIC_RELEASE, "agent");
            asm volatile("s_waitcnt vmcnt(0)" ::: "memory");
            const unsigned og = xb_add(&bar[XB_TOP], 1u);
            const unsigned tg = og / nx;
            if (og + 1u == (tg + 1u) * nx) xb_add(&bar[XB_TOPGEN], 1u);
            else XB_SPIN(xb_ld(&bar[XB_TOPGEN]) == tg, bar);
            __builtin_amdgcn_fence(__ATOMIC_ACQUIRE, "agent");
            xb_add(&bar[XB_XGEN(b.x)], 1u);
            asm volatile("s_waitcnt vmcnt(0)" ::: "memory");
        } else {
            XB_SPIN(xb_ld(&bar[XB_XGEN(b.x)]) == gen, bar);
            __builtin_amdgcn_fence(__ATOMIC_ACQUIRE, "agent");
            asm volatile("s_waitcnt vmcnt(0)" ::: "memory");
        }
    }
    __syncthreads();
}

__device__ __forceinline__ unsigned char* ws_of(const Params& P) { unsigned char* w = P.ws; asm volatile("" : "+s"(w)); return w; }
#ifndef PMASK
#define PMASK 0xffffffffu
#endif
#ifndef PROBE_K
#define PROBE_K 0
#endif
constexpr int N_PHASES_C = 1 + 6 * DEPTH + 1;
__global__ void __launch_bounds__(512) trunk_fwd(Params P, int ph_lo, int ph_hi) {
    extern __shared__ __attribute__((aligned(16))) unsigned char lds_raw[];
    LAS unsigned char* lds = (LAS unsigned char*)lds_raw;
    cg::grid_group grid = cg::this_grid();
    volatile LAS unsigned* bst = (volatile LAS unsigned*)(lds + LDS_BYTES - 64);
    if (threadIdx.x < 16) bst[threadIdx.x] = 0u;
    __syncthreads();
    XcdBarrier bar = xcd_barrier_post((unsigned*)(P.ws + WS_CTL) + 4096, bst);
    if (ph_lo < 0) grid.sync();
    for (int ph = ph_lo; ph < ph_hi; ++ph) {
        const int l = (ph - 1) / 6, k = (ph == 0) ? 0 : ((ph == 1 + 6 * DEPTH) ? 7 : 1 + (ph - 1) % 6);
        PT_BEGIN(20 + k);
        unsigned char* ws = ws_of(P);
        float* xpb = (float*)(ws + WS_XPART); float* cpb = (float*)(ws + WS_CPART);
        if (k == 0) { if (PMASK & 1u) prologue(P, lds); }
        else if (k == 1) { if (PMASK & 2u) {
            const float* ropec = (const float*)(ws + WS_ROPE);
            EpiInProj E{(bf16_t*)(ws + WS_Z), (l == 0) ? xpb : xpb + (size_t)2 * M * 16, cpb + (size_t)(2 * l) * M * 4, cpb + (size_t)(2 * l + 1) * M * 4, ropec, ropec + (size_t)M * 16};
            run_gemm(lds, (const bf16_t*)(ws + WS_XB), D, (const bf16_t*)(ws + WS_WIN) + (size_t)l * ZP * D, ZP, D, E); } }
        else if (k == 2) {
            if (PMASK & 4u) { const float* ropec = (const float*)(ws + WS_ROPE); EpiQup E{(bf16_t*)(ws + WS_QM), cpb + (size_t)(2 * l) * M * 4, ropec, ropec + (size_t)M * 16};
                run_gemm(lds, (const bf16_t*)(ws + WS_Z) + Z_CQ, ZP, (const bf16_t*)(ws + WS_WQUP) + (size_t)l * 768 * 256, 768, 256, E); }
            if (PMASK & 8u) { unsigned char* ws2 = ws_of(P); EpiKVup E{(bf16_t*)(ws2 + WS_KVM), (const float*)(ws2 + WS_CPART) + (size_t)(2 * l + 1) * M * 4};
                run_gemm(lds, (const bf16_t*)(ws2 + WS_Z) + Z_CKV, ZP, (const bf16_t*)(ws2 + WS_WKVUP) + (size_t)l * 768 * 128, 768, 128, E, true); }
            if (PMASK & 16u) compress_phase(P, l, lds);
            if (PMASK & 32u) pool_phase(P, l);
#if PROBE_K == 21
            compress_phase(P, l, lds);
#endif
#if PROBE_K == 22
            pool_phase(P, l);
#endif
        }
        else if (k == 3) { if (PMASK & 64u) { attention_phase(P, l, lds, 0);
#if PROBE_K == 3
            attention_phase(P, l, lds, 1);
#endif
        } }
        else if (k == 4) { if (PMASK & 128u) { EpiResid E{(bf16_t*)(ws + WS_XB), xpb + (size_t)(1 + 2 * l) * M * 16};
            run_gemm(lds, (const bf16_t*)(ws + WS_MIX), D, (const bf16_t*)(ws + WS_WOUT) + (size_t)l * D * D, D, D, E); } }
        else if (k == 5) { if (PMASK & 256u) { EpiFF1 E{(bf16_t*)(ws + WS_H), xpb + (size_t)(1 + 2 * l) * M * 16};
            run_gemm(lds, (const bf16_t*)(ws + WS_XB), D, (const bf16_t*)(ws + WS_WFF1) + (size_t)l * FF * D, FF, D, E); } }
        else if (k == 6) { if (PMASK & 512u) { EpiResid E{(bf16_t*)(ws + WS_XB), xpb + (size_t)(2 + 2 * l) * M * 16};
            run_gemm(lds, (const bf16_t*)(ws + WS_H), FF, (const bf16_t*)(ws + WS_WFF2) + (size_t)l * D * FF, D, FF, E); } }
        else { if (PMASK & 1024u) final_phase(P); }
        if (ph + 1 < ph_hi) xcd_barrier(bar);
        PT_END(20 + k);
#if PROBE_T >= 20
        if (ph == N_PHASES_C - 2) { if (bid_() == PROBE_BLK && tid_() == 0) { LAS unsigned* pa_ = (LAS unsigned*)(PT_LDS + LDS_BYTES - 32); const unsigned long long w = (unsigned long long)pa_[0] * PROBE_MUL; pa_[0] = 0u;
            const unsigned long long t0 = __builtin_amdgcn_s_memtime(); while (__builtin_amdgcn_s_memtime() - t0 < w) __builtin_amdgcn_s_sleep(8); }
            __syncthreads(); xcd_barrier(bar); }
#endif
    }
#if PROBE_T == 27
    if (bid_() == PROBE_BLK && tid_() == 0) { LAS unsigned* pa_ = (LAS unsigned*)(PT_LDS + LDS_BYTES - 32); const unsigned long long w = (unsigned long long)pa_[0] * PROBE_MUL;
        const unsigned long long t0 = __builtin_amdgcn_s_memtime(); while (__builtin_amdgcn_s_memtime() - t0 < w) __builtin_amdgcn_s_sleep(8); }
#endif
}
constexpr int N_PHASES = 1 + 6 * DEPTH + 1;

#ifndef MK_MULTI
#define MK_MULTI 0
#endif
extern "C" void kernel_launch(void* const* d_in, const int* in_sizes, int n_in, void* d_out, int out_size, void* d_ws, size_t ws_size, hipStream_t stream) {
    static int grid_blocks = 0;
    if (grid_blocks == 0) {
        if (n_in != 18 || out_size != M * D || ws_size < WS_END) { fprintf(stderr, "kernel_launch: unexpected shapes (n_in %d out %d ws %zu)\n", n_in, out_size, ws_size); grid_blocks = -1; return; }
        int dev = 0, cus = 0, per_cu = 0;
        hipGetDevice(&dev);
        hipDeviceGetAttribute(&cus, hipDeviceAttributeMultiprocessorCount, dev);
        if (hipFuncSetAttribute((const void*)trunk_fwd, hipFuncAttributeMaxDynamicSharedMemorySize, LDS_BYTES) != hipSuccess) { fprintf(stderr, "kernel_launch: hipFuncSetAttribute failed\n"); grid_blocks = -1; return; }
        if (hipOccupancyMaxActiveBlocksPerMultiprocessor(&per_cu, (const void*)trunk_fwd, 512, LDS_BYTES) != hipSuccess || per_cu < 1) { fprintf(stderr, "kernel_launch: occupancy query gave %d\n", per_cu); per_cu = 1; }
        (void)hipGetLastError();
        grid_blocks = cus * per_cu;
    }
    if (grid_blocks < 0) return;
    Params p{};
    for (int i = 0; i < 18; ++i) p.in[i] = (const float*)d_in[i];
    p.out = (float*)d_out; p.ws = (unsigned char*)d_ws;
    if (hipMemsetAsync(d_ws, 0, 65536, stream) != hipSuccess) { fprintf(stderr, "kernel_launch: memset failed\n"); return; }
    int lo = 0, hi = N_PHASES;
    void* args[] = {&p, &lo, &hi};
    hipError_t e = hipLaunchCooperativeKernel((const void*)trunk_fwd, dim3(grid_blocks), dim3(512), args, LDS_BYTES, stream);
    if (e != hipSuccess) fprintf(stderr, "cooperative launch failed: %s (grid %d)\n", hipGetErrorString(e), grid_blocks);
}
```

```cpp
#include <hip/hip_runtime.h>
#include <hip/hip_cooperative_groups.h>
#include <cstdio>
#include <cstdint>
namespace cg = cooperative_groups;

namespace pg8 {
#define PG8_LAS __attribute__((address_space(3)))
typedef unsigned short bf16_t;
typedef short bf16x8 __attribute__((ext_vector_type(8)));
typedef float f32x4 __attribute__((ext_vector_type(4)));
typedef unsigned u32x4 __attribute__((ext_vector_type(4)));
constexpr int BM = 256, BK = 64, HALF = 128, HTB = HALF * BK * 2  , STAGE_BYTES = 8 * HTB, NXCD = 8, WGM = 8;

__host__ __device__ __forceinline__ int lds_byte(int r, int c) { const int st = (r >> 4) * 2 + (c >> 5), rr = r & 15, cc = c & 31, ob = rr * 64 + cc * 2; return st * 1024 + (ob ^ (((ob >> 9) & 1) << 5)); }
__host__ __device__ __forceinline__ void stage_rc(int b, int& R, int& C) { const int st = b / 1024, sb = b % 1024, swz = sb ^ (((sb >> 9) & 1) << 5); R = (st >> 1) * 16 + swz / 64; C = (st & 1) * 32 + (swz % 64) / 2; }
__host__ __device__ __forceinline__ int perm32(int rho) { const int n = rho >> 4, i = rho & 15; return 8 * (i >> 2) + 4 * n + (i & 3); }

struct Unit { int pm, pn; };
struct Gemm { const bf16_t* A; const bf16_t* Bt; int M, N, K, lda; };
struct StaticOrder {
    int nM, nN, nwg, G, c;
    __host__ __device__ void init(int M, int N, int G_, int c_) { nM = M / BM; nN = N / BM; nwg = nM * nN; G = G_; c = c_; }
    __host__ __device__ bool next(int i, Unit& u) const {
        const long L = (long)i * G + c; if (L >= nwg) return false;
        int wgid = (int)L; { const int q = nwg / NXCD, r = nwg % NXCD, xcd = wgid % NXCD, off = wgid / NXCD; wgid = (xcd < r ? xcd * (q + 1) : r * (q + 1) + (xcd - r) * q) + off; }
        const int nig = WGM * nN, gid = wgid / nig, fm = gid * WGM, gsz = (nM - fm) < WGM ? (nM - fm) : WGM;
        u.pm = fm + ((wgid % nig) % gsz); u.pn = (wgid % nig) / gsz; return true;
    }
    __device__ __forceinline__ void a_ready(const Unit&) const {}
    __device__ __forceinline__ void done(const Unit&) const {}
};
__device__ __forceinline__ unsigned cvt_pk_bf16(float lo, float hi) { unsigned r; asm volatile("v_cvt_pk_bf16_f32 %0, %1, %2" : "=v"(r) : "v"(lo), "v"(hi)); return r; }
template <class Epi, class Sched, bool ALIGN_EPI = false, bool SP2 = false>
__device__ __forceinline__ void gemm_phase(PG8_LAS unsigned char* lds, const Gemm g, const Sched& S, const Epi& E) {
    int tid = threadIdx.x; asm volatile("" : "+v"(tid)); const int wid = __builtin_amdgcn_readfirstlane(tid >> 6), lane = tid & 63, wr = wid >> 2, wc = wid & 3, fr = lane & 15, fq = lane >> 4;
    const int K = g.K, nt = K / BK;
    unsigned voffA[2], voffB[2];
#pragma unroll
    for (int i = 0; i < 2; ++i) { int R, C; stage_rc(tid * 16 + i * 8192, R, C); const int Rb = Epi::PERM ? ((R & ~31) + perm32(R & 31)) : R;
        voffA[i] = (unsigned)(R * g.lda + C) * 2u; voffB[i] = (unsigned)(Rb * K + C) * 2u; }
    const size_t kstep = (size_t)(BK * 2);
    const size_t hstepB = (size_t)HALF * K * 2, hstepA = (size_t)HALF * g.lda * 2;
    const size_t tstepB = 2 * hstepB, tstepA = 2 * hstepA;
    const unsigned ldsw = (unsigned)wid * 1024u;
    const int aoff = lds_byte(wr * 64 + fr, fq * 8), boff = lds_byte(wc * 32 + fr, fq * 8);
#define PG8_SA(b, h) (((b) * 2 + (h)) * HTB)
#define PG8_SB(b, h) ((4 + (b) * 2 + (h)) * HTB)
#define PG8_STAGE(bufoff, gbase, voff) do { _Pragma("unroll") for (int _i = 0; _i < 2; ++_i) \
        __builtin_amdgcn_global_load_lds((const unsigned*)((const char*)(gbase) + (voff)[_i]), (PG8_LAS unsigned*)(lds + (bufoff) + ldsw + _i * 8192), 16, 0, 0); } while (0)
#define PG8_LDA(dst, b, h) do { _Pragma("unroll") for (int m = 0; m < 4; ++m) _Pragma("unroll") for (int k = 0; k < 2; ++k) dst[m][k] = *(const PG8_LAS bf16x8*)(lds + PG8_SA(b, h) + aoff + m * 2048 + k * 1024); } while (0)
#define PG8_LDB(dst, b, h) do { _Pragma("unroll") for (int n = 0; n < 2; ++n) _Pragma("unroll") for (int k = 0; k < 2; ++k) dst[n][k] = *(const PG8_LAS bf16x8*)(lds + PG8_SB(b, h) + boff + n * 2048 + k * 1024); } while (0)
#define PG8_MMA(ai, bj, At, Bt) do { __builtin_amdgcn_s_setprio(1); _Pragma("unroll") for (int m = 0; m < 4; ++m) _Pragma("unroll") for (int n = 0; n < 2; ++n) _Pragma("unroll") for (int k = 0; k < 2; ++k) \
        acc[ai][bj][m][n] = __builtin_amdgcn_mfma_f32_16x16x32_bf16(Bt[n][k], At[m][k], acc[ai][bj][m][n], 0, 0, 0); __builtin_amdgcn_s_setprio(0); } while (0)
#define PG8_WAIT_V(n) asm volatile("s_waitcnt vmcnt(" #n ")" ::: "memory")
#define PG8_WAIT_L(n) asm volatile("s_waitcnt lgkmcnt(" #n ")" ::: "memory")
#define PG8_BAR __builtin_amdgcn_s_barrier()
#define PG8_SCHED __builtin_amdgcn_sched_barrier(0)
    Unit cur, nxt; int ui = 0;
    if (!S.next(0, cur)) return;
    f32x4 acc[2][2][4][2];
#pragma unroll
    for (int a = 0; a < 2; ++a)
#pragma unroll
        for (int b = 0; b < 2; ++b)
#pragma unroll
            for (int m = 0; m < 4; ++m)
#pragma unroll
                for (int n = 0; n < 2; ++n) acc[a][b][m][n] = (f32x4){0.f, 0.f, 0.f, 0.f};
    bf16x8 At[4][2], B0[2][2], B1[2][2];
    const char* cA = (const char*)g.A + (size_t)cur.pm * tstepA; const char* cB = (const char*)g.Bt + (size_t)cur.pn * tstepB;
    S.a_ready(cur);
    if constexpr (SP2) {
        PG8_STAGE(PG8_SB(0, 0), cB, voffB); PG8_STAGE(PG8_SB(0, 1), cB + hstepB, voffB); PG8_STAGE(PG8_SA(0, 0), cA, voffA); PG8_STAGE(PG8_SA(0, 1), cA + hstepA, voffA);
        if (wr == 1) PG8_BAR;
        PG8_WAIT_V(2); PG8_BAR;
        PG8_STAGE(PG8_SB(1, 0), cB + kstep, voffB); PG8_STAGE(PG8_SA(1, 0), cA + kstep, voffA); PG8_STAGE(PG8_SB(1, 1), cB + hstepB + kstep, voffB);
        PG8_WAIT_V(6); PG8_BAR;
    } else {
        PG8_STAGE(PG8_SB(0, 0), cB, voffB); PG8_STAGE(PG8_SA(0, 0), cA, voffA); PG8_STAGE(PG8_SB(0, 1), cB + hstepB, voffB); PG8_STAGE(PG8_SA(0, 1), cA + hstepA, voffA);
        if (wr == 1) PG8_BAR;
        PG8_WAIT_V(4); PG8_BAR;
        PG8_STAGE(PG8_SB(1, 0), cB + kstep, voffB); PG8_STAGE(PG8_SA(1, 0), cA + kstep, voffA); PG8_STAGE(PG8_SB(1, 1), cB + hstepB + kstep, voffB);
        PG8_WAIT_V(6); PG8_BAR;
    }
    for (;;) {
        const bool has_next = S.next(ui + 1, nxt);
        const char* nA = has_next ? (const char*)g.A + (size_t)nxt.pm * tstepA : cA; const char* nB = has_next ? (const char*)g.Bt + (size_t)nxt.pn * tstepB : cB;
        for (int t = 0; t < nt; t += 2) {
            const bool last = (t == nt - 2);
            const char* a1 = cA + (size_t)(t + 1) * kstep;
            const char* a2 = last ? nA : cA + (size_t)(t + 2) * kstep; const char* b2 = last ? nB : cB + (size_t)(t + 2) * kstep;
            const char* a3 = a2 + kstep; const char* b3 = b2 + kstep;
            if (last && has_next) S.a_ready(nxt);
            if constexpr (SP2) {
            PG8_LDB(B0, 0, 0); PG8_LDB(B1, 0, 1); PG8_SCHED; PG8_LDA(At, 0, 0); PG8_STAGE(PG8_SA(1, 1), a1 + hstepA, voffA);
            PG8_WAIT_V(8); PG8_WAIT_L(0); PG8_BAR; PG8_MMA(0, 0, At, B0); PG8_MMA(0, 1, At, B1); PG8_BAR; PG8_SCHED;
            PG8_LDA(At, 0, 1); PG8_STAGE(PG8_SB(0, 0), b2, voffB); PG8_STAGE(PG8_SB(0, 1), b2 + hstepB, voffB); PG8_STAGE(PG8_SA(0, 0), a2, voffA);
            PG8_WAIT_V(8); PG8_WAIT_L(0); PG8_BAR; PG8_MMA(1, 0, At, B0); PG8_MMA(1, 1, At, B1); PG8_BAR; PG8_SCHED;
            PG8_LDB(B0, 1, 0); PG8_LDB(B1, 1, 1); PG8_SCHED; PG8_LDA(At, 1, 0); PG8_STAGE(PG8_SA(0, 1), a2 + hstepA, voffA);
            PG8_WAIT_V(8); PG8_WAIT_L(0); PG8_BAR; PG8_MMA(0, 0, At, B0); PG8_MMA(0, 1, At, B1); PG8_BAR; PG8_SCHED;
            PG8_LDA(At, 1, 1); PG8_STAGE(PG8_SB(1, 0), b3, voffB); PG8_STAGE(PG8_SB(1, 1), b3 + hstepB, voffB); PG8_STAGE(PG8_SA(1, 0), a3, voffA);
            PG8_WAIT_V(8); PG8_WAIT_L(0); PG8_BAR; PG8_MMA(1, 0, At, B0); PG8_MMA(1, 1, At, B1); PG8_BAR; PG8_SCHED;
            } else {
            PG8_LDB(B0, 0, 0); PG8_SCHED; PG8_LDA(At, 0, 0); PG8_STAGE(PG8_SA(1, 1), a1 + hstepA, voffA);
            PG8_WAIT_L(8); PG8_BAR; PG8_WAIT_L(0); PG8_MMA(0, 0, At, B0); PG8_BAR; PG8_SCHED;
            PG8_LDB(B1, 0, 1); PG8_STAGE(PG8_SB(0, 0), b2, voffB);
            PG8_BAR; PG8_WAIT_L(0); PG8_MMA(0, 1, At, B1); PG8_BAR;
            PG8_LDA(At, 0, 1); PG8_STAGE(PG8_SA(0, 0), a2, voffA);
            PG8_BAR; PG8_WAIT_L(0); PG8_MMA(1, 0, At, B0); PG8_BAR; PG8_SCHED;
            PG8_STAGE(PG8_SB(0, 1), b2 + hstepB, voffB);
            PG8_WAIT_V(6); PG8_BAR; PG8_MMA(1, 1, At, B1); PG8_BAR;
            PG8_LDB(B0, 1, 0); PG8_SCHED; PG8_LDA(At, 1, 0); PG8_STAGE(PG8_SA(0, 1), a2 + hstepA, voffA);
            PG8_WAIT_L(8); PG8_BAR; PG8_WAIT_L(0); PG8_MMA(0, 0, At, B0); PG8_BAR; PG8_SCHED;
            PG8_LDB(B1, 1, 1); PG8_STAGE(PG8_SB(1, 0), b3, voffB);
            PG8_BAR; PG8_WAIT_L(0); PG8_MMA(0, 1, At, B1); PG8_BAR;
            PG8_LDA(At, 1, 1); PG8_STAGE(PG8_SA(1, 0), a3, voffA);
            PG8_BAR; PG8_WAIT_L(0); PG8_MMA(1, 0, At, B0); PG8_BAR; PG8_SCHED;
            PG8_STAGE(PG8_SB(1, 1), b3 + hstepB, voffB);
            PG8_WAIT_V(6); PG8_BAR; PG8_MMA(1, 1, At, B1); PG8_BAR;
            }
        }
        if constexpr (ALIGN_EPI) { if (wr == 0) PG8_BAR; }
        if constexpr (!Epi::AFTER_DRAIN) { E(acc, cur, wr, wc, fr, fq); S.done(cur); }
        if (!has_next) break;
#pragma unroll
        for (int a = 0; a < 2; ++a)
#pragma unroll
            for (int b = 0; b < 2; ++b)
#pragma unroll
                for (int m = 0; m < 4; ++m)
#pragma unroll
                    for (int n = 0; n < 2; ++n) acc[a][b][m][n] = (f32x4){0.f, 0.f, 0.f, 0.f};
        cur = nxt; cA = nA; cB = nB; ++ui;
        if constexpr (ALIGN_EPI) { if (wr == 1) PG8_BAR; }
    }
    PG8_WAIT_V(0);
    if constexpr (!ALIGN_EPI) { if (wr == 0) PG8_BAR; }
    PG8_BAR;
    if constexpr (Epi::AFTER_DRAIN) { E.fused(acc, cur, wr, wc, fr, fq, lds, wid, lane); S.done(cur); }
#undef PG8_SA
#undef PG8_SB
#undef PG8_STAGE
#undef PG8_LDA
#undef PG8_LDB
#undef PG8_MMA
#undef PG8_WAIT_V
#undef PG8_WAIT_L
#undef PG8_BAR
#undef PG8_SCHED
}
}


#define LAS __attribute__((address_space(3)))
typedef unsigned short bf16_t;
typedef short bf16x8 __attribute__((ext_vector_type(8)));
typedef short s16x4 __attribute__((ext_vector_type(4)));
typedef float f32x4 __attribute__((ext_vector_type(4)));
typedef float f32x16 __attribute__((ext_vector_type(16)));
typedef unsigned u32x4 __attribute__((ext_vector_type(4)));
typedef unsigned u32x2 __attribute__((ext_vector_type(2)));
typedef float f32x2_t __attribute__((ext_vector_type(2)));
typedef __bf16 bf16x2_t __attribute__((ext_vector_type(2)));
typedef short v4i16_t __attribute__((ext_vector_type(4)));

constexpr int NB = 8, T = 4096, M = NB * T, D = 1024, FF = 4096, DEPTH = 2;
constexpr int P_IN = 1842, ZP = 2048;
constexpr int Z_CQ = 0, Z_CKV = 256, Z_KR = 384, Z_GATE = 416, Z_NQ = 512, Z_NKV = 896, Z_PU = 1664;
constexpr int QMP = 768, KVP = 768;
constexpr float EPS = 1e-6f;
constexpr float LOG2E = 1.4426950408889634f;
constexpr float NSA_QS = 0.125f * LOG2E;
constexpr float MLA_QS = 0.10206207261596575f * LOG2E;

constexpr size_t MiB = 1u << 20;
constexpr size_t WS_CTL = 0;
constexpr size_t WS_SS = 1 * MiB;
constexpr size_t WS_ROPE = 3 * MiB;
constexpr size_t WS_BIASP = 7 * MiB;
constexpr size_t WS_KCMP = 7 * MiB + 512 * 1024;
constexpr size_t WS_WIN = 10 * MiB, WS_WOUT = 18 * MiB, WS_WFF1 = 22 * MiB, WS_WFF2 = 38 * MiB, WS_WQUP = 54 * MiB, WS_WKVUP = 55 * MiB;
constexpr size_t WS_W1T = 56 * MiB, WS_W2T = 57 * MiB, WS_WPT = 57 * MiB + 512 * 1024;
constexpr size_t WS_XB = 64 * MiB, WS_MIX = 128 * MiB, WS_H = 192 * MiB, WS_Z = 192 * MiB, WS_QM = 320 * MiB, WS_KVM = 368 * MiB, WS_XPART = 448 * MiB, WS_CPART = 458 * MiB, WS_END = 460 * MiB;

constexpr int LDS_BYTES = 147456;

struct Params { const float* in[18]; float* out; unsigned char* ws; };

__device__ __forceinline__ unsigned f2bf(float f) { unsigned u = __builtin_bit_cast(unsigned, f); return (u + 0x7fffu + ((u >> 16) & 1u)) >> 16; }
__device__ __forceinline__ unsigned pk2(float lo, float hi) { f32x2_t v = {lo, hi}; bf16x2_t b = __builtin_convertvector(v, bf16x2_t); return __builtin_bit_cast(unsigned, b); }
__device__ __forceinline__ float bf2f(unsigned short b) { return __builtin_bit_cast(float, (unsigned)b << 16); }
__device__ __forceinline__ float wave_sum(float v) {
#pragma unroll
    for (int o = 1; o < 64; o <<= 1) v += __shfl_xor(v, o);
    return v;
}
__device__ __forceinline__ int crow(int r, int h) { return (r & 3) + 8 * (r >> 2) + 4 * h; }
__device__ __forceinline__ void atomic_addf(float* p, float v) { __hip_atomic_fetch_add(p, v, __ATOMIC_RELAXED, __HIP_MEMORY_SCOPE_AGENT); }
__device__ __forceinline__ float fast_exp2(float x) { return __builtin_amdgcn_exp2f(x); }

__device__ __forceinline__ int tid_() { int t = threadIdx.x; asm volatile("" : "+v"(t)); return t; }
__device__ __forceinline__ int bid_() { int t = blockIdx.x; asm volatile("" : "+s"(t)); return t; }
__device__ __forceinline__ int gdim_() { int t = gridDim.x; asm volatile("" : "+s"(t)); return t; }
#ifndef PROBE_T
#define PROBE_T 0
#endif
#ifndef PROBE_BLK
#define PROBE_BLK 0
#endif
#ifndef PROBE_TID
#define PROBE_TID 0
#endif
#ifndef PROBE_MUL
#define PROBE_MUL 3
#endif
#if PROBE_T
#define PT_LDS ((LAS unsigned char*)0)
#define PT_BEGIN(tag) unsigned long long pt_t0_ = 0; if ((tag) == PROBE_T) { __builtin_amdgcn_sched_barrier(0); pt_t0_ = __builtin_amdgcn_s_memtime(); __builtin_amdgcn_sched_barrier(0); }
#define PT_END(tag) do { if ((tag) == PROBE_T) { __builtin_amdgcn_sched_barrier(0); const unsigned long long pt_t1_ = __builtin_amdgcn_s_memtime(); __builtin_amdgcn_sched_barrier(0); if (bid_() == PROBE_BLK && tid_() == PROBE_TID) { LAS unsigned* pa_ = (LAS unsigned*)(PT_LDS + LDS_BYTES - 32); pa_[0] += (unsigned)(pt_t1_ - pt_t0_); } } } while (0)
#else
#define PT_BEGIN(tag) do {} while (0)
#define PT_END(tag) do {} while (0)
#endif
#define EPI_LOOP_ROWS  _Pragma("unroll") for (int ai = 0; ai < 2; ++ai) _Pragma("unroll") for (int m = 0; m < 4; ++m) if (epi_fence())
__device__ __forceinline__ bool epi_fence() { asm volatile("" ::: "memory"); return true; }
__device__ __forceinline__ float row_sum16(const float* part, int row) {
    const f32x4* p = (const f32x4*)(part + (size_t)row * 16); const f32x4 a = p[0], b = p[1], c = p[2], d = p[3];
    return (((a[0] + a[1]) + (a[2] + a[3])) + ((b[0] + b[1]) + (b[2] + b[3]))) + (((c[0] + c[1]) + (c[2] + c[3])) + ((d[0] + d[1]) + (d[2] + d[3])));
}
__device__ __forceinline__ float row_sum4(const float* part, int row) { const f32x4 a = *(const f32x4*)(part + (size_t)row * 4); return (a[0] + a[1]) + (a[2] + a[3]); }
template <int NPART>
__device__ __forceinline__ LAS float* epi_row_scales(const float* part, int pm, int wr, int wc, int fr, int fq, float inv_n, float mul) {
    LAS float* sc = (LAS float*)(size_t)131072 + (wr * 4 + wc) * 128;
    const int lane = fq * 16 + fr;
#pragma unroll
    for (int a = 0; a < 2; ++a) {
        const int row = pm * 256 + a * 128 + wr * 64 + lane;
        const float sm = (NPART == 16) ? row_sum16(part, row) : row_sum4(part, row);
        sc[a * 64 + lane] = rsqrtf(sm * inv_n + EPS) * mul;
    }
    asm volatile("" ::: "memory");
    return sc;
}
__device__ __forceinline__ void st_bf4(bf16_t* p, f32x4 v) { u32x2 w; w.x = pk2(v[0], v[1]); w.y = pk2(v[2], v[3]); *(u32x2*)p = w; }
__device__ __forceinline__ float dot4(f32x4 v) { return (v[0] * v[0] + v[1] * v[1]) + (v[2] * v[2] + v[3] * v[3]); }

struct EpiInProj {
    static constexpr bool PERM = true, AFTER_DRAIN = false;
    bf16_t* z; const float* ss_x; float* ss_cq; float* ss_ckv; const float* ropec; const float* ropes;
    __device__ __forceinline__ void operator()(const f32x4 (&acc)[2][2][4][2], const pg8::Unit& u, int wr, int wc, int fr, int fq) const {
        const int pn = u.pn;
        LAS float* sc = epi_row_scales<16>(ss_x, u.pm, wr, wc, fr, fq, 1.0f / 1024.0f, 1.0f);
        EPI_LOOP_ROWS {
            const int row = u.pm * 256 + ai * 128 + wr * 64 + m * 16 + fr;
            const float rs = sc[ai * 64 + m * 16 + fr];
            float sq = 0.f;
#pragma unroll
            for (int bj = 0; bj < 2; ++bj) {
                f32x4 v0 = acc[ai][bj][m][0] * rs, v1 = acc[ai][bj][m][1] * rs;
                const int cb = pn * 256 + bj * 128 + wc * 32;
                if (pn == 0 || (pn == 1 && bj == 0)) sq += dot4(v0) + dot4(v1);
                if (pn == 1 && bj == 1 && wc == 0) {
                    const float* cp = ropec + (size_t)row * 16 + 8 * (fq & 1); const float* sp = ropes + (size_t)row * 16 + 8 * (fq & 1);
                    const f32x4 c0 = *(const f32x4*)cp, c1 = *(const f32x4*)(cp + 4), s0 = *(const f32x4*)sp, s1 = *(const f32x4*)(sp + 4);
                    const float sg = (fq < 2) ? -1.f : 1.f;
                    f32x4 p0v, p1v;
#pragma unroll
                    for (int j = 0; j < 4; ++j) { p0v[j] = __shfl_xor(v0[j], 32); p1v[j] = __shfl_xor(v1[j], 32); }
                    v0 = v0 * c0 + p0v * s0 * sg; v1 = v1 * c1 + p1v * s1 * sg;
                }
                if (cb >= Z_NQ && cb < Z_NKV) { v0 = v0 * NSA_QS; v1 = v1 * NSA_QS; }
                u32x4 w; w.x = pk2(v0[0], v0[1]); w.y = pk2(v0[2], v0[3]); w.z = pk2(v1[0], v1[1]); w.w = pk2(v1[2], v1[3]);
                *(u32x4*)(z + (size_t)row * ZP + cb + 8 * fq) = w;
            }
            if (pn <= 1) {
                sq += __shfl_xor(sq, 16); sq += __shfl_xor(sq, 32);
                if (fq == 0) (pn == 0 ? ss_cq : ss_ckv)[(size_t)row * 4 + wc] = sq;
            }
        }
    }
};

struct EpiQup {
    static constexpr bool PERM = true, AFTER_DRAIN = false;
    bf16_t* qm; const float* ss_cq; const float* ropec; const float* ropes;
    __device__ __forceinline__ void operator()(const f32x4 (&acc)[2][2][4][2], const pg8::Unit& u, int wr, int wc, int fr, int fq) const {
        LAS float* sc = epi_row_scales<4>(ss_cq, u.pm, wr, wc, fr, fq, 1.0f / 256.0f, MLA_QS);
        EPI_LOOP_ROWS {
            const int row = u.pm * 256 + ai * 128 + wr * 64 + m * 16 + fr;
            const float rs = sc[ai * 64 + m * 16 + fr];
#pragma unroll
            for (int bj = 0; bj < 2; ++bj) {
                f32x4 v0 = acc[ai][bj][m][0] * rs, v1 = acc[ai][bj][m][1] * rs;
                const int gi = u.pn * 8 + bj * 4 + wc;
                if (gi % 3 == 2) {
                    const float* cp = ropec + (size_t)row * 16 + 8 * (fq & 1); const float* sp = ropes + (size_t)row * 16 + 8 * (fq & 1);
                    const f32x4 c0 = *(const f32x4*)cp, c1 = *(const f32x4*)(cp + 4), s0 = *(const f32x4*)sp, s1 = *(const f32x4*)(sp + 4);
                    const float sg = (fq < 2) ? -1.f : 1.f;
                    f32x4 p0v, p1v;
#pragma unroll
                    for (int j = 0; j < 4; ++j) { p0v[j] = __shfl_xor(v0[j], 32); p1v[j] = __shfl_xor(v1[j], 32); }
                    v0 = v0 * c0 + p0v * s0 * sg; v1 = v1 * c1 + p1v * s1 * sg;
                }
                u32x4 w; w.x = pk2(v0[0], v0[1]); w.y = pk2(v0[2], v0[3]); w.z = pk2(v1[0], v1[1]); w.w = pk2(v1[2], v1[3]);
                *(u32x4*)(qm + (size_t)row * QMP + gi * 32 + 8 * fq) = w;
            }
        }
    }
};

struct EpiKVup {
    static constexpr bool PERM = true, AFTER_DRAIN = false;
    bf16_t* kvm; const float* ss_ckv;
    __device__ __forceinline__ void operator()(const f32x4 (&acc)[2][2][4][2], const pg8::Unit& u, int wr, int wc, int fr, int fq) const {
        LAS float* sc = epi_row_scales<4>(ss_ckv, u.pm, wr, wc, fr, fq, 1.0f / 128.0f, 1.0f);
        EPI_LOOP_ROWS {
            const int row = u.pm * 256 + ai * 128 + wr * 64 + m * 16 + fr;
            const float rs = sc[ai * 64 + m * 16 + fr];
#pragma unroll
            for (int bj = 0; bj < 2; ++bj) {
                const f32x4 v0 = acc[ai][bj][m][0] * rs, v1 = acc[ai][bj][m][1] * rs;
                u32x4 w; w.x = pk2(v0[0], v0[1]); w.y = pk2(v0[2], v0[3]); w.z = pk2(v1[0], v1[1]); w.w = pk2(v1[2], v1[3]);
                *(u32x4*)(kvm + (size_t)row * KVP + u.pn * 256 + bj * 128 + wc * 32 + 8 * fq) = w;
            }
        }
    }
};

struct EpiResid {
    static constexpr bool PERM = true, AFTER_DRAIN = false;
    bf16_t* xb; float* ss;
    __device__ __forceinline__ void operator()(const f32x4 (&acc)[2][2][4][2], const pg8::Unit& u, int wr, int wc, int fr, int fq) const {
        EPI_LOOP_ROWS {
            const int row = u.pm * 256 + ai * 128 + wr * 64 + m * 16 + fr;
            float sq = 0.f;
#pragma unroll
            for (int bj = 0; bj < 2; ++bj) {
                bf16_t* p = xb + (size_t)row * D + u.pn * 256 + bj * 128 + wc * 32 + 8 * fq;
                const u32x4 a = *(const u32x4*)p;
                f32x4 v0, v1;
                v0[0] = __builtin_bit_cast(float, a.x << 16); v0[1] = __builtin_bit_cast(float, a.x & 0xffff0000u); v0[2] = __builtin_bit_cast(float, a.y << 16); v0[3] = __builtin_bit_cast(float, a.y & 0xffff0000u);
                v1[0] = __builtin_bit_cast(float, a.z << 16); v1[1] = __builtin_bit_cast(float, a.z & 0xffff0000u); v1[2] = __builtin_bit_cast(float, a.w << 16); v1[3] = __builtin_bit_cast(float, a.w & 0xffff0000u);
                v0 = v0 + acc[ai][bj][m][0]; v1 = v1 + acc[ai][bj][m][1];
                u32x4 w; w.x = pk2(v0[0], v0[1]); w.y = pk2(v0[2], v0[3]); w.z = pk2(v1[0], v1[1]); w.w = pk2(v1[2], v1[3]);
                *(u32x4*)p = w;
                sq += dot4(v0) + dot4(v1);
            }
            sq += __shfl_xor(sq, 16); sq += __shfl_xor(sq, 32);
            if (fq == 0) ss[(size_t)row * 16 + u.pn * 4 + wc] = sq;
        }
    }
};

struct EpiFF1 {
    static constexpr bool PERM = true, AFTER_DRAIN = false;
    bf16_t* h; const float* ss;
    __device__ __forceinline__ void operator()(const f32x4 (&acc)[2][2][4][2], const pg8::Unit& u, int wr, int wc, int fr, int fq) const {
        LAS float* sc = epi_row_scales<16>(ss, u.pm, wr, wc, fr, fq, 1.0f / 1024.0f, 1.0f);
        EPI_LOOP_ROWS {
            const int row = u.pm * 256 + ai * 128 + wr * 64 + m * 16 + fr;
            const float rs = sc[ai * 64 + m * 16 + fr];
#pragma unroll
            for (int bj = 0; bj < 2; ++bj) {
                f32x4 v0 = acc[ai][bj][m][0] * rs, v1 = acc[ai][bj][m][1] * rs;
#pragma unroll
                for (int j = 0; j < 4; ++j) { const float a = fmaxf(v0[j], 0.f), b = fmaxf(v1[j], 0.f); v0[j] = a * a; v1[j] = b * b; }
                u32x4 w; w.x = pk2(v0[0], v0[1]); w.y = pk2(v0[2], v0[3]); w.z = pk2(v1[0], v1[1]); w.w = pk2(v1[2], v1[3]);
                *(u32x4*)(h + (size_t)row * FF + u.pn * 256 + bj * 128 + wc * 32 + 8 * fq) = w;
            }
        }
    }
};

template <class Epi>
__device__ __forceinline__ void run_gemm(LAS unsigned char* lds, const bf16_t* A, int lda, const bf16_t* Bt, int N, int K, const Epi& E, bool mirror = false) {
    asm volatile("" : "+s"(N), "+s"(K), "+s"(lda));
    const int gd = gdim_(), bi = bid_();
    pg8::Gemm g{A, Bt, M, N, K, lda}; pg8::StaticOrder S; S.init(M, N, gd, mirror ? gd - 1 - bi : bi);
    pg8::gemm_phase<Epi, pg8::StaticOrder, true, true>(lds, g, S, E);
}

__device__ __forceinline__ int colmap(int mode, int n) {
    if (mode == 0) return n;
    if (mode == 1) {
        if (n < 256) return 1170 + n;
        if (n < 384) return 1426 + (n - 256);
        if (n < 416) return 1554 + (n - 384);
        if (n < 434) return 1152 + (n - 416);
        if (n < 512) return -1;
        if (n < 896) return n - 512;
        if (n < 1664) return 384 + (n - 896);
        if (n < 1920) return 1586 + (n - 1664);
        return -1;
    }
    if (mode == 2) {
        if (n < 384) return (n >> 6) * 128 + (n & 63);
        return ((n - 384) >> 6) * 128 + 64 + ((n - 384) & 63);
    }
    return n < 576 ? n : -1;
}
__device__ __forceinline__ void convert_tile(const float* src, int srcPitch, int K, bf16_t* dst, const float* rowscale, int mode, int n0, int k0, LAS float* tile, int tid) {
#pragma unroll
    for (int i = 0; i < 8; ++i) {
        const int kk = (tid >> 6) + 8 * i, nn = tid & 63; const int sc = colmap(mode, n0 + nn);
        float v = 0.f;
        if (sc >= 0) { v = src[(size_t)(k0 + kk) * srcPitch + sc]; if (rowscale) v *= rowscale[k0 + kk]; }
        tile[kk * 65 + nn] = v;
    }
    __syncthreads();
    { const int nn = tid >> 3, kc = (tid & 7) * 8; const LAS float* s = tile + kc * 65 + nn;
      u32x4 o; o.x = pk2(s[0], s[65]); o.y = pk2(s[2 * 65], s[3 * 65]); o.z = pk2(s[4 * 65], s[5 * 65]); o.w = pk2(s[6 * 65], s[7 * 65]);
      *(u32x4*)(dst + (size_t)(n0 + nn) * K + k0 + kc) = o; }
    __syncthreads();
}

__device__ __forceinline__ void prologue(const Params& P, LAS unsigned char* lds) {
    const int tid = tid_(), bid = bid_(), gdim = gdim_(), lane = tid & 63, wave = tid >> 6;
    const int gw = bid * 8 + wave, NGW = gdim * 8;
    unsigned char* ws = P.ws;
    if (bid == 0) { for (int i = tid; i < 2048; i += 512) ((unsigned*)(ws + WS_CTL))[i] = 0u; }
    { const float* x = P.in[0]; bf16_t* xb = (bf16_t*)(ws + WS_XB); float* ss0 = (float*)(ws + WS_XPART);
      for (int r = gw; r < M; r += 2 * NGW) {
          const int r2 = r + NGW;
          const f32x4* xr = (const f32x4*)(x + (size_t)r * D) + lane; const f32x4* xr2 = (const f32x4*)(x + (size_t)(r2 < M ? r2 : r) * D) + lane;
          f32x4 v[4], w[4]; float sa = 0.f, sb = 0.f;
#pragma unroll
          for (int j = 0; j < 4; ++j) { v[j] = xr[64 * j]; w[j] = xr2[64 * j]; }
#pragma unroll
          for (int j = 0; j < 4; ++j) { sa += dot4(v[j]); sb += dot4(w[j]); }
          sa = wave_sum(sa); sb = wave_sum(sb);
          if (lane < 16) ss0[(size_t)r * 16 + lane] = (lane == 0) ? sa : 0.f;
          u32x2* o = (u32x2*)(xb + (size_t)r * D) + lane;
#pragma unroll
          for (int j = 0; j < 4; ++j) { u32x2 t; t.x = pk2(v[j][0], v[j][1]); t.y = pk2(v[j][2], v[j][3]); o[64 * j] = t; }
          if (r2 < M) {
              if (lane < 16) ss0[(size_t)r2 * 16 + lane] = (lane == 0) ? sb : 0.f;
              u32x2* o2 = (u32x2*)(xb + (size_t)r2 * D) + lane;
#pragma unroll
              for (int j = 0; j < 4; ++j) { u32x2 t; t.x = pk2(w[j][0], w[j][1]); t.y = pk2(w[j][2], w[j][3]); o2[64 * j] = t; }
          }
      } }
    { const int* pos = (const int*)P.in[1]; float* rc = (float*)(ws + WS_ROPE); float* rsn = rc + (size_t)M * 16;
      const float INV[16] = {1.0f, 0.5623413324356079f, 0.3162277638912201f, 0.17782793939113617f, 0.10000000149011612f, 0.05623413249850273f, 0.03162277489900589f, 0.017782794311642647f,
                             0.009999999776482582f, 0.005623413249850273f, 0.003162277629598975f, 0.0017782794311642647f, 0.0010000000474974513f, 0.000562341301701963f, 0.0003162277571391314f, 0.00017782794020604342f};
      for (int i = bid * 512 + tid; i < M * 16; i += gdim * 512) {
          const int r = i >> 4, k = i & 15; float inv = INV[0];
#pragma unroll
          for (int q = 1; q < 16; ++q) inv = (k == q) ? INV[q] : inv;
          const float ang = (float)pos[r] * inv;
          double rev = (double)ang * 0.15915494309189535; rev -= floor(rev);
          const float fr = (float)rev;
          rc[i] = __builtin_amdgcn_cosf(fr); rsn[i] = __builtin_amdgcn_sinf(fr);
      } }
    { float* bp = (float*)(ws + WS_BIASP);
      for (int it = gw; it < DEPTH * 2 * 32; it += NGW) {
          const int lk = it >> 5, ch = it & 31; const float* pp = P.in[4] + (size_t)lk * 2048 + ch * 64; const float* w1 = P.in[5] + (size_t)lk * 2048 * 64 + (size_t)ch * 64 * 64;
          float s = 0.f;
          for (int k = 0; k < 64; ++k) s += pp[k] * w1[k * 64 + lane];
          bp[it * 64 + lane] = s;
      } }
    { LAS float* tile = (LAS float*)lds;
      constexpr int C_IN = 32 * 16, C_OUT = 16 * 16, C_F1 = 64 * 16, C_F2 = 16 * 64, C_QU = 12 * 4, C_KV = 12 * 2, C_W1 = 2 * 32, C_W2 = 2, C_WP = 4;
      constexpr int PER_L = C_IN + C_OUT + C_F1 + C_F2 + C_QU + C_KV + C_W1 + C_W2 + C_WP;
      for (int it = bid; it < DEPTH * PER_L; it += gdim) {
          const int l = it / PER_L; int r = it % PER_L;
          if (r < C_IN) { convert_tile(P.in[3] + (size_t)l * D * P_IN, P_IN, D, (bf16_t*)(ws + WS_WIN) + (size_t)l * ZP * D, P.in[2] + l * D, 1, (r >> 4) * 64, (r & 15) * 64, tile, tid); continue; } r -= C_IN;
          if (r < C_OUT) { convert_tile(P.in[13] + (size_t)l * D * D, D, D, (bf16_t*)(ws + WS_WOUT) + (size_t)l * D * D, nullptr, 0, (r >> 4) * 64, (r & 15) * 64, tile, tid); continue; } r -= C_OUT;
          if (r < C_F1) { convert_tile(P.in[15] + (size_t)l * D * FF, FF, D, (bf16_t*)(ws + WS_WFF1) + (size_t)l * FF * D, P.in[14] + l * D, 0, (r >> 4) * 64, (r & 15) * 64, tile, tid); continue; } r -= C_F1;
          if (r < C_F2) { convert_tile(P.in[16] + (size_t)l * FF * D, D, FF, (bf16_t*)(ws + WS_WFF2) + (size_t)l * D * FF, nullptr, 0, (r >> 6) * 64, (r & 63) * 64, tile, tid); continue; } r -= C_F2;
          if (r < C_QU) { convert_tile(P.in[8] + (size_t)l * 256 * 576, 576, 256, (bf16_t*)(ws + WS_WQUP) + (size_t)l * 768 * 256, P.in[7] + l * 256, 3, (r >> 2) * 64, (r & 3) * 64, tile, tid); continue; } r -= C_QU;
          if (r < C_KV) { convert_tile(P.in[10] + (size_t)l * 128 * 768, 768, 128, (bf16_t*)(ws + WS_WKVUP) + (size_t)l * 768 * 128, P.in[9] + l * 128, 2, (r >> 1) * 64, (r & 1) * 64, tile, tid); continue; } r -= C_KV;
          if (r < C_W1) { const int kv = r >> 5, kt = r & 31; convert_tile(P.in[5] + (size_t)(l * 2 + kv) * 2048 * 64, 64, 2048, (bf16_t*)(ws + WS_W1T) + (size_t)(l * 2 + kv) * 64 * 2048, nullptr, 0, 0, kt * 64, tile, tid); continue; } r -= C_W1;
          if (r < C_W2) { convert_tile(P.in[6] + (size_t)(l * 2 + r) * 64 * 64, 64, 64, (bf16_t*)(ws + WS_W2T) + (size_t)(l * 2 + r) * 64 * 64, nullptr, 0, 0, 0, tile, tid); continue; } r -= C_W2;
          convert_tile(P.in[11] + (size_t)(l * 4 + r) * 64 * 64, 64, 64, (bf16_t*)(ws + WS_WPT) + (size_t)(l * 4 + r) * 64 * 64, nullptr, 0, 0, 0, tile, tid);
      } }
}

#define MFMA16(a, b, c) __builtin_amdgcn_mfma_f32_16x16x32_bf16((a), (b), (c), 0, 0, 0)
#define MFMA32(a, b, c) __builtin_amdgcn_mfma_f32_32x32x16_bf16((a), (b), (c), 0, 0, 0)

__device__ __forceinline__ float gelu_tanh(float x) {
    const float u = 0.7978845608028654f * (x + 0.044715f * x * x * x);
    const float e = __expf(2.f * u);
    const float th = 1.f - 2.f / (e + 1.f);
    return 0.5f * x * (1.f + th);
}

__device__ __forceinline__ void compress_phase(const Params& P, int layer, LAS unsigned char* lds) {
    const int tid = tid_(), bid = bid_(), gdim = gdim_(), lane = tid & 63, wave = tid >> 6, sub = wave >> 2, et = wave & 3;
    const int l16 = lane & 15, quad = lane >> 4;
    unsigned char* ws = P.ws;
    const bf16_t* z = (const bf16_t*)(ws + WS_Z);
    bf16_t* kc = (bf16_t*)(ws + WS_KCMP);
    const float* bp = (const float*)(ws + WS_BIASP);
    LAS bf16_t* hb = (LAS bf16_t*)lds + sub * (16 * 72);
    for (int bi = bid; bi < 256; bi += gdim) {
        const int id = bi * 2 + sub, kv = id >> 8, rest = id & 255, b = rest >> 5, g = (rest >> 4) & 1, n0 = (rest & 15) * 16;
        const bf16_t* w1t = (const bf16_t*)(ws + WS_W1T) + ((size_t)(layer * 2 + kv) * 64 + 16 * et + l16) * 2048 + 8 * quad;
        const bf16_t* w2t = (const bf16_t*)(ws + WS_W2T) + ((size_t)(layer * 2 + kv) * 64 + 16 * et + l16) * 64 + 8 * quad;
        const int n = n0 + l16;
        const bf16_t* zc = z + Z_NKV + (kv * 2 + g) * 64 + 8 * quad;
        f32x4 acc = {0.f, 0.f, 0.f, 0.f};
#pragma unroll 4
        for (int l = 0; l < 32; ++l) {
            int tok = 16 * n + l; tok = tok > T - 1 ? T - 1 : tok;
            const bf16_t* ar = zc + (size_t)(b * T + tok) * ZP;
#pragma unroll
            for (int dh = 0; dh < 2; ++dh) {
                const bf16x8 a = *(const bf16x8*)(ar + 32 * dh);
                const bf16x8 bb = *(const bf16x8*)(w1t + l * 64 + 32 * dh);
                acc = MFMA16(a, bb, acc);
            }
        }
        float bsum = 0.f;
        for (int ch = 0; ch < 32; ++ch) bsum += bp[((size_t)(layer * 2 + kv) * 32 + ch) * 64 + 16 * et + l16];
#pragma unroll
        for (int j = 0; j < 4; ++j) hb[(4 * quad + j) * 72 + 16 * et + l16] = (bf16_t)f2bf(gelu_tanh(acc[j] + bsum));
        __syncthreads();
        f32x4 acc2 = {0.f, 0.f, 0.f, 0.f};
#pragma unroll
        for (int ks = 0; ks < 2; ++ks) {
            const bf16x8 a = *(const LAS bf16x8*)(hb + l16 * 72 + 32 * ks + 8 * quad);
            const bf16x8 bb = *(const bf16x8*)(w2t + 32 * ks);
            acc2 = MFMA16(a, bb, acc2);
        }
#pragma unroll
        for (int j = 0; j < 4; ++j) {
            const int nr = n0 + 4 * quad + j;
            kc[((size_t)((kv * NB + b) * 2 + g) * 256 + nr) * 64 + 16 * et + l16] = (bf16_t)(nr < 255 ? f2bf(acc2[j]) : 0u);
        }
        __syncthreads();
    }
}

__device__ __forceinline__ void pool_phase(const Params& P, int layer, int wi0, int wi1) {
    const int tid = tid_(), bid = bid_(), gdim = gdim_(), lane = tid & 63, wave = tid >> 6, l16 = lane & 15, quad = lane >> 4;
    unsigned char* ws = P.ws;
    const bf16_t* z = (const bf16_t*)(ws + WS_Z);
    bf16_t* mix = (bf16_t*)(ws + WS_MIX);
    const float* psc = P.in[12] + layer * 256;
    for (int wi = wi0 + wave; wi < wi1; wi += 8) {
        const int tt = wi >> 2, gi = wi & 3, w = 2 << gi;
        const int row = tt * 16 + l16, t = row & (T - 1);
        const int cnt = (t + 1 < w) ? t + 1 : w; const float icnt = 1.0f / (float)cnt;
        const bf16_t* wpt = (const bf16_t*)(ws + WS_WPT) + ((size_t)(layer * 4 + gi) * 64 + l16) * 64 + 8 * quad;
        f32x4 acc[4];
#pragma unroll
        for (int dt = 0; dt < 4; ++dt) acc[dt] = (f32x4){0.f, 0.f, 0.f, 0.f};
#pragma unroll
        for (int ks = 0; ks < 2; ++ks) {
            const bf16_t* ur = z + (size_t)row * ZP + Z_PU + gi * 64 + 32 * ks + 8 * quad;
            float s[8];
#pragma unroll
            for (int j = 0; j < 8; ++j) s[j] = 0.f;
            for (int i = 0; i < w; ++i) {
                if (i < cnt) {
                    const bf16x8 v = *(const bf16x8*)(ur - (size_t)i * ZP);
#pragma unroll
                    for (int j = 0; j < 8; ++j) s[j] += bf2f((unsigned short)v[j]);
                }
            }
            const bf16x8 u0 = *(const bf16x8*)ur;
            u32x4 pa;
            pa.x = pk2(s[0] * icnt - bf2f((unsigned short)u0[0]), s[1] * icnt - bf2f((unsigned short)u0[1]));
            pa.y = pk2(s[2] * icnt - bf2f((unsigned short)u0[2]), s[3] * icnt - bf2f((unsigned short)u0[3]));
            pa.z = pk2(s[4] * icnt - bf2f((unsigned short)u0[4]), s[5] * icnt - bf2f((unsigned short)u0[5]));
            pa.w = pk2(s[6] * icnt - bf2f((unsigned short)u0[6]), s[7] * icnt - bf2f((unsigned short)u0[7]));
            const bf16x8 a = __builtin_bit_cast(bf16x8, pa);
#pragma unroll
            for (int dt = 0; dt < 4; ++dt) {
                const bf16x8 bb = *(const bf16x8*)(wpt + (size_t)dt * 16 * 64 + 32 * ks);
                acc[dt] = MFMA16(a, bb, acc[dt]);
            }
        }
#pragma unroll
        for (int dt = 0; dt < 4; ++dt) {
            const float sc = psc[gi * 64 + 16 * dt + l16];
#pragma unroll
            for (int j = 0; j < 4; ++j) mix[(size_t)(tt * 16 + 4 * quad + j) * D + 768 + gi * 64 + 16 * dt + l16] = (bf16_t)f2bf(acc[dt][j] * sc);
        }
    }
}

#ifndef SLC_ELEM_MASK
#define SLC_ELEM_MASK 0
#endif
#ifndef USE_NEGM
#define USE_NEGM 1
#endif
#ifndef KPREF
#define KPREF 1
#endif
#ifndef STAGGER
#define STAGGER 0
#endif
constexpr int AG = 4, NSA_G = 2;
constexpr int AL_WSF = 0, AL_BC = 2048, AL_T0 = 2304, AL_VSZ = 9216;
constexpr int AL_IMP = AL_T0 + AG * 2 * 9216, AL_SCORE = AL_IMP + 6 * 8192, AL_SEL = AL_SCORE + 16384;
static_assert(AL_SEL + 512 <= LDS_BYTES - 64 && AL_T0 + AG * (13312 + 9216) <= LDS_BYTES - 64, "attention LDS map");
constexpr int VPB = 144;

__device__ __forceinline__ s16x4 vtr(const LAS unsigned char* p) { return __builtin_bit_cast(s16x4, __builtin_amdgcn_ds_read_tr16_b64_v4i16((LAS v4i16_t*)p)); }

template <int NDC, int KPB>
__device__ __forceinline__ void qk_tile(f32x16& p0, f32x16& p1, const LAS unsigned char* Kt, const bf16x8* qf, const f32x16& cinit, int r, int h) {
    const LAS unsigned char* kb = Kt + r * KPB + h * 16;
    bf16x8 ka[NDC], kc[NDC];
#pragma unroll
    for (int c = 0; c < NDC; ++c) { ka[c] = *(const LAS bf16x8*)(kb + c * 32); kc[c] = *(const LAS bf16x8*)(kb + 32 * KPB + c * 32); }
    if constexpr (NDC == 4) asm volatile("" : "+v"(ka[0]), "+v"(ka[1]), "+v"(ka[2]), "+v"(ka[3]), "+v"(kc[0]), "+v"(kc[1]), "+v"(kc[2]), "+v"(kc[3]));
    else asm volatile("" : "+v"(ka[0]), "+v"(ka[1]), "+v"(ka[2]), "+v"(ka[3]), "+v"(ka[4]), "+v"(ka[5]), "+v"(kc[0]), "+v"(kc[1]), "+v"(kc[2]), "+v"(kc[3]), "+v"(kc[4]), "+v"(kc[5]));
    p0 = MFMA32(ka[0], qf[0], cinit); p1 = MFMA32(kc[0], qf[0], cinit);
#pragma unroll
    for (int c = 1; c < NDC; ++c) { p0 = MFMA32(ka[c], qf[c], p0); p1 = MFMA32(kc[c], qf[c], p1); }
}

template <int NDC, int KPB>
__device__ __forceinline__ void k_load(bf16x8 (&kf)[2 * NDC], const LAS unsigned char* Kt, int r, int h) {
    const LAS unsigned char* kb = Kt + r * KPB + h * 16;
#pragma unroll
    for (int c = 0; c < NDC; ++c) { kf[2 * c] = *(const LAS bf16x8*)(kb + c * 32); kf[2 * c + 1] = *(const LAS bf16x8*)(kb + 32 * KPB + c * 32); }
}
template <int NDC>
__device__ __forceinline__ void qk_mma(f32x16& p0, f32x16& p1, bf16x8 (&kf)[2 * NDC], const bf16x8* qf, const f32x16& cinit) {
    if constexpr (NDC == 4) asm volatile("" : "+v"(kf[0]), "+v"(kf[1]), "+v"(kf[2]), "+v"(kf[3]), "+v"(kf[4]), "+v"(kf[5]), "+v"(kf[6]), "+v"(kf[7]));
    else asm volatile("" : "+v"(kf[0]), "+v"(kf[1]), "+v"(kf[2]), "+v"(kf[3]), "+v"(kf[4]), "+v"(kf[5]), "+v"(kf[6]), "+v"(kf[7]), "+v"(kf[8]), "+v"(kf[9]), "+v"(kf[10]), "+v"(kf[11]));
    __builtin_amdgcn_s_setprio(1);
    p0 = MFMA32(kf[0], qf[0], cinit); p1 = MFMA32(kf[1], qf[0], cinit);
#pragma unroll
    for (int c = 1; c < NDC; ++c) { p0 = MFMA32(kf[2 * c], qf[c], p0); p1 = MFMA32(kf[2 * c + 1], qf[c], p1); }
    __builtin_amdgcn_s_setprio(0);
}
__device__ __forceinline__ bf16x8 pack8(const f32x16& p, int s, unsigned pmask) {
    u32x4 w; w.x = pk2(p[8 * s], p[8 * s + 1]) & pmask; w.y = pk2(p[8 * s + 2], p[8 * s + 3]) & pmask; w.z = pk2(p[8 * s + 4], p[8 * s + 5]) & pmask; w.w = pk2(p[8 * s + 6], p[8 * s + 7]) & pmask;
    return __builtin_bit_cast(bf16x8, w);
}

__device__ __forceinline__ void pv_load(s16x4 (&vf)[16], const LAS unsigned char* Vt, int lane) {
    const int i16 = lane & 15, q4 = i16 >> 2, p4 = i16 & 3, blk = (lane >> 4) & 1, h = lane >> 5;
    const LAS unsigned char* vb = Vt + (4 * h + q4) * VPB + blk * 32 + p4 * 8;
#pragma unroll
    for (int ks = 0; ks < 4; ++ks) {
        vf[4 * ks + 0] = vtr(vb + (16 * ks) * VPB); vf[4 * ks + 1] = vtr(vb + (16 * ks + 8) * VPB);
        vf[4 * ks + 2] = vtr(vb + (16 * ks) * VPB + 64); vf[4 * ks + 3] = vtr(vb + (16 * ks + 8) * VPB + 64);
    }
}
__device__ __forceinline__ void pv_pin(s16x4 (&vf)[16], f32x16& p0, f32x16& p1) {
    asm volatile("s_nop 15\n\ts_nop 7" : "+v"(p0), "+v"(p1));
    asm volatile("" : "+v"(vf[0]), "+v"(vf[1]), "+v"(vf[2]), "+v"(vf[3]), "+v"(vf[4]), "+v"(vf[5]), "+v"(vf[6]), "+v"(vf[7]),
                      "+v"(vf[8]), "+v"(vf[9]), "+v"(vf[10]), "+v"(vf[11]), "+v"(vf[12]), "+v"(vf[13]), "+v"(vf[14]), "+v"(vf[15]));
}
template <bool MASKED>
__device__ __forceinline__ void pv_mma(f32x16& o0, f32x16& o1, const f32x16& p0, const f32x16& p1, const s16x4 (&vf)[16], unsigned pmask) {
#pragma unroll
    for (int ks = 0; ks < 4; ++ks) {
        const bf16x8 pa = (ks < 2) ? pack8(p0, ks & 1, MASKED ? pmask : 0xffffffffu) : pack8(p1, ks & 1, MASKED ? pmask : 0xffffffffu);
        const bf16x8 v0 = __builtin_shufflevector(vf[4 * ks + 0], vf[4 * ks + 1], 0, 1, 2, 3, 4, 5, 6, 7);
        const bf16x8 v1 = __builtin_shufflevector(vf[4 * ks + 2], vf[4 * ks + 3], 0, 1, 2, 3, 4, 5, 6, 7);
        __builtin_amdgcn_s_setprio(1);
        o0 = MFMA32(pa, v0, o0);
        o1 = MFMA32(pa, v1, o1);
        __builtin_amdgcn_s_setprio(0);
    }
}

__device__ __forceinline__ float max3f(float a, float b, float c) { float r; asm("v_max3_f32 %0, %1, %2, %3" : "=v"(r) : "v"(a), "v"(b), "v"(c)); return r; }
__device__ __forceinline__ float tile_rowmax(const f32x16& p0, const f32x16& p1) {
    float a = max3f(p0[0], p0[1], p1[0]), b = max3f(p0[2], p0[3], p1[1]); a = max3f(a, p1[2], p1[3]);
#pragma unroll
    for (int i = 4; i < 16; i += 4) { a = max3f(a, p0[i], p0[i + 1]); b = max3f(b, p0[i + 2], p0[i + 3]); a = max3f(a, p1[i], p1[i + 1]); b = max3f(b, p1[i + 2], p1[i + 3]); }
    float m; asm("v_max_f32_e32 %0, %1, %2" : "=v"(m) : "v"(a), "v"(b));
    const auto rr = __builtin_amdgcn_permlane32_swap(__float_as_uint(m), __float_as_uint(m), false, false);
    float res; asm("v_max_f32_e32 %0, %1, %2" : "=v"(res) : "v"(__uint_as_float(rr[0])), "v"(__uint_as_float(rr[1])));
    return res;
}

template <bool IMPR>
__device__ __forceinline__ void softmax_step(f32x16& p0, f32x16& p1, bool lane_on, float& mref, f32x16& negm, float& l, f32x16& o0, f32x16& o1, LAS float* wsf, int r, int h, LAS float* impw) {
    float rm = tile_rowmax(p0, p1);
    rm = lane_on ? rm : -INFINITY;
    if (__any(rm > 12.0f)) {
        const float dl = fmaxf(rm, 0.f);
        mref += dl;
        const float alpha = fast_exp2(-dl);
        l *= alpha;
        if (h == 0) wsf[r] = alpha;
        asm volatile("" ::: "memory");
#pragma unroll
        for (int i = 0; i < 16; ++i) { const float a = wsf[crow(i, h)]; o0[i] *= a; o1[i] *= a; p0[i] -= dl; p1[i] -= dl; negm[i] = -mref; }
        if (IMPR) {
            asm volatile("" ::: "memory");
#pragma unroll 8
            for (int j = 0; j < 32; ++j) impw[r * 64 + 2 * j + h] *= alpha;
            asm volatile("" ::: "memory");
        }
    }
    float s0 = 0.f, s1 = 0.f, s2 = 0.f, s3 = 0.f;
#pragma unroll
    for (int i = 0; i < 16; i += 2) { p0[i] = fast_exp2(p0[i]); p1[i] = fast_exp2(p1[i]); p0[i + 1] = fast_exp2(p0[i + 1]); p1[i + 1] = fast_exp2(p1[i + 1]); s0 += p0[i]; s1 += p1[i]; s2 += p0[i + 1]; s3 += p1[i + 1]; }
    l += lane_on ? ((s0 + s1) + (s2 + s3)) : 0.f;
}

enum { MODE_MLA = 0, MODE_WIN = 1, MODE_SLC = 2, MODE_CMP1 = 3, MODE_CMP2 = 4 };

template <int MODE>
__device__ __forceinline__ void attn_tile(bf16x8 (&kpre)[(MODE == MODE_MLA) ? 12 : 8], bool have_pre, const LAS unsigned char* Knext, const LAS unsigned char* Kt, const LAS unsigned char* Vt, int t, int ti, const bf16x8* qf, int qpos, int cblk, unsigned long long sel,
                                          float& mref, f32x16& negm, float& l, f32x16& o0, f32x16& o1, float pscale, float pgate, LAS float* impw, LAS float* wsf, int lane) {
    constexpr int KPB = (MODE == MODE_MLA) ? 208 : 144;
    constexpr int NDC = (MODE == MODE_MLA) ? 6 : 4;
    const int r = lane & 31, h = lane >> 5;
    bool on = true;
    if (MODE == MODE_SLC) { on = (sel >> t) & 1ull; if (!__any((int)on)) return; }
    f32x16 p0, p1;
    PT_BEGIN(11);
    if (!have_pre) k_load<NDC, KPB>(kpre, Kt, r, h);
    if (MODE == MODE_CMP1) { f32x16 zz; for (int i = 0; i < 16; ++i) zz[i] = 0.f; qk_mma<NDC>(p0, p1, kpre, qf, zz); }
    else qk_mma<NDC>(p0, p1, kpre, qf, negm);
    if (Knext) k_load<NDC, KPB>(kpre, Knext, r, h);
    s16x4 vf[16];
    if (MODE != MODE_CMP1) pv_load(vf, Vt, lane);
    pv_pin(vf, p0, p1);
    const int kb = 64 * t + 4 * h;
    if (MODE == MODE_MLA) {
        if (64 * t + 63 > (qpos - r)) {
#pragma unroll
            for (int i = 0; i < 16; ++i) { const int kv = kb + (i & 3) + 8 * (i >> 2); if (kv > qpos) p0[i] = -INFINITY; if (kv + 32 > qpos) p1[i] = -INFINITY; }
        }
    } else if (MODE == MODE_WIN) {
        if (t == cblk || t == cblk - 8) {
#pragma unroll
            for (int i = 0; i < 16; ++i) { const int kv = kb + (i & 3) + 8 * (i >> 2);
                if (kv > qpos || kv <= qpos - 512) p0[i] = -INFINITY; if (kv + 32 > qpos || kv + 32 <= qpos - 512) p1[i] = -INFINITY; }
        }
    } else if (MODE == MODE_SLC) {
#if SLC_ELEM_MASK
        if (t == cblk || !__all((int)on)) {
#pragma unroll
            for (int i = 0; i < 16; ++i) { const int kv = kb + (i & 3) + 8 * (i >> 2); if (!on || kv > qpos) p0[i] = -INFINITY; if (!on || kv + 32 > qpos) p1[i] = -INFINITY; }
        }
        on = true;
#else
        if (t == cblk) {
#pragma unroll
            for (int i = 0; i < 16; ++i) { const int kv = kb + (i & 3) + 8 * (i >> 2); if (kv > qpos) p0[i] = -INFINITY; if (kv + 32 > qpos) p1[i] = -INFINITY; }
        }
#endif
    } else {
#pragma unroll
        for (int i = 0; i < 16; ++i) { const int kv = kb + (i & 3) + 8 * (i >> 2);
            if (16 * kv + 31 > qpos) p0[i] = -INFINITY; if (16 * (kv + 32) + 31 > qpos) p1[i] = -INFINITY; }
    }
    PT_END(11);
    if (MODE == MODE_CMP1) {
        const float rm = tile_rowmax(p0, p1);
        const float mnew = fmaxf(mref, rm);
        const float ms = (mnew == -INFINITY) ? 0.f : mnew;
        const float alpha = (mnew == -INFINITY) ? 1.f : fast_exp2(mref - mnew);
        float sm = 0.f;
#pragma unroll
        for (int i = 0; i < 16; ++i) sm += fast_exp2(p0[i] - ms) + fast_exp2(p1[i] - ms);
        l = l * alpha + sm; mref = mnew;
    } else if (MODE == MODE_CMP2) {
        softmax_step<true>(p0, p1, true, mref, negm, l, o0, o1, wsf, r, h, impw);
        LAS float* iw = impw + r * 64 + 16 * ti + h;
#pragma unroll
        for (int k = 0; k < 4; ++k) { iw[2 * k] += (p0[4 * k] + p0[4 * k + 1]) + (p0[4 * k + 2] + 0.5f * p0[4 * k + 3]); iw[8 + 2 * k] += (p1[4 * k] + p1[4 * k + 1]) + (p1[4 * k + 2] + 0.5f * p1[4 * k + 3]); }
        asm volatile("" ::: "memory");
#pragma unroll
        for (int k = 0; k < 4; ++k) { iw[2 * k + 1] += 0.5f * p0[4 * k + 3]; if (16 * ti + h + 8 + 2 * k + 1 < 64) iw[8 + 2 * k + 1] += 0.5f * p1[4 * k + 3]; }
        asm volatile("" ::: "memory");
        pv_mma<false>(o0, o1, p0, p1, vf, 0xffffffffu);
    } else {
        { PT_BEGIN(12);
        softmax_step<false>(p0, p1, on, mref, negm, l, o0, o1, wsf, r, h, impw);
        PT_END(12); }
        { PT_BEGIN(13);
        pv_mma<MODE == MODE_SLC>(o0, o1, p0, p1, vf, on ? 0xffffffffu : 0u);
        PT_END(13); }
    }
}

template <int MODE, int G>
__device__ __forceinline__ void attn_branch(LAS unsigned char* L, const bf16_t* kS, int kP, const bf16_t* vS, int vP, const bf16_t* rS, int rP,
                                            int t0, int t1, bool preloaded, const bf16x8* qf, int qpos, bool active, int wlo, int whi, int cblk, unsigned long long sel,
                                            float& mref, f32x16& negm, float& l, f32x16& o0, f32x16& o1, float pscale, float pgate, LAS float* impw, LAS float* wsf, int tid) {
    constexpr int KPB = (MODE == MODE_MLA) ? 208 : 144;
    constexpr int KSZ = 64 * KPB;
    constexpr bool DB = (2 * G <= AG);
    const int lane = tid & 63;
    const int srow = tid >> 3, sch = tid & 7;
    const int nsteps = (t1 - t0 + G - 1) / G;
    u32x4 kreg[G], vreg[G], rreg[G];
    bf16x8 kpre[(MODE == MODE_MLA) ? 12 : 8];
#define AB_LOAD(s_) do { _Pragma("unroll") for (int j_ = 0; j_ < G; ++j_) { const int t_ = t0 + (s_) * G + j_; if (t_ < t1) { \
        const size_t row_ = (size_t)t_ * 64 + srow; kreg[j_] = *(const u32x4*)(kS + row_ * kP + sch * 8); vreg[j_] = *(const u32x4*)(vS + row_ * vP + sch * 8); \
        if (MODE == MODE_MLA) { if (tid < 256) rreg[j_] = *(const u32x4*)(rS + ((size_t)t_ * 64 + (tid >> 2)) * rP + (tid & 3) * 8); } } } } while (0)
#define AB_STORE(s_) do { _Pragma("unroll") for (int j_ = 0; j_ < G; ++j_) { const int t_ = t0 + (s_) * G + j_; if (t_ < t1) { const int jj_ = (DB ? ((s_) & 1) * G : 0) + j_; \
        *(LAS u32x4*)(L + AL_T0 + jj_ * KSZ + srow * KPB + sch * 16) = kreg[j_]; *(LAS u32x4*)(L + AL_T0 + AG * KSZ + jj_ * AL_VSZ + srow * VPB + sch * 16) = vreg[j_]; \
        if (MODE == MODE_MLA) { if (tid < 256) *(LAS u32x4*)(L + AL_T0 + jj_ * KSZ + (tid >> 2) * KPB + 128 + (tid & 3) * 16) = rreg[j_]; } } } } while (0)
    if (!preloaded && nsteps > 0) { AB_LOAD(0); AB_STORE(0); }
    __syncthreads();
    for (int s = 0; s < nsteps; ++s) {
        if (s + 1 < nsteps) AB_LOAD(s + 1);
        PT_BEGIN(7);
        if (STAGGER && (tid >> 8)) __builtin_amdgcn_s_sleep(STAGGER);
        bool have_pre = false;
        const int jb = DB ? (s & 1) * G : 0;
#pragma unroll
        for (int j = 0; j < G; ++j) {
            const int t = t0 + s * G + j;
            const bool run = active && t < t1 && t >= wlo && t <= whi && (MODE != MODE_SLC || __any((int)((sel >> t) & 1ull)));
            const int tn = t + 1;
            const bool runn = KPREF && (j + 1 < G) && active && tn < t1 && tn >= wlo && tn <= whi && (MODE != MODE_SLC || __any((int)((sel >> tn) & 1ull)));
            if (run)
                attn_tile<MODE>(kpre, have_pre, runn ? (const LAS unsigned char*)(L + AL_T0 + (jb + j + 1) * KSZ) : (const LAS unsigned char*)nullptr, L + AL_T0 + (jb + j) * KSZ, L + AL_T0 + AG * KSZ + (jb + j) * AL_VSZ, t, t - t0, qf, qpos, cblk, sel, mref, negm, l, o0, o1, pscale, pgate, impw, wsf, lane);
            have_pre = run && runn;
        }
        PT_END(7);
        if (DB) {
            if (s + 1 < nsteps) AB_STORE(s + 1);
            __syncthreads();
        } else {
            __syncthreads();
            if (s + 1 < nsteps) { AB_STORE(s + 1); __syncthreads(); }
        }
    }
#undef AB_LOAD
#undef AB_STORE
}

__device__ __forceinline__ void branch_finish(f32x16& out0, f32x16& out1, const f32x16& o0, const f32x16& o1, float l, float gate, LAS float* wsf, int r, int h) {
    const float lt = l + __shfl_xor(l, 32);
    const float f = lt > 0.f ? gate / lt : 0.f;
    if (h == 0) wsf[r] = f;
    asm volatile("" ::: "memory");
#pragma unroll
    for (int i = 0; i < 16; ++i) { const float a = wsf[crow(i, h)]; out0[i] += o0[i] * a; out1[i] += o1[i] * a; }
    asm volatile("" ::: "memory");
}

__device__ __forceinline__ void branch_finish_lds(LAS float* obuf, bool active, const f32x16& o0, const f32x16& o1, float l, float gate, LAS float* wsf, int r, int h) {
    const float lt = l + __shfl_xor(l, 32);
    const float f = lt > 0.f ? gate / lt : 0.f;
    if (h == 0) wsf[r] = f;
    asm volatile("" ::: "memory");
    if (active) {
#pragma unroll
        for (int i = 0; i < 16; ++i) { const int qq = crow(i, h); const float a = wsf[qq]; obuf[qq * 64] += o0[i] * a; obuf[qq * 64 + 32] += o1[i] * a; }
    }
    asm volatile("" ::: "memory");
}
__device__ __forceinline__ float sigmoidf_(float x) { return 1.f / (1.f + __expf(-x)); }

__device__ __forceinline__ void nsa_unit(const Params& P, LAS unsigned char* L, int b, int g, int c) {
    const int tid = tid_(), lane = tid & 63, wave = __builtin_amdgcn_readfirstlane(tid >> 6), r = lane & 31, h = lane >> 5;
    unsigned char* ws = P.ws;
    const bf16_t* z = (const bf16_t*)(ws + WS_Z);
    const bf16_t* kcmp = (const bf16_t*)(ws + WS_KCMP);
    bf16_t* mix = (bf16_t*)(ws + WS_MIX);
    const bool active = wave < 6;
    const int hh = active ? (wave >> 1) : 0, qh = wave & 1, head = 3 * g + hh;
    const int q0 = 64 * c, qpos = q0 + 32 * qh + r;
    const size_t qrow = (size_t)b * T + qpos;
    LAS float* wsf = (LAS float*)(L + AL_WSF) + wave * 64;
    LAS float* impw = (LAS float*)(L + AL_IMP) + (active ? wave : 0) * 2048;
    bf16x8 qf[4];
#pragma unroll
    for (int cc = 0; cc < 4; ++cc) qf[cc] = *(const bf16x8*)(z + qrow * ZP + Z_NQ + head * 64 + 16 * cc + 8 * h);
    const bf16_t* gp = z + qrow * ZP + Z_GATE + head * 3;
    const float g_cmp = sigmoidf_(bf2f(gp[0])), g_slc = sigmoidf_(bf2f(gp[1])), g_win = sigmoidf_(bf2f(gp[2]));
    f32x16 out0, out1, o0, o1, negm;
#pragma unroll
    for (int i = 0; i < 16; ++i) { out0[i] = 0.f; out1[i] = 0.f; o0[i] = 0.f; o1[i] = 0.f; negm[i] = 0.f; }
    const int ntc = (4 * c + 3 + 63) >> 6;
    const bf16_t* kc = kcmp + (size_t)((0 * NB + b) * 2 + g) * 256 * 64;
    const bf16_t* vc = kcmp + (size_t)((1 * NB + b) * 2 + g) * 256 * 64;
    float m1 = 0.f, l1 = 0.f;
    PT_BEGIN(3);
    if (active) { for (int i = lane; i < 2048; i += 64) impw[i] = 0.f; }
    attn_branch<MODE_CMP2, AG>(L, kc, 64, vc, 64, nullptr, 0, 0, ntc, false, qf, qpos, active, 0, ntc, c, 0ull, m1, negm, l1, o0, o1, 0.f, 0.f, impw, wsf, tid);
    { const float lt = l1 + __shfl_xor(l1, 32); const float inv = lt > 0.f ? 1.f / lt : 0.f;
      if (h == 0) wsf[32 + r] = inv;
      branch_finish(out0, out1, o0, o1, l1, g_cmp, wsf, r, h); }
    __syncthreads();
    PT_END(3);
    {
        PT_BEGIN(4);
        LAS float* imp = (LAS float*)(L + AL_IMP); LAS float* sc = (LAS float*)(L + AL_SCORE); LAS unsigned long long* selL = (LAS unsigned long long*)(L + AL_SEL);
        const int q = tid >> 3, part = tid & 7;
        float my[8];
#pragma unroll
        for (int j = 0; j < 8; ++j) { const int s = part * 8 + j; const int o = (q >> 5) * 2048 + (q & 31) * 64 + s;
            const LAS float* wl = (const LAS float*)(L + AL_WSF) + (q >> 5) * 64 + 32 + (q & 31);
            const float v = (imp[o] * wl[0] + imp[o + 2 * 2048] * wl[2 * 64]) + imp[o + 4 * 2048] * wl[4 * 64];
            my[j] = (s > c) ? -1.f : ((s == 0 || s == c || s == c - 1) ? 1.0e4f : v);
            sc[q * 64 + s] = my[j]; }
        __syncthreads();
        int rank[8];
#pragma unroll
        for (int j = 0; j < 8; ++j) rank[j] = 0;
        if (c >= 16) {
            for (int s2 = 0; s2 <= c; ++s2) { const float v = sc[q * 64 + s2];
#pragma unroll
                for (int j = 0; j < 8; ++j) rank[j] += (v > my[j] || (v == my[j] && s2 < part * 8 + j)) ? 1 : 0; }
        }
        unsigned bits = 0;
#pragma unroll
        for (int j = 0; j < 8; ++j) if (part * 8 + j <= c && rank[j] < 16) bits |= 1u << j;
        unsigned lo = (part < 4) ? (bits << (8 * part)) : 0u, hi = (part >= 4) ? (bits << (8 * (part - 4))) : 0u;
        lo |= __shfl_xor(lo, 1); hi |= __shfl_xor(hi, 1); lo |= __shfl_xor(lo, 2); hi |= __shfl_xor(hi, 2); lo |= __shfl_xor(lo, 4); hi |= __shfl_xor(hi, 4);
        if (part == 0) selL[q] = ((unsigned long long)hi << 32) | lo;
        __syncthreads();
        PT_END(4);
    }
    const unsigned long long sel = ((LAS unsigned long long*)(L + AL_SEL))[32 * qh + r];
    LAS float* obuf = impw + r;
    if (active) {
#pragma unroll
        for (int i = 0; i < 16; ++i) { obuf[crow(i, h) * 64] = out0[i]; obuf[crow(i, h) * 64 + 32] = out1[i]; }
    }
    {
        const bf16_t* ks = z + (size_t)b * T * ZP + Z_NKV + ((1 * 2 + 0) * 2 + g) * 64;
        const bf16_t* vs = z + (size_t)b * T * ZP + Z_NKV + ((1 * 2 + 1) * 2 + g) * 64;
        float m = 0.f, l = 0.f;
#pragma unroll
        for (int i = 0; i < 16; ++i) { o0[i] = 0.f; o1[i] = 0.f; }
        PT_BEGIN(5);
        attn_branch<MODE_SLC, NSA_G>(L, ks, ZP, vs, ZP, nullptr, 0, 0, c + 1, false, qf, qpos, active, 0, c, c, sel, m, negm, l, o0, o1, 0.f, 0.f, impw, wsf, tid);
        branch_finish_lds(obuf, active, o0, o1, l, g_slc, wsf, r, h);
        PT_END(5);
    }
    {
        const bf16_t* kw = z + (size_t)b * T * ZP + Z_NKV + ((2 * 2 + 0) * 2 + g) * 64;
        const bf16_t* vw = z + (size_t)b * T * ZP + Z_NKV + ((2 * 2 + 1) * 2 + g) * 64;
        float m = 0.f, l = 0.f;
#pragma unroll
        for (int i = 0; i < 16; ++i) { o0[i] = 0.f; o1[i] = 0.f; negm[i] = 0.f; }
        const int tb = c >= 8 ? c - 8 : 0;
        PT_BEGIN(6);
        attn_branch<MODE_WIN, NSA_G>(L, kw, ZP, vw, ZP, nullptr, 0, tb, c + 1, false, qf, qpos, active, tb, c, c, 0ull, m, negm, l, o0, o1, 0.f, 0.f, impw, wsf, tid);
        branch_finish_lds(obuf, active, o0, o1, l, g_win, wsf, r, h);
        PT_END(6);
    }
    if (active) {
        bf16_t* op = mix + ((size_t)b * T + q0 + 32 * qh) * D + head * 64 + r;
#pragma unroll
        for (int i = 0; i < 16; ++i) { const int qq = crow(i, h); op[(size_t)qq * D] = (bf16_t)f2bf(obuf[qq * 64]); op[(size_t)qq * D + 32] = (bf16_t)f2bf(obuf[qq * 64 + 32]); }
    }
    __syncthreads();
}

__device__ __forceinline__ void mla_unit(const Params& P, LAS unsigned char* L, int b, int hd, int qb) {
    const int tid = tid_(), lane = tid & 63, wave = __builtin_amdgcn_readfirstlane(tid >> 6), r = lane & 31, h = lane >> 5;
    unsigned char* ws = P.ws;
    const bf16_t* z = (const bf16_t*)(ws + WS_Z);
    const bf16_t* qm = (const bf16_t*)(ws + WS_QM);
    const bf16_t* kvm = (const bf16_t*)(ws + WS_KVM);
    bf16_t* mix = (bf16_t*)(ws + WS_MIX);
    const int q0 = 256 * qb, qpos = q0 + 32 * wave + r;
    const size_t qrow = (size_t)b * T + qpos;
    LAS float* wsf = (LAS float*)(L + AL_WSF) + wave * 64;
    bf16x8 qf[6];
#pragma unroll
    for (int cc = 0; cc < 6; ++cc) qf[cc] = *(const bf16x8*)(qm + qrow * QMP + hd * 96 + 16 * cc + 8 * h);
    f32x16 o0, o1, out0, out1, negm;
#pragma unroll
    for (int i = 0; i < 16; ++i) { o0[i] = 0.f; o1[i] = 0.f; negm[i] = 0.f; }
    float m = 0.f, l = 0.f;
    const bf16_t* kS = kvm + (size_t)b * T * KVP + hd * 64;
    const bf16_t* vS = kvm + (size_t)b * T * KVP + 384 + hd * 64;
    const bf16_t* rS = z + (size_t)b * T * ZP + Z_KR;
    const int nt = 4 * qb + 4, whi = (q0 + 32 * wave + 31) >> 6;
    attn_branch<MODE_MLA, 2>(L, kS, KVP, vS, KVP, rS, ZP, 0, nt, false, qf, qpos, true, 0, whi, 0, 0ull, m, negm, l, o0, o1, 0.f, 0.f, wsf, wsf, tid);
    { const float lt = l + __shfl_xor(l, 32); const float f = lt > 0.f ? 1.f / lt : 0.f;
      if (h == 0) wsf[r] = f;
      asm volatile("" ::: "memory");
#pragma unroll
      for (int i = 0; i < 16; ++i) { const float a = wsf[crow(i, h)]; out0[i] = o0[i] * a; out1[i] = o1[i] * a; } }
    bf16_t* op = mix + ((size_t)b * T + q0 + 32 * wave) * D + 384 + hd * 64 + r;
#pragma unroll
    for (int i = 0; i < 16; ++i) { const int qq = crow(i, h); op[(size_t)qq * D] = (bf16_t)f2bf(out0[i]); op[(size_t)qq * D + 32] = (bf16_t)f2bf(out1[i]); }
}

constexpr int Q_NSA = 128, Q_MLA = 96, Q_UNITS = Q_NSA + Q_MLA;
__device__ const unsigned char Q_ORDER[Q_UNITS] = {63, 127, 62, 126, 61, 125, 60, 124, 59, 123, 58, 122, 57, 121, 56, 120, 55, 119, 54, 118, 53, 117, 52, 116, 51, 115, 50, 114, 49, 113, 48, 112, 47, 111, 46, 110, 45, 109, 44, 108, 43, 107, 42, 106, 41, 105, 40, 104, 39, 103, 38, 102, 37, 101, 36, 100, 35, 99, 34, 98, 33, 97, 32, 96, 31, 95, 30, 94, 29, 93, 143, 159, 175, 191, 207, 223, 28, 92, 27, 91, 26, 90, 142, 158, 174, 190, 206, 222, 25, 89, 24, 88, 23, 87, 141, 157, 173, 189, 205, 221, 22, 86, 21, 85, 140, 156, 172, 188, 204, 220, 20, 84, 19, 83, 18, 82, 139, 155, 171, 187, 203, 219, 17, 81, 16, 80, 138, 154, 170, 186, 202, 218, 15, 79, 14, 78, 13, 77, 137, 153, 169, 185, 201, 217, 12, 76, 11, 75, 136, 152, 168, 184, 200, 216, 10, 74, 9, 73, 8, 72, 135, 151, 167, 183, 199, 215, 7, 71, 134, 150, 166, 182, 198, 214, 6, 70, 5, 69, 133, 149, 165, 181, 197, 213, 4, 68, 132, 148, 164, 180, 196, 212, 3, 67, 131, 147, 163, 179, 195, 211, 2, 66, 1, 65, 130, 146, 162, 178, 194, 210, 0, 64, 129, 145, 161, 177, 193, 209, 128, 144, 160, 176, 192, 208};
__device__ __forceinline__ unsigned xcc_id_() { return (unsigned)__builtin_amdgcn_s_getreg((3 << 11) | 20) & 0x7u; }
__device__ __forceinline__ void attention_phase(const Params& P, int layer, LAS unsigned char* L, int rep) {
    unsigned* ctr = (unsigned*)(P.ws + WS_CTL) + 1024 * rep + 512 * layer;
    LAS unsigned* bc = (LAS unsigned*)(L + AL_BC);
    const int x = (int)xcc_id_();
    for (int dx = 0; dx < 8; ++dx) {
        const int q = (x + dx) & 7;
        for (;;) {
            if (tid_() == 0) bc[0] = __hip_atomic_fetch_add(ctr + 64 * q, 1u, __ATOMIC_RELAXED, __HIP_MEMORY_SCOPE_AGENT);
            __syncthreads();
            const unsigned u = bc[0];
            __syncthreads();
            if (u >= (unsigned)Q_UNITS) break;
            PT_BEGIN(u < (unsigned)Q_NSA ? 1 : 2);
            const unsigned e = Q_ORDER[u];
            if (!(e & 0x80u)) { const int bg = 2 * q + (int)((e >> 6) & 1u), c = (int)(e & 63u); nsa_unit(P, L, bg >> 1, bg & 1, c); }
            else { const int hd = (int)((e >> 4) & 7u), qb = (int)(e & 15u); mla_unit(P, L, q, hd, qb); }
            PT_END(u < (unsigned)Q_NSA ? 1 : 2);
        }
    }
    { unsigned* pc = (unsigned*)(P.ws + WS_CTL) + 1536 + 64 * layer;
      for (;;) {
          if (tid_() == 0) bc[0] = __hip_atomic_fetch_add(pc, 1u, __ATOMIC_RELAXED, __HIP_MEMORY_SCOPE_AGENT);
          __syncthreads();
          const unsigned u = bc[0];
          __syncthreads();
          if (u >= 512u) break;
          pool_phase(P, layer, (int)u * 16, (int)u * 16 + 16);
      } }
#if PROBE_T && PROBE_T < 20
    if (bid_() == PROBE_BLK && tid_() == 0) { LAS unsigned* pa_ = (LAS unsigned*)(PT_LDS + LDS_BYTES - 32); const unsigned long long w = (unsigned long long)pa_[0] * PROBE_MUL; pa_[0] = 0u;
        const unsigned long long t0 = __builtin_amdgcn_s_memtime(); while (__builtin_amdgcn_s_memtime() - t0 < w) __builtin_amdgcn_s_sleep(8); }
    __syncthreads();
#endif
}

__device__ __forceinline__ void final_phase(const Params& P) {
    const int tid = tid_(), bid = bid_(), gdim = gdim_(), lane = tid & 63, wave = tid >> 6;
    const float* ss = (const float*)(P.ws + WS_XPART) + (size_t)4 * M * 16; const float* gf = P.in[17];
    const bf16_t* xb = (const bf16_t*)(P.ws + WS_XB);
    for (int r = bid * 8 + wave; r < M; r += gdim * 8) {
        const float rs = rsqrtf(row_sum16(ss, r) * (1.0f / 1024.0f) + EPS);
        const u32x2* xr = (const u32x2*)(xb + (size_t)r * D) + lane;
        f32x4* orow = (f32x4*)(P.out + (size_t)r * D) + lane;
#pragma unroll
        for (int j = 0; j < 4; ++j) { const f32x4 gv = *((const f32x4*)gf + lane + 64 * j); const u32x2 a = xr[64 * j];
            f32x4 v; v[0] = __builtin_bit_cast(float, a.x << 16); v[1] = __builtin_bit_cast(float, a.x & 0xffff0000u); v[2] = __builtin_bit_cast(float, a.y << 16); v[3] = __builtin_bit_cast(float, a.y & 0xffff0000u);
            orow[64 * j] = v * rs * gv; }
    }
}

#define XB_TMO      128
#define XB_XCNT(j)  (256  + 64 * (j))
#define XB_XSUB(j)  (1280 + 64 * (j))
#define XB_XGEN(j)  (2304 + 64 * (j))
#define XB_TOP      3328
#define XB_TOPGEN   3392
#define XCD_BAR_WORDS 3456
#define XB_SPIN_CAP (1u << 18)

__device__ __forceinline__ unsigned xb_ld(unsigned* p)              { return __hip_atomic_load(p, __ATOMIC_RELAXED, __HIP_MEMORY_SCOPE_AGENT); }
__device__ __forceinline__ unsigned xb_add(unsigned* p, unsigned v) { return __hip_atomic_fetch_add(p, v, __ATOMIC_RELAXED, __HIP_MEMORY_SCOPE_AGENT); }
__device__ __forceinline__ unsigned xb_xcc_id() { return (unsigned)__builtin_amdgcn_s_getreg((3 << 11) | 20) & 0xFu; }
#define XB_SPIN(cond, bar) do { unsigned _sp = 0; while (cond) { __builtin_amdgcn_s_sleep(1); \
    if ((++_sp & 255u) == 0u) { if (xb_ld(&(bar)[XB_TMO])) break; if (_sp > XB_SPIN_CAP) { atomicAdd(&(bar)[XB_TMO], 1u); break; } } } } while (0)

struct XcdBarrier {
    unsigned* bar; unsigned x;
    volatile LAS unsigned* st;
};

__device__ __forceinline__ XcdBarrier xcd_barrier_post(unsigned* bar, volatile LAS unsigned* st) {
    XcdBarrier b; b.bar = bar; b.x = xb_xcc_id(); b.st = st;
    if (threadIdx.x == 0) (void)xb_add(&bar[XB_XCNT(b.x)], 1u);
    return b;
}
__device__ __forceinline__ void xcd_barrier_complete(unsigned* bar, unsigned x, unsigned& nloc, unsigned& nx) {
    const unsigned G = gridDim.x * gridDim.y * gridDim.z;
    unsigned sum, cnt, mine, sp = 0u;
    for (;;) {
        sum = 0u; cnt = 0u; mine = 0u;
#pragma unroll
        for (unsigned j = 0; j < 16; ++j) { const unsigned c = xb_ld(&bar[XB_XCNT(j)]); sum += c; cnt += (c > 0u) ? 1u : 0u; mine = (j == x) ? c : mine; }
        if (sum == G) break;
        __builtin_amdgcn_s_sleep(1);
        if ((++sp & 255u) == 0u) { if (xb_ld(&bar[XB_TMO])) break; if (sp > XB_SPIN_CAP) { atomicAdd(&bar[XB_TMO], 1u); break; } }
    }
    nloc = mine > 0u ? mine : 1u; nx = cnt > 0u ? cnt : 1u;
}

__device__ __forceinline__ void xcd_barrier(const XcdBarrier& b) {
    asm volatile("s_waitcnt vmcnt(0)" ::: "memory");
    __syncthreads();
    if (threadIdx.x == 0) {
        unsigned* bar = b.bar;
        __builtin_amdgcn_s_waitcnt(0);
        unsigned nloc = b.st[0], nx = b.st[1];
        if (nloc == 0u) { xcd_barrier_complete(bar, b.x, nloc, nx); b.st[0] = nloc; b.st[1] = nx; }
        const unsigned old = xb_add(&bar[XB_XSUB(b.x)], 1u);
        const unsigned gen = old / nloc;
        if (old + 1u == (gen + 1u) * nloc) {
            __builtin_amdgcn_fence(__ATOMIC_RELEASE, "agent");
            asm volatile("s_waitcnt vmcnt(0)" ::: "memory");
            const unsigned og = xb_add(&bar[XB_TOP], 1u);
            const unsigned tg = og / nx;
            if (og + 1u == (tg + 1u) * nx) xb_add(&bar[XB_TOPGEN], 1u);
            else XB_SPIN(xb_ld(&bar[XB_TOPGEN]) == tg, bar);
            __builtin_amdgcn_fence(__ATOMIC_ACQUIRE, "agent");
            xb_add(&bar[XB_XGEN(b.x)], 1u);
            asm volatile("s_waitcnt vmcnt(0)" ::: "memory");
        } else {
            XB_SPIN(xb_ld(&bar[XB_XGEN(b.x)]) == gen, bar);
            __builtin_amdgcn_fence(__ATOMIC_ACQUIRE, "agent");
            asm volatile("s_waitcnt vmcnt(0)" ::: "memory");
        }
    }
    __syncthreads();
}

__device__ __forceinline__ unsigned char* ws_of(const Params& P) { unsigned char* w = P.ws; asm volatile("" : "+s"(w)); return w; }
#ifndef PMASK
#define PMASK 0xffffffffu
#endif
#ifndef PROBE_K
#define PROBE_K 0
#endif
constexpr int N_PHASES_C = 1 + 6 * DEPTH + 1;
__global__ void __launch_bounds__(512) trunk_fwd(Params P, int ph_lo, int ph_hi) {
    extern __shared__ __attribute__((aligned(16))) unsigned char lds_raw[];
    LAS unsigned char* lds = (LAS unsigned char*)lds_raw;
    cg::grid_group grid = cg::this_grid();
    volatile LAS unsigned* bst = (volatile LAS unsigned*)(lds + LDS_BYTES - 64);
    if (threadIdx.x < 16) bst[threadIdx.x] = 0u;
    __syncthreads();
    XcdBarrier bar = xcd_barrier_post((unsigned*)(P.ws + WS_CTL) + 4096, bst);
    if (ph_lo < 0) grid.sync();
    for (int ph = ph_lo; ph < ph_hi; ++ph) {
        const int l = (ph - 1) / 6, k = (ph == 0) ? 0 : ((ph == 1 + 6 * DEPTH) ? 7 : 1 + (ph - 1) % 6);
        PT_BEGIN(20 + k);
        unsigned char* ws = ws_of(P);
        float* xpb = (float*)(ws + WS_XPART); float* cpb = (float*)(ws + WS_CPART);
        if (k == 0) { if (PMASK & 1u) prologue(P, lds); }
        else if (k == 1) { if (PMASK & 2u) {
            const float* ropec = (const float*)(ws + WS_ROPE);
            EpiInProj E{(bf16_t*)(ws + WS_Z), (l == 0) ? xpb : xpb + (size_t)2 * M * 16, cpb + (size_t)(2 * l) * M * 4, cpb + (size_t)(2 * l + 1) * M * 4, ropec, ropec + (size_t)M * 16};
            run_gemm(lds, (const bf16_t*)(ws + WS_XB), D, (const bf16_t*)(ws + WS_WIN) + (size_t)l * ZP * D, ZP, D, E); } }
        else if (k == 2) {
            if (PMASK & 4u) { const float* ropec = (const float*)(ws + WS_ROPE); EpiQup E{(bf16_t*)(ws + WS_QM), cpb + (size_t)(2 * l) * M * 4, ropec, ropec + (size_t)M * 16};
                run_gemm(lds, (const bf16_t*)(ws + WS_Z) + Z_CQ, ZP, (const bf16_t*)(ws + WS_WQUP) + (size_t)l * 768 * 256, 768, 256, E); }
            if (PMASK & 8u) { unsigned char* ws2 = ws_of(P); EpiKVup E{(bf16_t*)(ws2 + WS_KVM), (const float*)(ws2 + WS_CPART) + (size_t)(2 * l + 1) * M * 4};
                run_gemm(lds, (const bf16_t*)(ws2 + WS_Z) + Z_CKV, ZP, (const bf16_t*)(ws2 + WS_WKVUP) + (size_t)l * 768 * 128, 768, 128, E, true); }
            if (PMASK & 16u) compress_phase(P, l, lds);
#if PROBE_K == 21
            compress_phase(P, l, lds);
#endif
        }
        else if (k == 3) { if (PMASK & 64u) { attention_phase(P, l, lds, 0);
#if PROBE_K == 3
            attention_phase(P, l, lds, 1);
#endif
        } }
        else if (k == 4) { if (PMASK & 128u) { EpiResid E{(bf16_t*)(ws + WS_XB), xpb + (size_t)(1 + 2 * l) * M * 16};
            run_gemm(lds, (const bf16_t*)(ws + WS_MIX), D, (const bf16_t*)(ws + WS_WOUT) + (size_t)l * D * D, D, D, E); } }
        else if (k == 5) { if (PMASK & 256u) { EpiFF1 E{(bf16_t*)(ws + WS_H), xpb + (size_t)(1 + 2 * l) * M * 16};
            run_gemm(lds, (const bf16_t*)(ws + WS_XB), D, (const bf16_t*)(ws + WS_WFF1) + (size_t)l * FF * D, FF, D, E); } }
        else if (k == 6) { if (PMASK & 512u) { EpiResid E{(bf16_t*)(ws + WS_XB), xpb + (size_t)(2 + 2 * l) * M * 16};
            run_gemm(lds, (const bf16_t*)(ws + WS_H), FF, (const bf16_t*)(ws + WS_WFF2) + (size_t)l * D * FF, D, FF, E); } }
        else { if (PMASK & 1024u) final_phase(P); }
        if (ph + 1 < ph_hi) xcd_barrier(bar);
        PT_END(20 + k);
#if PROBE_T >= 20
        if (ph == N_PHASES_C - 2) { if (bid_() == PROBE_BLK && tid_() == 0) { LAS unsigned* pa_ = (LAS unsigned*)(PT_LDS + LDS_BYTES - 32); const unsigned long long w = (unsigned long long)pa_[0] * PROBE_MUL; pa_[0] = 0u;
            const unsigned long long t0 = __builtin_amdgcn_s_memtime(); while (__builtin_amdgcn_s_memtime() - t0 < w) __builtin_amdgcn_s_sleep(8); }
            __syncthreads(); xcd_barrier(bar); }
#endif
    }
#if PROBE_T == 27
    if (bid_() == PROBE_BLK && tid_() == 0) { LAS unsigned* pa_ = (LAS unsigned*)(PT_LDS + LDS_BYTES - 32); const unsigned long long w = (unsigned long long)pa_[0] * PROBE_MUL;
        const unsigned long long t0 = __builtin_amdgcn_s_memtime(); while (__builtin_amdgcn_s_memtime() - t0 < w) __builtin_amdgcn_s_sleep(8); }
#endif
}
constexpr int N_PHASES = 1 + 6 * DEPTH + 1;

#ifndef MK_MULTI
#define MK_MULTI 0
#endif
extern "C" void kernel_launch(void* const* d_in, const int* in_sizes, int n_in, void* d_out, int out_size, void* d_ws, size_t ws_size, hipStream_t stream) {
    static int grid_blocks = 0;
    if (grid_blocks == 0) {
        if (n_in != 18 || out_size != M * D || ws_size < WS_END) { fprintf(stderr, "kernel_launch: unexpected shapes (n_in %d out %d ws %zu)\n", n_in, out_size, ws_size); grid_blocks = -1; return; }
        int dev = 0, cus = 0, per_cu = 0;
        hipGetDevice(&dev);
        hipDeviceGetAttribute(&cus, hipDeviceAttributeMultiprocessorCount, dev);
        if (hipFuncSetAttribute((const void*)trunk_fwd, hipFuncAttributeMaxDynamicSharedMemorySize, LDS_BYTES) != hipSuccess) { fprintf(stderr, "kernel_launch: hipFuncSetAttribute failed\n"); grid_blocks = -1; return; }
        if (hipOccupancyMaxActiveBlocksPerMultiprocessor(&per_cu, (const void*)trunk_fwd, 512, LDS_BYTES) != hipSuccess || per_cu < 1) { fprintf(stderr, "kernel_launch: occupancy query gave %d\n", per_cu); per_cu = 1; }
        (void)hipGetLastError();
        grid_blocks = cus * per_cu;
    }
    if (grid_blocks < 0) return;
    Params p{};
    for (int i = 0; i < 18; ++i) p.in[i] = (const float*)d_in[i];
    p.out = (float*)d_out; p.ws = (unsigned char*)d_ws;
    if (hipMemsetAsync(d_ws, 0, 65536, stream) != hipSuccess) { fprintf(stderr, "kernel_launch: memset failed\n"); return; }
    int lo = 0, hi = N_PHASES;
    void* args[] = {&p, &lo, &hi};
    hipError_t e = hipLaunchCooperativeKernel((const void*)trunk_fwd, dim3(grid_blocks), dim3(512), args, LDS_BYTES, stream);
    if (e != hipSuccess) fprintf(stderr, "cooperative launch failed: %s (grid %d)\n", hipGetErrorString(e), grid_blocks);
}
```

```cpp
#include <hip/hip_runtime.h>
#include <hip/hip_cooperative_groups.h>
#include <cstdio>
#include <cstdint>
namespace cg = cooperative_groups;

namespace pg8 {
#define PG8_LAS __attribute__((address_space(3)))
typedef unsigned short bf16_t;
typedef short bf16x8 __attribute__((ext_vector_type(8)));
typedef float f32x4 __attribute__((ext_vector_type(4)));
typedef unsigned u32x4 __attribute__((ext_vector_type(4)));
constexpr int BM = 256, BK = 64, HALF = 128, HTB = HALF * BK * 2  , STAGE_BYTES = 8 * HTB, NXCD = 8, WGM = 8;

__host__ __device__ __forceinline__ int lds_byte(int r, int c) { const int st = (r >> 4) * 2 + (c >> 5), rr = r & 15, cc = c & 31, ob = rr * 64 + cc * 2; return st * 1024 + (ob ^ (((ob >> 9) & 1) << 5)); }
__host__ __device__ __forceinline__ void stage_rc(int b, int& R, int& C) { const int st = b / 1024, sb = b % 1024, swz = sb ^ (((sb >> 9) & 1) << 5); R = (st >> 1) * 16 + swz / 64; C = (st & 1) * 32 + (swz % 64) / 2; }
__host__ __device__ __forceinline__ int perm32(int rho) { const int n = rho >> 4, i = rho & 15; return 8 * (i >> 2) + 4 * n + (i & 3); }

struct Unit { int pm, pn; };
struct Gemm { const bf16_t* A; const bf16_t* Bt; int M, N, K, lda; };
struct StaticOrder {
    int nM, nN, nwg, G, c;
    __host__ __device__ void init(int M, int N, int G_, int c_) { nM = M / BM; nN = N / BM; nwg = nM * nN; G = G_; c = c_; }
    __host__ __device__ bool next(int i, Unit& u) const {
        const long L = (long)i * G + c; if (L >= nwg) return false;
        int wgid = (int)L; { const int q = nwg / NXCD, r = nwg % NXCD, xcd = wgid % NXCD, off = wgid / NXCD; wgid = (xcd < r ? xcd * (q + 1) : r * (q + 1) + (xcd - r) * q) + off; }
        const int nig = WGM * nN, gid = wgid / nig, fm = gid * WGM, gsz = (nM - fm) < WGM ? (nM - fm) : WGM;
        u.pm = fm + ((wgid % nig) % gsz); u.pn = (wgid % nig) / gsz; return true;
    }
    __device__ __forceinline__ void a_ready(const Unit&) const {}
    __device__ __forceinline__ void done(const Unit&) const {}
};
__device__ __forceinline__ unsigned cvt_pk_bf16(float lo, float hi) { unsigned r; asm volatile("v_cvt_pk_bf16_f32 %0, %1, %2" : "=v"(r) : "v"(lo), "v"(hi)); return r; }
template <class Epi, class Sched, bool ALIGN_EPI = false, bool SP2 = false>
__device__ __forceinline__ void gemm_phase(PG8_LAS unsigned char* lds, const Gemm g, const Sched& S, const Epi& E) {
    int tid = threadIdx.x; asm volatile("" : "+v"(tid)); const int wid = __builtin_amdgcn_readfirstlane(tid >> 6), lane = tid & 63, wr = wid >> 2, wc = wid & 3, fr = lane & 15, fq = lane >> 4;
    const int K = g.K, nt = K / BK;
    unsigned voffA[2], voffB[2];
#pragma unroll
    for (int i = 0; i < 2; ++i) { int R, C; stage_rc(tid * 16 + i * 8192, R, C); const int Rb = Epi::PERM ? ((R & ~31) + perm32(R & 31)) : R;
        voffA[i] = (unsigned)(R * g.lda + C) * 2u; voffB[i] = (unsigned)(Rb * K + C) * 2u; }
    const size_t kstep = (size_t)(BK * 2);
    const size_t hstepB = (size_t)HALF * K * 2, hstepA = (size_t)HALF * g.lda * 2;
    const size_t tstepB = 2 * hstepB, tstepA = 2 * hstepA;
    const unsigned ldsw = (unsigned)wid * 1024u;
    const int aoff = lds_byte(wr * 64 + fr, fq * 8), boff = lds_byte(wc * 32 + fr, fq * 8);
#define PG8_SA(b, h) (((b) * 2 + (h)) * HTB)
#define PG8_SB(b, h) ((4 + (b) * 2 + (h)) * HTB)
#define PG8_STAGE(bufoff, gbase, voff) do { _Pragma("unroll") for (int _i = 0; _i < 2; ++_i) \
        __builtin_amdgcn_global_load_lds((const unsigned*)((const char*)(gbase) + (voff)[_i]), (PG8_LAS unsigned*)(lds + (bufoff) + ldsw + _i * 8192), 16, 0, 0); } while (0)
#define PG8_LDA(dst, b, h) do { _Pragma("unroll") for (int m = 0; m < 4; ++m) _Pragma("unroll") for (int k = 0; k < 2; ++k) dst[m][k] = *(const PG8_LAS bf16x8*)(lds + PG8_SA(b, h) + aoff + m * 2048 + k * 1024); } while (0)
#define PG8_LDB(dst, b, h) do { _Pragma("unroll") for (int n = 0; n < 2; ++n) _Pragma("unroll") for (int k = 0; k < 2; ++k) dst[n][k] = *(const PG8_LAS bf16x8*)(lds + PG8_SB(b, h) + boff + n * 2048 + k * 1024); } while (0)
#define PG8_MMA(ai, bj, At, Bt) do { __builtin_amdgcn_s_setprio(1); _Pragma("unroll") for (int m = 0; m < 4; ++m) _Pragma("unroll") for (int n = 0; n < 2; ++n) _Pragma("unroll") for (int k = 0; k < 2; ++k) \
        acc[ai][bj][m][n] = __builtin_amdgcn_mfma_f32_16x16x32_bf16(Bt[n][k], At[m][k], acc[ai][bj][m][n], 0, 0, 0); __builtin_amdgcn_s_setprio(0); } while (0)
#define PG8_WAIT_V(n) asm volatile("s_waitcnt vmcnt(" #n ")" ::: "memory")
#define PG8_WAIT_L(n) asm volatile("s_waitcnt lgkmcnt(" #n ")" ::: "memory")
#define PG8_BAR __builtin_amdgcn_s_barrier()
#define PG8_SCHED __builtin_amdgcn_sched_barrier(0)
    Unit cur, nxt; int ui = 0;
    if (!S.next(0, cur)) return;
    f32x4 acc[2][2][4][2];
#pragma unroll
    for (int a = 0; a < 2; ++a)
#pragma unroll
        for (int b = 0; b < 2; ++b)
#pragma unroll
            for (int m = 0; m < 4; ++m)
#pragma unroll
                for (int n = 0; n < 2; ++n) acc[a][b][m][n] = (f32x4){0.f, 0.f, 0.f, 0.f};
    bf16x8 At[4][2], B0[2][2], B1[2][2];
    const char* cA = (const char*)g.A + (size_t)cur.pm * tstepA; const char* cB = (const char*)g.Bt + (size_t)cur.pn * tstepB;
    S.a_ready(cur);
    if constexpr (SP2) {
        PG8_STAGE(PG8_SB(0, 0), cB, voffB); PG8_STAGE(PG8_SB(0, 1), cB + hstepB, voffB); PG8_STAGE(PG8_SA(0, 0), cA, voffA); PG8_STAGE(PG8_SA(0, 1), cA + hstepA, voffA);
        if (wr == 1) PG8_BAR;
        PG8_WAIT_V(2); PG8_BAR;
        PG8_STAGE(PG8_SB(1, 0), cB + kstep, voffB); PG8_STAGE(PG8_SA(1, 0), cA + kstep, voffA); PG8_STAGE(PG8_SB(1, 1), cB + hstepB + kstep, voffB);
        PG8_WAIT_V(6); PG8_BAR;
    } else {
        PG8_STAGE(PG8_SB(0, 0), cB, voffB); PG8_STAGE(PG8_SA(0, 0), cA, voffA); PG8_STAGE(PG8_SB(0, 1), cB + hstepB, voffB); PG8_STAGE(PG8_SA(0, 1), cA + hstepA, voffA);
        if (wr == 1) PG8_BAR;
        PG8_WAIT_V(4); PG8_BAR;
        PG8_STAGE(PG8_SB(1, 0), cB + kstep, voffB); PG8_STAGE(PG8_SA(1, 0), cA + kstep, voffA); PG8_STAGE(PG8_SB(1, 1), cB + hstepB + kstep, voffB);
        PG8_WAIT_V(6); PG8_BAR;
    }
    for (;;) {
        const bool has_next = S.next(ui + 1, nxt);
        const char* nA = has_next ? (const char*)g.A + (size_t)nxt.pm * tstepA : cA; const char* nB = has_next ? (const char*)g.Bt + (size_t)nxt.pn * tstepB : cB;
        for (int t = 0; t < nt; t += 2) {
            const bool last = (t == nt - 2);
            const char* a1 = cA + (size_t)(t + 1) * kstep;
            const char* a2 = last ? nA : cA + (size_t)(t + 2) * kstep; const char* b2 = last ? nB : cB + (size_t)(t + 2) * kstep;
            const char* a3 = a2 + kstep; const char* b3 = b2 + kstep;
            if (last && has_next) S.a_ready(nxt);
            if constexpr (SP2) {
            PG8_LDB(B0, 0, 0); PG8_LDB(B1, 0, 1); PG8_SCHED; PG8_LDA(At, 0, 0); PG8_STAGE(PG8_SA(1, 1), a1 + hstepA, voffA);
            PG8_WAIT_V(8); PG8_WAIT_L(0); PG8_BAR; PG8_MMA(0, 0, At, B0); PG8_MMA(0, 1, At, B1); PG8_BAR; PG8_SCHED;
            PG8_LDA(At, 0, 1); PG8_STAGE(PG8_SB(0, 0), b2, voffB); PG8_STAGE(PG8_SB(0, 1), b2 + hstepB, voffB); PG8_STAGE(PG8_SA(0, 0), a2, voffA);
            PG8_WAIT_V(8); PG8_WAIT_L(0); PG8_BAR; PG8_MMA(1, 0, At, B0); PG8_MMA(1, 1, At, B1); PG8_BAR; PG8_SCHED;
            PG8_LDB(B0, 1, 0); PG8_LDB(B1, 1, 1); PG8_SCHED; PG8_LDA(At, 1, 0); PG8_STAGE(PG8_SA(0, 1), a2 + hstepA, voffA);
            PG8_WAIT_V(8); PG8_WAIT_L(0); PG8_BAR; PG8_MMA(0, 0, At, B0); PG8_MMA(0, 1, At, B1); PG8_BAR; PG8_SCHED;
            PG8_LDA(At, 1, 1); PG8_STAGE(PG8_SB(1, 0), b3, voffB); PG8_STAGE(PG8_SB(1, 1), b3 + hstepB, voffB); PG8_STAGE(PG8_SA(1, 0), a3, voffA);
            PG8_WAIT_V(8); PG8_WAIT_L(0); PG8_BAR; PG8_MMA(1, 0, At, B0); PG8_MMA(1, 1, At, B1); PG8_BAR; PG8_SCHED;
            } else {
            PG8_LDB(B0, 0, 0); PG8_SCHED; PG8_LDA(At, 0, 0); PG8_STAGE(PG8_SA(1, 1), a1 + hstepA, voffA);
            PG8_WAIT_L(8); PG8_BAR; PG8_WAIT_L(0); PG8_MMA(0, 0, At, B0); PG8_BAR; PG8_SCHED;
            PG8_LDB(B1, 0, 1); PG8_STAGE(PG8_SB(0, 0), b2, voffB);
            PG8_BAR; PG8_WAIT_L(0); PG8_MMA(0, 1, At, B1); PG8_BAR;
            PG8_LDA(At, 0, 1); PG8_STAGE(PG8_SA(0, 0), a2, voffA);
            PG8_BAR; PG8_WAIT_L(0); PG8_MMA(1, 0, At, B0); PG8_BAR; PG8_SCHED;
            PG8_STAGE(PG8_SB(0, 1), b2 + hstepB, voffB);
            PG8_WAIT_V(6); PG8_BAR; PG8_MMA(1, 1, At, B1); PG8_BAR;
            PG8_LDB(B0, 1, 0); PG8_SCHED; PG8_LDA(At, 1, 0); PG8_STAGE(PG8_SA(0, 1), a2 + hstepA, voffA);
            PG8_WAIT_L(8); PG8_BAR; PG8_WAIT_L(0); PG8_MMA(0, 0, At, B0); PG8_BAR; PG8_SCHED;
            PG8_LDB(B1, 1, 1); PG8_STAGE(PG8_SB(1, 0), b3, voffB);
            PG8_BAR; PG8_WAIT_L(0); PG8_MMA(0, 1, At, B1); PG8_BAR;
            PG8_LDA(At, 1, 1); PG8_STAGE(PG8_SA(1, 0), a3, voffA);
            PG8_BAR; PG8_WAIT_L(0); PG8_MMA(1, 0, At, B0); PG8_BAR; PG8_SCHED;
            PG8_STAGE(PG8_SB(1, 1), b3 + hstepB, voffB);
            PG8_WAIT_V(6); PG8_BAR; PG8_MMA(1, 1, At, B1); PG8_BAR;
            }
        }
        if constexpr (ALIGN_EPI) { if (wr == 0) PG8_BAR; }
        if constexpr (!Epi::AFTER_DRAIN) { E(acc, cur, wr, wc, fr, fq); S.done(cur); }
        if (!has_next) break;
#pragma unroll
        for (int a = 0; a < 2; ++a)
#pragma unroll
            for (int b = 0; b < 2; ++b)
#pragma unroll
                for (int m = 0; m < 4; ++m)
#pragma unroll
                    for (int n = 0; n < 2; ++n) acc[a][b][m][n] = (f32x4){0.f, 0.f, 0.f, 0.f};
        cur = nxt; cA = nA; cB = nB; ++ui;
        if constexpr (ALIGN_EPI) { if (wr == 1) PG8_BAR; }
    }
    PG8_WAIT_V(0);
    if constexpr (!ALIGN_EPI) { if (wr == 0) PG8_BAR; }
    PG8_BAR;
    if constexpr (Epi::AFTER_DRAIN) { E.fused(acc, cur, wr, wc, fr, fq, lds, wid, lane); S.done(cur); }
#undef PG8_SA
#undef PG8_SB
#undef PG8_STAGE
#undef PG8_LDA
#undef PG8_LDB
#undef PG8_MMA
#undef PG8_WAIT_V
#undef PG8_WAIT_L
#undef PG8_BAR
#undef PG8_SCHED
}
}


#define LAS __attribute__((address_space(3)))
typedef unsigned short bf16_t;
typedef short bf16x8 __attribute__((ext_vector_type(8)));
typedef short s16x4 __attribute__((ext_vector_type(4)));
typedef float f32x4 __attribute__((ext_vector_type(4)));
typedef float f32x16 __attribute__((ext_vector_type(16)));
typedef unsigned u32x4 __attribute__((ext_vector_type(4)));
typedef unsigned u32x2 __attribute__((ext_vector_type(2)));
typedef float f32x2_t __attribute__((ext_vector_type(2)));
typedef __bf16 bf16x2_t __attribute__((ext_vector_type(2)));
typedef short v4i16_t __attribute__((ext_vector_type(4)));

constexpr int NB = 8, T = 4096, M = NB * T, D = 1024, FF = 4096, DEPTH = 2;
constexpr int P_IN = 1842, ZP = 2048;
constexpr int Z_CQ = 0, Z_CKV = 256, Z_KR = 384, Z_GATE = 416, Z_NQ = 512, Z_NKV = 896, Z_PU = 1664;
constexpr int QMP = 768, KVP = 768;
constexpr float EPS = 1e-6f;
constexpr float LOG2E = 1.4426950408889634f;
constexpr float NSA_QS = 0.125f * LOG2E;
constexpr float MLA_QS = 0.10206207261596575f * LOG2E;

constexpr size_t MiB = 1u << 20;
constexpr size_t WS_CTL = 0;
constexpr size_t WS_SS = 1 * MiB;
constexpr size_t WS_ROPE = 3 * MiB;
constexpr size_t WS_BIASP = 7 * MiB;
constexpr size_t WS_KCMP = 7 * MiB + 512 * 1024;
constexpr size_t WS_WIN = 10 * MiB, WS_WOUT = 18 * MiB, WS_WFF1 = 22 * MiB, WS_WFF2 = 38 * MiB, WS_WQUP = 54 * MiB, WS_WKVUP = 55 * MiB;
constexpr size_t WS_W1T = 56 * MiB, WS_W2T = 57 * MiB, WS_WPT = 57 * MiB + 512 * 1024;
constexpr size_t WS_XB = 64 * MiB, WS_MIX = 128 * MiB, WS_H = 192 * MiB, WS_Z = 192 * MiB, WS_QM = 320 * MiB, WS_KVM = 368 * MiB, WS_XPART = 448 * MiB, WS_CPART = 458 * MiB, WS_END = 460 * MiB;

constexpr int LDS_BYTES = 147456;

struct Params { const float* in[18]; float* out; unsigned char* ws; };

__device__ __forceinline__ unsigned f2bf(float f) { unsigned u = __builtin_bit_cast(unsigned, f); return (u + 0x7fffu + ((u >> 16) & 1u)) >> 16; }
__device__ __forceinline__ unsigned pk2(float lo, float hi) { f32x2_t v = {lo, hi}; bf16x2_t b = __builtin_convertvector(v, bf16x2_t); return __builtin_bit_cast(unsigned, b); }
__device__ __forceinline__ float bf2f(unsigned short b) { return __builtin_bit_cast(float, (unsigned)b << 16); }
__device__ __forceinline__ float wave_sum(float v) {
#pragma unroll
    for (int o = 1; o < 64; o <<= 1) v += __shfl_xor(v, o);
    return v;
}
__device__ __forceinline__ int crow(int r, int h) { return (r & 3) + 8 * (r >> 2) + 4 * h; }
__device__ __forceinline__ void atomic_addf(float* p, float v) { __hip_atomic_fetch_add(p, v, __ATOMIC_RELAXED, __HIP_MEMORY_SCOPE_AGENT); }
__device__ __forceinline__ float fast_exp2(float x) { return __builtin_amdgcn_exp2f(x); }

__device__ __forceinline__ int tid_() { int t = threadIdx.x; asm volatile("" : "+v"(t)); return t; }
__device__ __forceinline__ int bid_() { int t = blockIdx.x; asm volatile("" : "+s"(t)); return t; }
__device__ __forceinline__ int gdim_() { int t = gridDim.x; asm volatile("" : "+s"(t)); return t; }
#ifndef PROBE_T
#define PROBE_T 0
#endif
#ifndef PROBE_BLK
#define PROBE_BLK 0
#endif
#ifndef PROBE_TID
#define PROBE_TID 0
#endif
#ifndef PROBE_MUL
#define PROBE_MUL 3
#endif
#if PROBE_T
#define PT_LDS ((LAS unsigned char*)0)
#define PT_BEGIN(tag) unsigned long long pt_t0_ = 0; if ((tag) == PROBE_T) { __builtin_amdgcn_sched_barrier(0); pt_t0_ = __builtin_amdgcn_s_memtime(); __builtin_amdgcn_sched_barrier(0); }
#define PT_END(tag) do { if ((tag) == PROBE_T) { __builtin_amdgcn_sched_barrier(0); const unsigned long long pt_t1_ = __builtin_amdgcn_s_memtime(); __builtin_amdgcn_sched_barrier(0); if (bid_() == PROBE_BLK && tid_() == PROBE_TID) { LAS unsigned* pa_ = (LAS unsigned*)(PT_LDS + LDS_BYTES - 32); pa_[0] += (unsigned)(pt_t1_ - pt_t0_); } } } while (0)
#else
#define PT_BEGIN(tag) do {} while (0)
#define PT_END(tag) do {} while (0)
#endif
#define EPI_LOOP_ROWS  _Pragma("unroll") for (int ai = 0; ai < 2; ++ai) _Pragma("unroll") for (int m = 0; m < 4; ++m) if (epi_fence())
__device__ __forceinline__ bool epi_fence() { asm volatile("" ::: "memory"); return true; }
__device__ __forceinline__ float row_sum16(const float* part, int row) {
    const f32x4* p = (const f32x4*)(part + (size_t)row * 16); const f32x4 a = p[0], b = p[1], c = p[2], d = p[3];
    return (((a[0] + a[1]) + (a[2] + a[3])) + ((b[0] + b[1]) + (b[2] + b[3]))) + (((c[0] + c[1]) + (c[2] + c[3])) + ((d[0] + d[1]) + (d[2] + d[3])));
}
__device__ __forceinline__ float row_sum4(const float* part, int row) { const f32x4 a = *(const f32x4*)(part + (size_t)row * 4); return (a[0] + a[1]) + (a[2] + a[3]); }
template <int NPART>
__device__ __forceinline__ LAS float* epi_row_scales(const float* part, int pm, int wr, int wc, int fr, int fq, float inv_n, float mul) {
    LAS float* sc = (LAS float*)(size_t)131072 + (wr * 4 + wc) * 128;
    const int lane = fq * 16 + fr;
#pragma unroll
    for (int a = 0; a < 2; ++a) {
        const int row = pm * 256 + a * 128 + wr * 64 + lane;
        const float sm = (NPART == 16) ? row_sum16(part, row) : row_sum4(part, row);
        sc[a * 64 + lane] = rsqrtf(sm * inv_n + EPS) * mul;
    }
    asm volatile("" ::: "memory");
    return sc;
}
__device__ __forceinline__ void st_bf4(bf16_t* p, f32x4 v) { u32x2 w; w.x = pk2(v[0], v[1]); w.y = pk2(v[2], v[3]); *(u32x2*)p = w; }
__device__ __forceinline__ float dot4(f32x4 v) { return (v[0] * v[0] + v[1] * v[1]) + (v[2] * v[2] + v[3] * v[3]); }

struct EpiInProj {
    static constexpr bool PERM = true, AFTER_DRAIN = false;
    bf16_t* z; const float* ss_x; float* ss_cq; float* ss_ckv; const float* ropec; const float* ropes;
    __device__ __forceinline__ void operator()(const f32x4 (&acc)[2][2][4][2], const pg8::Unit& u, int wr, int wc, int fr, int fq) const {
        const int pn = u.pn;
        LAS float* sc = epi_row_scales<16>(ss_x, u.pm, wr, wc, fr, fq, 1.0f / 1024.0f, 1.0f);
        EPI_LOOP_ROWS {
            const int row = u.pm * 256 + ai * 128 + wr * 64 + m * 16 + fr;
            const float rs = sc[ai * 64 + m * 16 + fr];
            float sq = 0.f;
#pragma unroll
            for (int bj = 0; bj < 2; ++bj) {
                f32x4 v0 = acc[ai][bj][m][0] * rs, v1 = acc[ai][bj][m][1] * rs;
                const int cb = pn * 256 + bj * 128 + wc * 32;
                if (pn == 0 || (pn == 1 && bj == 0)) sq += dot4(v0) + dot4(v1);
                if (pn == 1 && bj == 1 && wc == 0) {
                    const float* cp = ropec + (size_t)row * 16 + 8 * (fq & 1); const float* sp = ropes + (size_t)row * 16 + 8 * (fq & 1);
                    const f32x4 c0 = *(const f32x4*)cp, c1 = *(const f32x4*)(cp + 4), s0 = *(const f32x4*)sp, s1 = *(const f32x4*)(sp + 4);
                    const float sg = (fq < 2) ? -1.f : 1.f;
                    f32x4 p0v, p1v;
#pragma unroll
                    for (int j = 0; j < 4; ++j) { p0v[j] = __shfl_xor(v0[j], 32); p1v[j] = __shfl_xor(v1[j], 32); }
                    v0 = v0 * c0 + p0v * s0 * sg; v1 = v1 * c1 + p1v * s1 * sg;
                }
                if (cb >= Z_NQ && cb < Z_NKV) { v0 = v0 * NSA_QS; v1 = v1 * NSA_QS; }
                u32x4 w; w.x = pk2(v0[0], v0[1]); w.y = pk2(v0[2], v0[3]); w.z = pk2(v1[0], v1[1]); w.w = pk2(v1[2], v1[3]);
                *(u32x4*)(z + (size_t)row * ZP + cb + 8 * fq) = w;
            }
            if (pn <= 1) {
                sq += __shfl_xor(sq, 16); sq += __shfl_xor(sq, 32);
                if (fq == 0) (pn == 0 ? ss_cq : ss_ckv)[(size_t)row * 4 + wc] = sq;
            }
        }
    }
};

struct EpiQup {
    static constexpr bool PERM = true, AFTER_DRAIN = false;
    bf16_t* qm; const float* ss_cq; const float* ropec; const float* ropes;
    __device__ __forceinline__ void operator()(const f32x4 (&acc)[2][2][4][2], const pg8::Unit& u, int wr, int wc, int fr, int fq) const {
        LAS float* sc = epi_row_scales<4>(ss_cq, u.pm, wr, wc, fr, fq, 1.0f / 256.0f, MLA_QS);
        EPI_LOOP_ROWS {
            const int row = u.pm * 256 + ai * 128 + wr * 64 + m * 16 + fr;
            const float rs = sc[ai * 64 + m * 16 + fr];
#pragma unroll
            for (int bj = 0; bj < 2; ++bj) {
                f32x4 v0 = acc[ai][bj][m][0] * rs, v1 = acc[ai][bj][m][1] * rs;
                const int gi = u.pn * 8 + bj * 4 + wc;
                if (gi % 3 == 2) {
                    const float* cp = ropec + (size_t)row * 16 + 8 * (fq & 1); const float* sp = ropes + (size_t)row * 16 + 8 * (fq & 1);
                    const f32x4 c0 = *(const f32x4*)cp, c1 = *(const f32x4*)(cp + 4), s0 = *(const f32x4*)sp, s1 = *(const f32x4*)(sp + 4);
                    const float sg = (fq < 2) ? -1.f : 1.f;
                    f32x4 p0v, p1v;
#pragma unroll
                    for (int j = 0; j < 4; ++j) { p0v[j] = __shfl_xor(v0[j], 32); p1v[j] = __shfl_xor(v1[j], 32); }
                    v0 = v0 * c0 + p0v * s0 * sg; v1 = v1 * c1 + p1v * s1 * sg;
                }
                u32x4 w; w.x = pk2(v0[0], v0[1]); w.y = pk2(v0[2], v0[3]); w.z = pk2(v1[0], v1[1]); w.w = pk2(v1[2], v1[3]);
                *(u32x4*)(qm + (size_t)row * QMP + gi * 32 + 8 * fq) = w;
            }
        }
    }
};

struct EpiKVup {
    static constexpr bool PERM = true, AFTER_DRAIN = false;
    bf16_t* kvm; const float* ss_ckv;
    __device__ __forceinline__ void operator()(const f32x4 (&acc)[2][2][4][2], const pg8::Unit& u, int wr, int wc, int fr, int fq) const {
        LAS float* sc = epi_row_scales<4>(ss_ckv, u.pm, wr, wc, fr, fq, 1.0f / 128.0f, 1.0f);
        EPI_LOOP_ROWS {
            const int row = u.pm * 256 + ai * 128 + wr * 64 + m * 16 + fr;
            const float rs = sc[ai * 64 + m * 16 + fr];
#pragma unroll
            for (int bj = 0; bj < 2; ++bj) {
                const f32x4 v0 = acc[ai][bj][m][0] * rs, v1 = acc[ai][bj][m][1] * rs;
                u32x4 w; w.x = pk2(v0[0], v0[1]); w.y = pk2(v0[2], v0[3]); w.z = pk2(v1[0], v1[1]); w.w = pk2(v1[2], v1[3]);
                *(u32x4*)(kvm + (size_t)row * KVP + u.pn * 256 + bj * 128 + wc * 32 + 8 * fq) = w;
            }
        }
    }
};

struct EpiResid {
    static constexpr bool PERM = true, AFTER_DRAIN = false;
    bf16_t* xb; float* ss;
    __device__ __forceinline__ void operator()(const f32x4 (&acc)[2][2][4][2], const pg8::Unit& u, int wr, int wc, int fr, int fq) const {
        EPI_LOOP_ROWS {
            const int row = u.pm * 256 + ai * 128 + wr * 64 + m * 16 + fr;
            float sq = 0.f;
#pragma unroll
            for (int bj = 0; bj < 2; ++bj) {
                bf16_t* p = xb + (size_t)row * D + u.pn * 256 + bj * 128 + wc * 32 + 8 * fq;
                const u32x4 a = *(const u32x4*)p;
                f32x4 v0, v1;
                v0[0] = __builtin_bit_cast(float, a.x << 16); v0[1] = __builtin_bit_cast(float, a.x & 0xffff0000u); v0[2] = __builtin_bit_cast(float, a.y << 16); v0[3] = __builtin_bit_cast(float, a.y & 0xffff0000u);
                v1[0] = __builtin_bit_cast(float, a.z << 16); v1[1] = __builtin_bit_cast(float, a.z & 0xffff0000u); v1[2] = __builtin_bit_cast(float, a.w << 16); v1[3] = __builtin_bit_cast(float, a.w & 0xffff0000u);
                v0 = v0 + acc[ai][bj][m][0]; v1 = v1 + acc[ai][bj][m][1];
                u32x4 w; w.x = pk2(v0[0], v0[1]); w.y = pk2(v0[2], v0[3]); w.z = pk2(v1[0], v1[1]); w.w = pk2(v1[2], v1[3]);
                *(u32x4*)p = w;
                sq += dot4(v0) + dot4(v1);
            }
            sq += __shfl_xor(sq, 16); sq += __shfl_xor(sq, 32);
            if (fq == 0) ss[(size_t)row * 16 + u.pn * 4 + wc] = sq;
        }
    }
};

struct EpiFF1 {
    static constexpr bool PERM = true, AFTER_DRAIN = false;
    bf16_t* h; const float* ss;
    __device__ __forceinline__ void operator()(const f32x4 (&acc)[2][2][4][2], const pg8::Unit& u, int wr, int wc, int fr, int fq) const {
        LAS float* sc = epi_row_scales<16>(ss, u.pm, wr, wc, fr, fq, 1.0f / 1024.0f, 1.0f);
        EPI_LOOP_ROWS {
            const int row = u.pm * 256 + ai * 128 + wr * 64 + m * 16 + fr;
            const float rs = sc[ai * 64 + m * 16 + fr];
#pragma unroll
            for (int bj = 0; bj < 2; ++bj) {
                f32x4 v0 = acc[ai][bj][m][0] * rs, v1 = acc[ai][bj][m][1] * rs;
#pragma unroll
                for (int j = 0; j < 4; ++j) { const float a = fmaxf(v0[j], 0.f), b = fmaxf(v1[j], 0.f); v0[j] = a * a; v1[j] = b * b; }
                u32x4 w; w.x = pk2(v0[0], v0[1]); w.y = pk2(v0[2], v0[3]); w.z = pk2(v1[0], v1[1]); w.w = pk2(v1[2], v1[3]);
                *(u32x4*)(h + (size_t)row * FF + u.pn * 256 + bj * 128 + wc * 32 + 8 * fq) = w;
            }
        }
    }
};

template <class Epi>
__device__ __forceinline__ void run_gemm(LAS unsigned char* lds, const bf16_t* A, int lda, const bf16_t* Bt, int N, int K, const Epi& E, bool mirror = false) {
    asm volatile("" : "+s"(N), "+s"(K), "+s"(lda));
    const int gd = gdim_(), bi = bid_();
    pg8::Gemm g{A, Bt, M, N, K, lda}; pg8::StaticOrder S; S.init(M, N, gd, mirror ? gd - 1 - bi : bi);
    pg8::gemm_phase<Epi, pg8::StaticOrder, true, true>(lds, g, S, E);
}

__device__ __forceinline__ int colmap(int mode, int n) {
    if (mode == 0) return n;
    if (mode == 1) {
        if (n < 256) return 1170 + n;
        if (n < 384) return 1426 + (n - 256);
        if (n < 416) return 1554 + (n - 384);
        if (n < 434) return 1152 + (n - 416);
        if (n < 512) return -1;
        if (n < 896) return n - 512;
        if (n < 1664) return 384 + (n - 896);
        if (n < 1920) return 1586 + (n - 1664);
        return -1;
    }
    if (mode == 2) {
        if (n < 384) return (n >> 6) * 128 + (n & 63);
        return ((n - 384) >> 6) * 128 + 64 + ((n - 384) & 63);
    }
    return n < 576 ? n : -1;
}
__device__ __forceinline__ void convert_tile(const float* src, int srcPitch, int K, bf16_t* dst, const float* rowscale, int mode, int n0, int k0, LAS float* tile, int tid) {
#pragma unroll
    for (int i = 0; i < 8; ++i) {
        const int kk = (tid >> 6) + 8 * i, nn = tid & 63; const int sc = colmap(mode, n0 + nn);
        float v = 0.f;
        if (sc >= 0) { v = src[(size_t)(k0 + kk) * srcPitch + sc]; if (rowscale) v *= rowscale[k0 + kk]; }
        tile[kk * 65 + nn] = v;
    }
    __syncthreads();
    { const int nn = tid >> 3, kc = (tid & 7) * 8; const LAS float* s = tile + kc * 65 + nn;
      u32x4 o; o.x = pk2(s[0], s[65]); o.y = pk2(s[2 * 65], s[3 * 65]); o.z = pk2(s[4 * 65], s[5 * 65]); o.w = pk2(s[6 * 65], s[7 * 65]);
      *(u32x4*)(dst + (size_t)(n0 + nn) * K + k0 + kc) = o; }
    __syncthreads();
}

__device__ __forceinline__ void prologue(const Params& P, LAS unsigned char* lds) {
    const int tid = tid_(), bid = bid_(), gdim = gdim_(), lane = tid & 63, wave = tid >> 6;
    const int gw = bid * 8 + wave, NGW = gdim * 8;
    unsigned char* ws = P.ws;
    if (bid == 0) { for (int i = tid; i < 2048; i += 512) ((unsigned*)(ws + WS_CTL))[i] = 0u; }
    { const float* x = P.in[0]; bf16_t* xb = (bf16_t*)(ws + WS_XB); float* ss0 = (float*)(ws + WS_XPART);
      for (int r = gw; r < M; r += 2 * NGW) {
          const int r2 = r + NGW;
          const f32x4* xr = (const f32x4*)(x + (size_t)r * D) + lane; const f32x4* xr2 = (const f32x4*)(x + (size_t)(r2 < M ? r2 : r) * D) + lane;
          f32x4 v[4], w[4]; float sa = 0.f, sb = 0.f;
#pragma unroll
          for (int j = 0; j < 4; ++j) { v[j] = xr[64 * j]; w[j] = xr2[64 * j]; }
#pragma unroll
          for (int j = 0; j < 4; ++j) { sa += dot4(v[j]); sb += dot4(w[j]); }
          sa = wave_sum(sa); sb = wave_sum(sb);
          if (lane < 16) ss0[(size_t)r * 16 + lane] = (lane == 0) ? sa : 0.f;
          u32x2* o = (u32x2*)(xb + (size_t)r * D) + lane;
#pragma unroll
          for (int j = 0; j < 4; ++j) { u32x2 t; t.x = pk2(v[j][0], v[j][1]); t.y = pk2(v[j][2], v[j][3]); o[64 * j] = t; }
          if (r2 < M) {
              if (lane < 16) ss0[(size_t)r2 * 16 + lane] = (lane == 0) ? sb : 0.f;
              u32x2* o2 = (u32x2*)(xb + (size_t)r2 * D) + lane;
#pragma unroll
              for (int j = 0; j < 4; ++j) { u32x2 t; t.x = pk2(w[j][0], w[j][1]); t.y = pk2(w[j][2], w[j][3]); o2[64 * j] = t; }
          }
      } }
    { const int* pos = (const int*)P.in[1]; float* rc = (float*)(ws + WS_ROPE); float* rsn = rc + (size_t)M * 16;
      const float INV[16] = {1.0f, 0.5623413324356079f, 0.3162277638912201f, 0.17782793939113617f, 0.10000000149011612f, 0.05623413249850273f, 0.03162277489900589f, 0.017782794311642647f,
                             0.009999999776482582f, 0.005623413249850273f, 0.003162277629598975f, 0.0017782794311642647f, 0.0010000000474974513f, 0.000562341301701963f, 0.0003162277571391314f, 0.00017782794020604342f};
      for (int i = bid * 512 + tid; i < M * 16; i += gdim * 512) {
          const int r = i >> 4, k = i & 15; float inv = INV[0];
#pragma unroll
          for (int q = 1; q < 16; ++q) inv = (k == q) ? INV[q] : inv;
          const float ang = (float)pos[r] * inv;
          double rev = (double)ang * 0.15915494309189535; rev -= floor(rev);
          const float fr = (float)rev;
          rc[i] = __builtin_amdgcn_cosf(fr); rsn[i] = __builtin_amdgcn_sinf(fr);
      } }
    { float* bp = (float*)(ws + WS_BIASP);
      for (int it = gw; it < DEPTH * 2 * 32; it += NGW) {
          const int lk = it >> 5, ch = it & 31; const float* pp = P.in[4] + (size_t)lk * 2048 + ch * 64; const float* w1 = P.in[5] + (size_t)lk * 2048 * 64 + (size_t)ch * 64 * 64;
          float s = 0.f;
          for (int k = 0; k < 64; ++k) s += pp[k] * w1[k * 64 + lane];
          bp[it * 64 + lane] = s;
      } }
    { LAS float* tile = (LAS float*)lds;
      constexpr int C_IN = 32 * 16, C_OUT = 16 * 16, C_F1 = 64 * 16, C_F2 = 16 * 64, C_QU = 12 * 4, C_KV = 12 * 2, C_W1 = 2 * 32, C_W2 = 2, C_WP = 4;
      constexpr int PER_L = C_IN + C_OUT + C_F1 + C_F2 + C_QU + C_KV + C_W1 + C_W2 + C_WP;
      for (int it = bid; it < DEPTH * PER_L; it += gdim) {
          const int l = it / PER_L; int r = it % PER_L;
          if (r < C_IN) { convert_tile(P.in[3] + (size_t)l * D * P_IN, P_IN, D, (bf16_t*)(ws + WS_WIN) + (size_t)l * ZP * D, P.in[2] + l * D, 1, (r >> 4) * 64, (r & 15) * 64, tile, tid); continue; } r -= C_IN;
          if (r < C_OUT) { convert_tile(P.in[13] + (size_t)l * D * D, D, D, (bf16_t*)(ws + WS_WOUT) + (size_t)l * D * D, nullptr, 0, (r >> 4) * 64, (r & 15) * 64, tile, tid); continue; } r -= C_OUT;
          if (r < C_F1) { convert_tile(P.in[15] + (size_t)l * D * FF, FF, D, (bf16_t*)(ws + WS_WFF1) + (size_t)l * FF * D, P.in[14] + l * D, 0, (r >> 4) * 64, (r & 15) * 64, tile, tid); continue; } r -= C_F1;
          if (r < C_F2) { convert_tile(P.in[16] + (size_t)l * FF * D, D, FF, (bf16_t*)(ws + WS_WFF2) + (size_t)l * D * FF, nullptr, 0, (r >> 6) * 64, (r & 63) * 64, tile, tid); continue; } r -= C_F2;
          if (r < C_QU) { convert_tile(P.in[8] + (size_t)l * 256 * 576, 576, 256, (bf16_t*)(ws + WS_WQUP) + (size_t)l * 768 * 256, P.in[7] + l * 256, 3, (r >> 2) * 64, (r & 3) * 64, tile, tid); continue; } r -= C_QU;
          if (r < C_KV) { convert_tile(P.in[10] + (size_t)l * 128 * 768, 768, 128, (bf16_t*)(ws + WS_WKVUP) + (size_t)l * 768 * 128, P.in[9] + l * 128, 2, (r >> 1) * 64, (r & 1) * 64, tile, tid); continue; } r -= C_KV;
          if (r < C_W1) { const int kv = r >> 5, kt = r & 31; convert_tile(P.in[5] + (size_t)(l * 2 + kv) * 2048 * 64, 64, 2048, (bf16_t*)(ws + WS_W1T) + (size_t)(l * 2 + kv) * 64 * 2048, nullptr, 0, 0, kt * 64, tile, tid); continue; } r -= C_W1;
          if (r < C_W2) { convert_tile(P.in[6] + (size_t)(l * 2 + r) * 64 * 64, 64, 64, (bf16_t*)(ws + WS_W2T) + (size_t)(l * 2 + r) * 64 * 64, nullptr, 0, 0, 0, tile, tid); continue; } r -= C_W2;
          convert_tile(P.in[11] + (size_t)(l * 4 + r) * 64 * 64, 64, 64, (bf16_t*)(ws + WS_WPT) + (size_t)(l * 4 + r) * 64 * 64, nullptr, 0, 0, 0, tile, tid);
      } }
}

#define MFMA16(a, b, c) __builtin_amdgcn_mfma_f32_16x16x32_bf16((a), (b), (c), 0, 0, 0)
#define MFMA32(a, b, c) __builtin_amdgcn_mfma_f32_32x32x16_bf16((a), (b), (c), 0, 0, 0)

__device__ __forceinline__ float gelu_tanh(float x) {
    const float u = 0.7978845608028654f * (x + 0.044715f * x * x * x);
    const float e = __expf(2.f * u);
    const float th = 1.f - 2.f / (e + 1.f);
    return 0.5f * x * (1.f + th);
}

__device__ __forceinline__ void compress_phase(const Params& P, int layer, LAS unsigned char* lds) {
    const int tid = tid_(), bid = bid_(), gdim = gdim_(), lane = tid & 63, wave = tid >> 6, sub = wave >> 2, et = wave & 3;
    const int l16 = lane & 15, quad = lane >> 4;
    unsigned char* ws = P.ws;
    const bf16_t* z = (const bf16_t*)(ws + WS_Z);
    bf16_t* kc = (bf16_t*)(ws + WS_KCMP);
    const float* bp = (const float*)(ws + WS_BIASP);
    LAS bf16_t* hb = (LAS bf16_t*)lds + sub * (16 * 72);
    for (int bi = bid; bi < 256; bi += gdim) {
        const int id = bi * 2 + sub, kv = id >> 8, rest = id & 255, b = rest >> 5, g = (rest >> 4) & 1, n0 = (rest & 15) * 16;
        const bf16_t* w1t = (const bf16_t*)(ws + WS_W1T) + ((size_t)(layer * 2 + kv) * 64 + 16 * et + l16) * 2048 + 8 * quad;
        const bf16_t* w2t = (const bf16_t*)(ws + WS_W2T) + ((size_t)(layer * 2 + kv) * 64 + 16 * et + l16) * 64 + 8 * quad;
        const int n = n0 + l16;
        const bf16_t* zc = z + Z_NKV + (kv * 2 + g) * 64 + 8 * quad;
        f32x4 acc = {0.f, 0.f, 0.f, 0.f};
#pragma unroll 4
        for (int l = 0; l < 32; ++l) {
            int tok = 16 * n + l; tok = tok > T - 1 ? T - 1 : tok;
            const bf16_t* ar = zc + (size_t)(b * T + tok) * ZP;
#pragma unroll
            for (int dh = 0; dh < 2; ++dh) {
                const bf16x8 a = *(const bf16x8*)(ar + 32 * dh);
                const bf16x8 bb = *(const bf16x8*)(w1t + l * 64 + 32 * dh);
                acc = MFMA16(a, bb, acc);
            }
        }
        float bsum = 0.f;
        for (int ch = 0; ch < 32; ++ch) bsum += bp[((size_t)(layer * 2 + kv) * 32 + ch) * 64 + 16 * et + l16];
#pragma unroll
        for (int j = 0; j < 4; ++j) hb[(4 * quad + j) * 72 + 16 * et + l16] = (bf16_t)f2bf(gelu_tanh(acc[j] + bsum));
        __syncthreads();
        f32x4 acc2 = {0.f, 0.f, 0.f, 0.f};
#pragma unroll
        for (int ks = 0; ks < 2; ++ks) {
            const bf16x8 a = *(const LAS bf16x8*)(hb + l16 * 72 + 32 * ks + 8 * quad);
            const bf16x8 bb = *(const bf16x8*)(w2t + 32 * ks);
            acc2 = MFMA16(a, bb, acc2);
        }
#pragma unroll
        for (int j = 0; j < 4; ++j) {
            const int nr = n0 + 4 * quad + j;
            kc[((size_t)((kv * NB + b) * 2 + g) * 256 + nr) * 64 + 16 * et + l16] = (bf16_t)(nr < 255 ? f2bf(acc2[j]) : 0u);
        }
        __syncthreads();
    }
}

__device__ __forceinline__ void pool_phase(const Params& P, int layer, int wi0, int wi1) {
    const int tid = tid_(), bid = bid_(), gdim = gdim_(), lane = tid & 63, wave = tid >> 6, l16 = lane & 15, quad = lane >> 4;
    unsigned char* ws = P.ws;
    const bf16_t* z = (const bf16_t*)(ws + WS_Z);
    bf16_t* mix = (bf16_t*)(ws + WS_MIX);
    const float* psc = P.in[12] + layer * 256;
    for (int wi = wi0 + wave; wi < wi1; wi += 8) {
        const int tt = wi >> 2, gi = wi & 3, w = 2 << gi;
        const int row = tt * 16 + l16, t = row & (T - 1);
        const int cnt = (t + 1 < w) ? t + 1 : w; const float icnt = 1.0f / (float)cnt;
        const bf16_t* wpt = (const bf16_t*)(ws + WS_WPT) + ((size_t)(layer * 4 + gi) * 64 + l16) * 64 + 8 * quad;
        f32x4 acc[4];
#pragma unroll
        for (int dt = 0; dt < 4; ++dt) acc[dt] = (f32x4){0.f, 0.f, 0.f, 0.f};
#pragma unroll
        for (int ks = 0; ks < 2; ++ks) {
            const bf16_t* ur = z + (size_t)row * ZP + Z_PU + gi * 64 + 32 * ks + 8 * quad;
            float s[8];
#pragma unroll
            for (int j = 0; j < 8; ++j) s[j] = 0.f;
            for (int i = 0; i < w; ++i) {
                if (i < cnt) {
                    const bf16x8 v = *(const bf16x8*)(ur - (size_t)i * ZP);
#pragma unroll
                    for (int j = 0; j < 8; ++j) s[j] += bf2f((unsigned short)v[j]);
                }
            }
            const bf16x8 u0 = *(const bf16x8*)ur;
            u32x4 pa;
            pa.x = pk2(s[0] * icnt - bf2f((unsigned short)u0[0]), s[1] * icnt - bf2f((unsigned short)u0[1]));
            pa.y = pk2(s[2] * icnt - bf2f((unsigned short)u0[2]), s[3] * icnt - bf2f((unsigned short)u0[3]));
            pa.z = pk2(s[4] * icnt - bf2f((unsigned short)u0[4]), s[5] * icnt - bf2f((unsigned short)u0[5]));
            pa.w = pk2(s[6] * icnt - bf2f((unsigned short)u0[6]), s[7] * icnt - bf2f((unsigned short)u0[7]));
            const bf16x8 a = __builtin_bit_cast(bf16x8, pa);
#pragma unroll
            for (int dt = 0; dt < 4; ++dt) {
                const bf16x8 bb = *(const bf16x8*)(wpt + (size_t)dt * 16 * 64 + 32 * ks);
                acc[dt] = MFMA16(a, bb, acc[dt]);
            }
        }
#pragma unroll
        for (int dt = 0; dt < 4; ++dt) {
            const float sc = psc[gi * 64 + 16 * dt + l16];
#pragma unroll
            for (int j = 0; j < 4; ++j) mix[(size_t)(tt * 16 + 4 * quad + j) * D + 768 + gi * 64 + 16 * dt + l16] = (bf16_t)f2bf(acc[dt][j] * sc);
        }
    }
}

#ifndef SLC_ELEM_MASK
#define SLC_ELEM_MASK 0
#endif
#ifndef USE_NEGM
#define USE_NEGM 1
#endif
#ifndef KPREF
#define KPREF 1
#endif
#ifndef STAGGER
#define STAGGER 0
#endif
constexpr int AG = 4, NSA_G = 2;
constexpr int AL_WSF = 0, AL_BC = 2048, AL_T0 = 2304, AL_VSZ = 9216;
constexpr int AL_IMP = AL_T0 + AG * 2 * 9216, AL_SCORE = AL_IMP + 6 * 8192, AL_SEL = AL_SCORE + 16384;
static_assert(AL_SEL + 512 <= LDS_BYTES - 64 && AL_T0 + AG * (13312 + 9216) <= LDS_BYTES - 64, "attention LDS map");
constexpr int VPB = 144;

__device__ __forceinline__ s16x4 vtr(const LAS unsigned char* p) { return __builtin_bit_cast(s16x4, __builtin_amdgcn_ds_read_tr16_b64_v4i16((LAS v4i16_t*)p)); }

template <int NDC, int KPB>
__device__ __forceinline__ void qk_tile(f32x16& p0, f32x16& p1, const LAS unsigned char* Kt, const bf16x8* qf, const f32x16& cinit, int r, int h) {
    const LAS unsigned char* kb = Kt + r * KPB + h * 16;
    bf16x8 ka[NDC], kc[NDC];
#pragma unroll
    for (int c = 0; c < NDC; ++c) { ka[c] = *(const LAS bf16x8*)(kb + c * 32); kc[c] = *(const LAS bf16x8*)(kb + 32 * KPB + c * 32); }
    if constexpr (NDC == 4) asm volatile("" : "+v"(ka[0]), "+v"(ka[1]), "+v"(ka[2]), "+v"(ka[3]), "+v"(kc[0]), "+v"(kc[1]), "+v"(kc[2]), "+v"(kc[3]));
    else asm volatile("" : "+v"(ka[0]), "+v"(ka[1]), "+v"(ka[2]), "+v"(ka[3]), "+v"(ka[4]), "+v"(ka[5]), "+v"(kc[0]), "+v"(kc[1]), "+v"(kc[2]), "+v"(kc[3]), "+v"(kc[4]), "+v"(kc[5]));
    p0 = MFMA32(ka[0], qf[0], cinit); p1 = MFMA32(kc[0], qf[0], cinit);
#pragma unroll
    for (int c = 1; c < NDC; ++c) { p0 = MFMA32(ka[c], qf[c], p0); p1 = MFMA32(kc[c], qf[c], p1); }
}

template <int NDC, int KPB>
__device__ __forceinline__ void k_load(bf16x8 (&kf)[2 * NDC], const LAS unsigned char* Kt, int r, int h) {
    const LAS unsigned char* kb = Kt + r * KPB + h * 16;
#pragma unroll
    for (int c = 0; c < NDC; ++c) { kf[2 * c] = *(const LAS bf16x8*)(kb + c * 32); kf[2 * c + 1] = *(const LAS bf16x8*)(kb + 32 * KPB + c * 32); }
}
template <int NDC>
__device__ __forceinline__ void qk_mma(f32x16& p0, f32x16& p1, bf16x8 (&kf)[2 * NDC], const bf16x8* qf, const f32x16& cinit) {
    if constexpr (NDC == 4) asm volatile("" : "+v"(kf[0]), "+v"(kf[1]), "+v"(kf[2]), "+v"(kf[3]), "+v"(kf[4]), "+v"(kf[5]), "+v"(kf[6]), "+v"(kf[7]));
    else asm volatile("" : "+v"(kf[0]), "+v"(kf[1]), "+v"(kf[2]), "+v"(kf[3]), "+v"(kf[4]), "+v"(kf[5]), "+v"(kf[6]), "+v"(kf[7]), "+v"(kf[8]), "+v"(kf[9]), "+v"(kf[10]), "+v"(kf[11]));
    __builtin_amdgcn_s_setprio(1);
    p0 = MFMA32(kf[0], qf[0], cinit); p1 = MFMA32(kf[1], qf[0], cinit);
#pragma unroll
    for (int c = 1; c < NDC; ++c) { p0 = MFMA32(kf[2 * c], qf[c], p0); p1 = MFMA32(kf[2 * c + 1], qf[c], p1); }
    __builtin_amdgcn_s_setprio(0);
}
__device__ __forceinline__ bf16x8 pack8(const f32x16& p, int s, unsigned pmask) {
    u32x4 w; w.x = pk2(p[8 * s], p[8 * s + 1]) & pmask; w.y = pk2(p[8 * s + 2], p[8 * s + 3]) & pmask; w.z = pk2(p[8 * s + 4], p[8 * s + 5]) & pmask; w.w = pk2(p[8 * s + 6], p[8 * s + 7]) & pmask;
    return __builtin_bit_cast(bf16x8, w);
}

__device__ __forceinline__ void pv_load(s16x4 (&vf)[16], const LAS unsigned char* Vt, int lane) {
    const int i16 = lane & 15, q4 = i16 >> 2, p4 = i16 & 3, blk = (lane >> 4) & 1, h = lane >> 5;
    const LAS unsigned char* vb = Vt + (4 * h + q4) * VPB + blk * 32 + p4 * 8;
#pragma unroll
    for (int ks = 0; ks < 4; ++ks) {
        vf[4 * ks + 0] = vtr(vb + (16 * ks) * VPB); vf[4 * ks + 1] = vtr(vb + (16 * ks + 8) * VPB);
        vf[4 * ks + 2] = vtr(vb + (16 * ks) * VPB + 64); vf[4 * ks + 3] = vtr(vb + (16 * ks + 8) * VPB + 64);
    }
}
__device__ __forceinline__ void pv_pin(s16x4 (&vf)[16], f32x16& p0, f32x16& p1) {
    asm volatile("s_nop 15\n\ts_nop 7" : "+v"(p0), "+v"(p1));
    asm volatile("" : "+v"(vf[0]), "+v"(vf[1]), "+v"(vf[2]), "+v"(vf[3]), "+v"(vf[4]), "+v"(vf[5]), "+v"(vf[6]), "+v"(vf[7]),
                      "+v"(vf[8]), "+v"(vf[9]), "+v"(vf[10]), "+v"(vf[11]), "+v"(vf[12]), "+v"(vf[13]), "+v"(vf[14]), "+v"(vf[15]));
}
template <bool MASKED>
__device__ __forceinline__ void pv_mma(f32x16& o0, f32x16& o1, const f32x16& p0, const f32x16& p1, const s16x4 (&vf)[16], unsigned pmask) {
#pragma unroll
    for (int ks = 0; ks < 4; ++ks) {
        const bf16x8 pa = (ks < 2) ? pack8(p0, ks & 1, MASKED ? pmask : 0xffffffffu) : pack8(p1, ks & 1, MASKED ? pmask : 0xffffffffu);
        const bf16x8 v0 = __builtin_shufflevector(vf[4 * ks + 0], vf[4 * ks + 1], 0, 1, 2, 3, 4, 5, 6, 7);
        const bf16x8 v1 = __builtin_shufflevector(vf[4 * ks + 2], vf[4 * ks + 3], 0, 1, 2, 3, 4, 5, 6, 7);
        __builtin_amdgcn_s_setprio(1);
        o0 = MFMA32(pa, v0, o0);
        o1 = MFMA32(pa, v1, o1);
        __builtin_amdgcn_s_setprio(0);
    }
}

__device__ __forceinline__ float max3f(float a, float b, float c) { float r; asm("v_max3_f32 %0, %1, %2, %3" : "=v"(r) : "v"(a), "v"(b), "v"(c)); return r; }
__device__ __forceinline__ float tile_rowmax(const f32x16& p0, const f32x16& p1) {
    float a = max3f(p0[0], p0[1], p1[0]), b = max3f(p0[2], p0[3], p1[1]); a = max3f(a, p1[2], p1[3]);
#pragma unroll
    for (int i = 4; i < 16; i += 4) { a = max3f(a, p0[i], p0[i + 1]); b = max3f(b, p0[i + 2], p0[i + 3]); a = max3f(a, p1[i], p1[i + 1]); b = max3f(b, p1[i + 2], p1[i + 3]); }
    float m; asm("v_max_f32_e32 %0, %1, %2" : "=v"(m) : "v"(a), "v"(b));
    const auto rr = __builtin_amdgcn_permlane32_swap(__float_as_uint(m), __float_as_uint(m), false, false);
    float res; asm("v_max_f32_e32 %0, %1, %2" : "=v"(res) : "v"(__uint_as_float(rr[0])), "v"(__uint_as_float(rr[1])));
    return res;
}

template <bool IMPR>
__device__ __forceinline__ void softmax_step(f32x16& p0, f32x16& p1, bool lane_on, float& mref, f32x16& negm, float& l, f32x16& o0, f32x16& o1, LAS float* wsf, int r, int h, LAS float* impw) {
    float rm = tile_rowmax(p0, p1);
    rm = lane_on ? rm : -INFINITY;
    if (__any(rm > 12.0f)) {
        const float dl = fmaxf(rm, 0.f);
        mref += dl;
        const float alpha = fast_exp2(-dl);
        l *= alpha;
        if (h == 0) wsf[r] = alpha;
        asm volatile("" ::: "memory");
#pragma unroll
        for (int i = 0; i < 16; ++i) { const float a = wsf[crow(i, h)]; o0[i] *= a; o1[i] *= a; p0[i] -= dl; p1[i] -= dl; negm[i] = -mref; }
        if (IMPR) {
            asm volatile("" ::: "memory");
#pragma unroll 8
            for (int j = 0; j < 32; ++j) impw[r * 64 + 2 * j + h] *= alpha;
            asm volatile("" ::: "memory");
        }
    }
    float s0 = 0.f, s1 = 0.f, s2 = 0.f, s3 = 0.f;
#pragma unroll
    for (int i = 0; i < 16; i += 2) { p0[i] = fast_exp2(p0[i]); p1[i] = fast_exp2(p1[i]); p0[i + 1] = fast_exp2(p0[i + 1]); p1[i + 1] = fast_exp2(p1[i + 1]); s0 += p0[i]; s1 += p1[i]; s2 += p0[i + 1]; s3 += p1[i + 1]; }
    l += lane_on ? ((s0 + s1) + (s2 + s3)) : 0.f;
}

enum { MODE_MLA = 0, MODE_WIN = 1, MODE_SLC = 2, MODE_CMP1 = 3, MODE_CMP2 = 4 };

template <int MODE>
__device__ __forceinline__ void attn_tile(bf16x8 (&kpre)[(MODE == MODE_MLA) ? 12 : 8], bool have_pre, const LAS unsigned char* Knext, const LAS unsigned char* Kt, const LAS unsigned char* Vt, int t, int ti, const bf16x8* qf, int qpos, int cblk, unsigned long long sel,
                                          float& mref, f32x16& negm, float& l, f32x16& o0, f32x16& o1, float pscale, float pgate, LAS float* impw, LAS float* wsf, int lane) {
    constexpr int KPB = (MODE == MODE_MLA) ? 208 : 144;
    constexpr int NDC = (MODE == MODE_MLA) ? 6 : 4;
    const int r = lane & 31, h = lane >> 5;
    bool on = true;
    if (MODE == MODE_SLC) { on = (sel >> t) & 1ull; if (!__any((int)on)) return; }
    f32x16 p0, p1;
    PT_BEGIN(11);
    if (!have_pre) k_load<NDC, KPB>(kpre, Kt, r, h);
    if (MODE == MODE_CMP1) { f32x16 zz; for (int i = 0; i < 16; ++i) zz[i] = 0.f; qk_mma<NDC>(p0, p1, kpre, qf, zz); }
    else qk_mma<NDC>(p0, p1, kpre, qf, negm);
    if (Knext) k_load<NDC, KPB>(kpre, Knext, r, h);
    s16x4 vf[16];
    if (MODE != MODE_CMP1) pv_load(vf, Vt, lane);
    pv_pin(vf, p0, p1);
    const int kb = 64 * t + 4 * h;
    if (MODE == MODE_MLA) {
        if (64 * t + 63 > (qpos - r)) {
#pragma unroll
            for (int i = 0; i < 16; ++i) { const int kv = kb + (i & 3) + 8 * (i >> 2); if (kv > qpos) p0[i] = -INFINITY; if (kv + 32 > qpos) p1[i] = -INFINITY; }
        }
    } else if (MODE == MODE_WIN) {
        if (t == cblk || t == cblk - 8) {
#pragma unroll
            for (int i = 0; i < 16; ++i) { const int kv = kb + (i & 3) + 8 * (i >> 2);
                if (kv > qpos || kv <= qpos - 512) p0[i] = -INFINITY; if (kv + 32 > qpos || kv + 32 <= qpos - 512) p1[i] = -INFINITY; }
        }
    } else if (MODE == MODE_SLC) {
#if SLC_ELEM_MASK
        if (t == cblk || !__all((int)on)) {
#pragma unroll
            for (int i = 0; i < 16; ++i) { const int kv = kb + (i & 3) + 8 * (i >> 2); if (!on || kv > qpos) p0[i] = -INFINITY; if (!on || kv + 32 > qpos) p1[i] = -INFINITY; }
        }
        on = true;
#else
        if (t == cblk) {
#pragma unroll
            for (int i = 0; i < 16; ++i) { const int kv = kb + (i & 3) + 8 * (i >> 2); if (kv > qpos) p0[i] = -INFINITY; if (kv + 32 > qpos) p1[i] = -INFINITY; }
        }
#endif
    } else {
#pragma unroll
        for (int i = 0; i < 16; ++i) { const int kv = kb + (i & 3) + 8 * (i >> 2);
            if (16 * kv + 31 > qpos) p0[i] = -INFINITY; if (16 * (kv + 32) + 31 > qpos) p1[i] = -INFINITY; }
    }
    PT_END(11);
    if (MODE == MODE_CMP1) {
        const float rm = tile_rowmax(p0, p1);
        const float mnew = fmaxf(mref, rm);
        const float ms = (mnew == -INFINITY) ? 0.f : mnew;
        const float alpha = (mnew == -INFINITY) ? 1.f : fast_exp2(mref - mnew);
        float sm = 0.f;
#pragma unroll
        for (int i = 0; i < 16; ++i) sm += fast_exp2(p0[i] - ms) + fast_exp2(p1[i] - ms);
        l = l * alpha + sm; mref = mnew;
    } else if (MODE == MODE_CMP2) {
        softmax_step<true>(p0, p1, true, mref, negm, l, o0, o1, wsf, r, h, impw);
        LAS float* iw = impw + r * 64 + 16 * ti + h;
#pragma unroll
        for (int k = 0; k < 4; ++k) { iw[2 * k] += (p0[4 * k] + p0[4 * k + 1]) + (p0[4 * k + 2] + 0.5f * p0[4 * k + 3]); iw[8 + 2 * k] += (p1[4 * k] + p1[4 * k + 1]) + (p1[4 * k + 2] + 0.5f * p1[4 * k + 3]); }
        asm volatile("" ::: "memory");
#pragma unroll
        for (int k = 0; k < 4; ++k) { iw[2 * k + 1] += 0.5f * p0[4 * k + 3]; if (16 * ti + h + 8 + 2 * k + 1 < 64) iw[8 + 2 * k + 1] += 0.5f * p1[4 * k + 3]; }
        asm volatile("" ::: "memory");
        pv_mma<false>(o0, o1, p0, p1, vf, 0xffffffffu);
    } else {
        { PT_BEGIN(12);
        softmax_step<false>(p0, p1, on, mref, negm, l, o0, o1, wsf, r, h, impw);
        PT_END(12); }
        { PT_BEGIN(13);
        pv_mma<MODE == MODE_SLC>(o0, o1, p0, p1, vf, on ? 0xffffffffu : 0u);
        PT_END(13); }
    }
}

template <int MODE, int G>
__device__ __forceinline__ void attn_branch(LAS unsigned char* L, const bf16_t* kS, int kP, const bf16_t* vS, int vP, const bf16_t* rS, int rP,
                                            int t0, int t1, bool preloaded, const bf16x8* qf, int qpos, bool active, int wlo, int whi, int cblk, unsigned long long sel,
                                            float& mref, f32x16& negm, float& l, f32x16& o0, f32x16& o1, float pscale, float pgate, LAS float* impw, LAS float* wsf, int tid) {
    constexpr int KPB = (MODE == MODE_MLA) ? 208 : 144;
    constexpr int KSZ = 64 * KPB;
    constexpr bool DB = (2 * G <= AG);
    const int lane = tid & 63;
    const int srow = tid >> 3, sch = tid & 7;
    const int nsteps = (t1 - t0 + G - 1) / G;
    u32x4 kreg[G], vreg[G], rreg[G];
    bf16x8 kpre[(MODE == MODE_MLA) ? 12 : 8];
#define AB_LOAD(s_) do { _Pragma("unroll") for (int j_ = 0; j_ < G; ++j_) { const int t_ = t0 + (s_) * G + j_; if (t_ < t1) { \
        const size_t row_ = (size_t)t_ * 64 + srow; kreg[j_] = *(const u32x4*)(kS + row_ * kP + sch * 8); vreg[j_] = *(const u32x4*)(vS + row_ * vP + sch * 8); \
        if (MODE == MODE_MLA) { if (tid < 256) rreg[j_] = *(const u32x4*)(rS + ((size_t)t_ * 64 + (tid >> 2)) * rP + (tid & 3) * 8); } } } } while (0)
#define AB_STORE(s_) do { _Pragma("unroll") for (int j_ = 0; j_ < G; ++j_) { const int t_ = t0 + (s_) * G + j_; if (t_ < t1) { const int jj_ = (DB ? ((s_) & 1) * G : 0) + j_; \
        *(LAS u32x4*)(L + AL_T0 + jj_ * KSZ + srow * KPB + sch * 16) = kreg[j_]; *(LAS u32x4*)(L + AL_T0 + AG * KSZ + jj_ * AL_VSZ + srow * VPB + sch * 16) = vreg[j_]; \
        if (MODE == MODE_MLA) { if (tid < 256) *(LAS u32x4*)(L + AL_T0 + jj_ * KSZ + (tid >> 2) * KPB + 128 + (tid & 3) * 16) = rreg[j_]; } } } } while (0)
    if (!preloaded && nsteps > 0) { AB_LOAD(0); AB_STORE(0); }
    __syncthreads();
    for (int s = 0; s < nsteps; ++s) {
        if (s + 1 < nsteps) AB_LOAD(s + 1);
        PT_BEGIN(7);
        if (STAGGER && (tid >> 8)) __builtin_amdgcn_s_sleep(STAGGER);
        bool have_pre = false;
        const int jb = DB ? (s & 1) * G : 0;
#pragma unroll
        for (int j = 0; j < G; ++j) {
            const int t = t0 + s * G + j;
            const bool run = active && t < t1 && t >= wlo && t <= whi && (MODE != MODE_SLC || __any((int)((sel >> t) & 1ull)));
            const int tn = t + 1;
            const bool runn = KPREF && (j + 1 < G) && active && tn < t1 && tn >= wlo && tn <= whi && (MODE != MODE_SLC || __any((int)((sel >> tn) & 1ull)));
            if (run)
                attn_tile<MODE>(kpre, have_pre, runn ? (const LAS unsigned char*)(L + AL_T0 + (jb + j + 1) * KSZ) : (const LAS unsigned char*)nullptr, L + AL_T0 + (jb + j) * KSZ, L + AL_T0 + AG * KSZ + (jb + j) * AL_VSZ, t, t - t0, qf, qpos, cblk, sel, mref, negm, l, o0, o1, pscale, pgate, impw, wsf, lane);
            have_pre = run && runn;
        }
        PT_END(7);
        if (DB) {
            if (s + 1 < nsteps) AB_STORE(s + 1);
            __syncthreads();
        } else {
            __syncthreads();
            if (s + 1 < nsteps) { AB_STORE(s + 1); __syncthreads(); }
        }
    }
#undef AB_LOAD
#undef AB_STORE
}

__device__ __forceinline__ void branch_finish(f32x16& out0, f32x16& out1, const f32x16& o0, const f32x16& o1, float l, float gate, LAS float* wsf, int r, int h) {
    const float lt = l + __shfl_xor(l, 32);
    const float f = lt > 0.f ? gate / lt : 0.f;
    if (h == 0) wsf[r] = f;
    asm volatile("" ::: "memory");
#pragma unroll
    for (int i = 0; i < 16; ++i) { const float a = wsf[crow(i, h)]; out0[i] += o0[i] * a; out1[i] += o1[i] * a; }
    asm volatile("" ::: "memory");
}

__device__ __forceinline__ void branch_finish_lds(LAS float* obuf, bool active, const f32x16& o0, const f32x16& o1, float l, float gate, LAS float* wsf, int r, int h) {
    const float lt = l + __shfl_xor(l, 32);
    const float f = lt > 0.f ? gate / lt : 0.f;
    if (h == 0) wsf[r] = f;
    asm volatile("" ::: "memory");
    if (active) {
#pragma unroll
        for (int i = 0; i < 16; ++i) { const int qq = crow(i, h); const float a = wsf[qq]; obuf[qq * 64] += o0[i] * a; obuf[qq * 64 + 32] += o1[i] * a; }
    }
    asm volatile("" ::: "memory");
}
__device__ __forceinline__ float sigmoidf_(float x) { return 1.f / (1.f + __expf(-x)); }

__device__ __forceinline__ void nsa_unit(const Params& P, LAS unsigned char* L, int b, int g, int c) {
    const int tid = tid_(), lane = tid & 63, wave = __builtin_amdgcn_readfirstlane(tid >> 6), r = lane & 31, h = lane >> 5;
    unsigned char* ws = P.ws;
    const bf16_t* z = (const bf16_t*)(ws + WS_Z);
    const bf16_t* kcmp = (const bf16_t*)(ws + WS_KCMP);
    bf16_t* mix = (bf16_t*)(ws + WS_MIX);
    const bool active = wave < 6;
    const int hh = active ? (wave >> 1) : 0, qh = wave & 1, head = 3 * g + hh;
    const int q0 = 64 * c, qpos = q0 + 32 * qh + r;
    const size_t qrow = (size_t)b * T + qpos;
    LAS float* wsf = (LAS float*)(L + AL_WSF) + wave * 64;
    LAS float* impw = (LAS float*)(L + AL_IMP) + (active ? wave : 0) * 2048;
    bf16x8 qf[4];
#pragma unroll
    for (int cc = 0; cc < 4; ++cc) qf[cc] = *(const bf16x8*)(z + qrow * ZP + Z_NQ + head * 64 + 16 * cc + 8 * h);
    const bf16_t* gp = z + qrow * ZP + Z_GATE + head * 3;
    const float g_cmp = sigmoidf_(bf2f(gp[0])), g_slc = sigmoidf_(bf2f(gp[1])), g_win = sigmoidf_(bf2f(gp[2]));
    f32x16 out0, out1, o0, o1, negm;
#pragma unroll
    for (int i = 0; i < 16; ++i) { out0[i] = 0.f; out1[i] = 0.f; o0[i] = 0.f; o1[i] = 0.f; negm[i] = 0.f; }
    const int ntc = (4 * c + 3 + 63) >> 6;
    const bf16_t* kc = kcmp + (size_t)((0 * NB + b) * 2 + g) * 256 * 64;
    const bf16_t* vc = kcmp + (size_t)((1 * NB + b) * 2 + g) * 256 * 64;
    float m1 = 0.f, l1 = 0.f;
    PT_BEGIN(3);
    if (active) { for (int i = lane; i < 2048; i += 64) impw[i] = 0.f; }
    attn_branch<MODE_CMP2, AG>(L, kc, 64, vc, 64, nullptr, 0, 0, ntc, false, qf, qpos, active, 0, ntc, c, 0ull, m1, negm, l1, o0, o1, 0.f, 0.f, impw, wsf, tid);
    { const float lt = l1 + __shfl_xor(l1, 32); const float inv = lt > 0.f ? 1.f / lt : 0.f;
      if (h == 0) wsf[32 + r] = inv;
      branch_finish(out0, out1, o0, o1, l1, g_cmp, wsf, r, h); }
    __syncthreads();
    PT_END(3);
    {
        PT_BEGIN(4);
        LAS float* imp = (LAS float*)(L + AL_IMP); LAS float* sc = (LAS float*)(L + AL_SCORE); LAS unsigned long long* selL = (LAS unsigned long long*)(L + AL_SEL);
        const int q = tid >> 3, part = tid & 7;
        float my[8];
#pragma unroll
        for (int j = 0; j < 8; ++j) { const int s = part * 8 + j; const int o = (q >> 5) * 2048 + (q & 31) * 64 + s;
            const LAS float* wl = (const LAS float*)(L + AL_WSF) + (q >> 5) * 64 + 32 + (q & 31);
            const float v = (imp[o] * wl[0] + imp[o + 2 * 2048] * wl[2 * 64]) + imp[o + 4 * 2048] * wl[4 * 64];
            my[j] = (s > c) ? -1.f : ((s == 0 || s == c || s == c - 1) ? 1.0e4f : v);
            sc[q * 64 + s] = my[j]; }
        __syncthreads();
        int rank[8];
#pragma unroll
        for (int j = 0; j < 8; ++j) rank[j] = 0;
        if (c >= 16) {
            for (int s2 = 0; s2 <= c; ++s2) { const float v = sc[q * 64 + s2];
#pragma unroll
                for (int j = 0; j < 8; ++j) rank[j] += (v > my[j] || (v == my[j] && s2 < part * 8 + j)) ? 1 : 0; }
        }
        unsigned bits = 0;
#pragma unroll
        for (int j = 0; j < 8; ++j) if (part * 8 + j <= c && rank[j] < 16) bits |= 1u << j;
        unsigned lo = (part < 4) ? (bits << (8 * part)) : 0u, hi = (part >= 4) ? (bits << (8 * (part - 4))) : 0u;
        lo |= __shfl_xor(lo, 1); hi |= __shfl_xor(hi, 1); lo |= __shfl_xor(lo, 2); hi |= __shfl_xor(hi, 2); lo |= __shfl_xor(lo, 4); hi |= __shfl_xor(hi, 4);
        if (part == 0) selL[q] = ((unsigned long long)hi << 32) | lo;
        __syncthreads();
        PT_END(4);
    }
    const unsigned long long sel = ((LAS unsigned long long*)(L + AL_SEL))[32 * qh + r];
    LAS float* obuf = impw + r;
    if (active) {
#pragma unroll
        for (int i = 0; i < 16; ++i) { obuf[crow(i, h) * 64] = out0[i]; obuf[crow(i, h) * 64 + 32] = out1[i]; }
    }
    {
        const bf16_t* ks = z + (size_t)b * T * ZP + Z_NKV + ((1 * 2 + 0) * 2 + g) * 64;
        const bf16_t* vs = z + (size_t)b * T * ZP + Z_NKV + ((1 * 2 + 1) * 2 + g) * 64;
        float m = 0.f, l = 0.f;
#pragma unroll
        for (int i = 0; i < 16; ++i) { o0[i] = 0.f; o1[i] = 0.f; }
        PT_BEGIN(5);
        attn_branch<MODE_SLC, NSA_G>(L, ks, ZP, vs, ZP, nullptr, 0, 0, c + 1, false, qf, qpos, active, 0, c, c, sel, m, negm, l, o0, o1, 0.f, 0.f, impw, wsf, tid);
        branch_finish_lds(obuf, active, o0, o1, l, g_slc, wsf, r, h);
        PT_END(5);
    }
    {
        const bf16_t* kw = z + (size_t)b * T * ZP + Z_NKV + ((2 * 2 + 0) * 2 + g) * 64;
        const bf16_t* vw = z + (size_t)b * T * ZP + Z_NKV + ((2 * 2 + 1) * 2 + g) * 64;
        float m = 0.f, l = 0.f;
#pragma unroll
        for (int i = 0; i < 16; ++i) { o0[i] = 0.f; o1[i] = 0.f; negm[i] = 0.f; }
        const int tb = c >= 8 ? c - 8 : 0;
        PT_BEGIN(6);
        attn_branch<MODE_WIN, NSA_G>(L, kw, ZP, vw, ZP, nullptr, 0, tb, c + 1, false, qf, qpos, active, tb, c, c, 0ull, m, negm, l, o0, o1, 0.f, 0.f, impw, wsf, tid);
        branch_finish_lds(obuf, active, o0, o1, l, g_win, wsf, r, h);
        PT_END(6);
    }
    if (active) {
        bf16_t* op = mix + ((size_t)b * T + q0 + 32 * qh) * D + head * 64 + r;
#pragma unroll
        for (int i = 0; i < 16; ++i) { const int qq = crow(i, h); op[(size_t)qq * D] = (bf16_t)f2bf(obuf[qq * 64]); op[(size_t)qq * D + 32] = (bf16_t)f2bf(obuf[qq * 64 + 32]); }
    }
    __syncthreads();
}

__device__ __forceinline__ void mla_unit(const Params& P, LAS unsigned char* L, int b, int hd, int qb) {
    const int tid = tid_(), lane = tid & 63, wave = __builtin_amdgcn_readfirstlane(tid >> 6), r = lane & 31, h = lane >> 5;
    unsigned char* ws = P.ws;
    const bf16_t* z = (const bf16_t*)(ws + WS_Z);
    const bf16_t* qm = (const bf16_t*)(ws + WS_QM);
    const bf16_t* kvm = (const bf16_t*)(ws + WS_KVM);
    bf16_t* mix = (bf16_t*)(ws + WS_MIX);
    const int q0 = 256 * qb, qpos = q0 + 32 * wave + r;
    const size_t qrow = (size_t)b * T + qpos;
    LAS float* wsf = (LAS float*)(L + AL_WSF) + wave * 64;
    bf16x8 qf[6];
#pragma unroll
    for (int cc = 0; cc < 6; ++cc) qf[cc] = *(const bf16x8*)(qm + qrow * QMP + hd * 96 + 16 * cc + 8 * h);
    f32x16 o0, o1, out0, out1, negm;
#pragma unroll
    for (int i = 0; i < 16; ++i) { o0[i] = 0.f; o1[i] = 0.f; negm[i] = 0.f; }
    float m = 0.f, l = 0.f;
    const bf16_t* kS = kvm + (size_t)b * T * KVP + hd * 64;
    const bf16_t* vS = kvm + (size_t)b * T * KVP + 384 + hd * 64;
    const bf16_t* rS = z + (size_t)b * T * ZP + Z_KR;
    const int nt = 4 * qb + 4, whi = (q0 + 32 * wave + 31) >> 6;
    attn_branch<MODE_MLA, 2>(L, kS, KVP, vS, KVP, rS, ZP, 0, nt, false, qf, qpos, true, 0, whi, 0, 0ull, m, negm, l, o0, o1, 0.f, 0.f, wsf, wsf, tid);
    { const float lt = l + __shfl_xor(l, 32); const float f = lt > 0.f ? 1.f / lt : 0.f;
      if (h == 0) wsf[r] = f;
      asm volatile("" ::: "memory");
#pragma unroll
      for (int i = 0; i < 16; ++i) { const float a = wsf[crow(i, h)]; out0[i] = o0[i] * a; out1[i] = o1[i] * a; } }
    bf16_t* op = mix + ((size_t)b * T + q0 + 32 * wave) * D + 384 + hd * 64 + r;
#pragma unroll
    for (int i = 0; i < 16; ++i) { const int qq = crow(i, h); op[(size_t)qq * D] = (bf16_t)f2bf(out0[i]); op[(size_t)qq * D + 32] = (bf16_t)f2bf(out1[i]); }
}

constexpr int Q_NSA = 128, Q_MLA = 96, Q_UNITS = Q_NSA + Q_MLA;
__device__ const unsigned char Q_ORDER[Q_UNITS] = {63, 127, 62, 126, 61, 125, 60, 124, 59, 123, 58, 122, 57, 121, 56, 120, 55, 119, 54, 118, 53, 117, 52, 116, 51, 115, 50, 114, 49, 113, 48, 112, 47, 111, 46, 110, 45, 109, 44, 108, 43, 107, 42, 106, 41, 105, 40, 104, 39, 103, 38, 102, 37, 101, 36, 100, 35, 99, 34, 98, 33, 97, 32, 96, 31, 95, 30, 94, 29, 93, 143, 159, 175, 191, 207, 223, 28, 92, 27, 91, 26, 90, 142, 158, 174, 190, 206, 222, 25, 89, 24, 88, 23, 87, 141, 157, 173, 189, 205, 221, 22, 86, 21, 85, 140, 156, 172, 188, 204, 220, 20, 84, 19, 83, 18, 82, 139, 155, 171, 187, 203, 219, 17, 81, 16, 80, 138, 154, 170, 186, 202, 218, 15, 79, 14, 78, 13, 77, 137, 153, 169, 185, 201, 217, 12, 76, 11, 75, 136, 152, 168, 184, 200, 216, 10, 74, 9, 73, 8, 72, 135, 151, 167, 183, 199, 215, 7, 71, 134, 150, 166, 182, 198, 214, 6, 70, 5, 69, 133, 149, 165, 181, 197, 213, 4, 68, 132, 148, 164, 180, 196, 212, 3, 67, 131, 147, 163, 179, 195, 211, 2, 66, 1, 65, 130, 146, 162, 178, 194, 210, 0, 64, 129, 145, 161, 177, 193, 209, 128, 144, 160, 176, 192, 208};
__device__ __forceinline__ unsigned xcc_id_() { return (unsigned)__builtin_amdgcn_s_getreg((3 << 11) | 20) & 0x7u; }
__device__ __forceinline__ void attention_phase(const Params& P, int layer, LAS unsigned char* L, int rep) {
    unsigned* ctr = (unsigned*)(P.ws + WS_CTL) + 1024 * rep + 512 * layer;
    LAS unsigned* bc = (LAS unsigned*)(L + AL_BC);
    const int x = (int)xcc_id_();
    for (int dx = 0; dx < 8; ++dx) {
        const int q = (x + dx) & 7;
        for (;;) {
            if (tid_() == 0) bc[0] = __hip_atomic_fetch_add(ctr + 64 * q, 1u, __ATOMIC_RELAXED, __HIP_MEMORY_SCOPE_AGENT);
            __syncthreads();
            const unsigned u = bc[0];
            __syncthreads();
            if (u >= (unsigned)Q_UNITS) break;
            PT_BEGIN(u < (unsigned)Q_NSA ? 1 : 2);
            const unsigned e = Q_ORDER[u];
            if (!(e & 0x80u)) { const int bg = 2 * q + (int)((e >> 6) & 1u), c = (int)(e & 63u); nsa_unit(P, L, bg >> 1, bg & 1, c); }
            else { const int hd = (int)((e >> 4) & 7u), qb = (int)(e & 15u); mla_unit(P, L, q, hd, qb); }
            PT_END(u < (unsigned)Q_NSA ? 1 : 2);
        }
    }
    { unsigned* pc = (unsigned*)(P.ws + WS_CTL) + 1536 + 64 * layer;
      for (;;) {
          if (tid_() == 0) bc[0] = __hip_atomic_fetch_add(pc, 1u, __ATOMIC_RELAXED, __HIP_MEMORY_SCOPE_AGENT);
          __syncthreads();
          const unsigned u = bc[0];
          __syncthreads();
          if (u >= 1024u) break;
          pool_phase(P, layer, (int)u * 8, (int)u * 8 + 8);
      } }
#if PROBE_T && PROBE_T < 20
    if (bid_() == PROBE_BLK && tid_() == 0) { LAS unsigned* pa_ = (LAS unsigned*)(PT_LDS + LDS_BYTES - 32); const unsigned long long w = (unsigned long long)pa_[0] * PROBE_MUL; pa_[0] = 0u;
        const unsigned long long t0 = __builtin_amdgcn_s_memtime(); while (__builtin_amdgcn_s_memtime() - t0 < w) __builtin_amdgcn_s_sleep(8); }
    __syncthreads();
#endif
}

__device__ __forceinline__ void final_phase(const Params& P) {
    const int tid = tid_(), bid = bid_(), gdim = gdim_(), lane = tid & 63, wave = tid >> 6;
    const float* ss = (const float*)(P.ws + WS_XPART) + (size_t)4 * M * 16; const float* gf = P.in[17];
    const bf16_t* xb = (const bf16_t*)(P.ws + WS_XB);
    for (int r = bid * 8 + wave; r < M; r += gdim * 8) {
        const float rs = rsqrtf(row_sum16(ss, r) * (1.0f / 1024.0f) + EPS);
        const u32x2* xr = (const u32x2*)(xb + (size_t)r * D) + lane;
        f32x4* orow = (f32x4*)(P.out + (size_t)r * D) + lane;
#pragma unroll
        for (int j = 0; j < 4; ++j) { const f32x4 gv = *((const f32x4*)gf + lane + 64 * j); const u32x2 a = xr[64 * j];
            f32x4 v; v[0] = __builtin_bit_cast(float, a.x << 16); v[1] = __builtin_bit_cast(float, a.x & 0xffff0000u); v[2] = __builtin_bit_cast(float, a.y << 16); v[3] = __builtin_bit_cast(float, a.y & 0xffff0000u);
            orow[64 * j] = v * rs * gv; }
    }
}

#define XB_TMO      128
#define XB_XCNT(j)  (256  + 64 * (j))
#define XB_XSUB(j)  (1280 + 64 * (j))
#define XB_XGEN(j)  (2304 + 64 * (j))
#define XB_TOP      3328
#define XB_TOPGEN   3392
#define XCD_BAR_WORDS 3456
#define XB_SPIN_CAP (1u << 18)

__device__ __forceinline__ unsigned xb_ld(unsigned* p)              { return __hip_atomic_load(p, __ATOMIC_RELAXED, __HIP_MEMORY_SCOPE_AGENT); }
__device__ __forceinline__ unsigned xb_add(unsigned* p, unsigned v) { return __hip_atomic_fetch_add(p, v, __ATOMIC_RELAXED, __HIP_MEMORY_SCOPE_AGENT); }
__device__ __forceinline__ unsigned xb_xcc_id() { return (unsigned)__builtin_amdgcn_s_getreg((3 << 11) | 20) & 0xFu; }
#define XB_SPIN(cond, bar) do { unsigned _sp = 0; while (cond) { __builtin_amdgcn_s_sleep(1); \
    if ((++_sp & 255u) == 0u) { if (xb_ld(&(bar)[XB_TMO])) break; if (_sp > XB_SPIN_CAP) { atomicAdd(&(bar)[XB_TMO], 1u); break; } } } } while (0)

struct XcdBarrier {
    unsigned* bar; unsigned x;
    volatile LAS unsigned* st;
};

__device__ __forceinline__ XcdBarrier xcd_barrier_post(unsigned* bar, volatile LAS unsigned* st) {
    XcdBarrier b; b.bar = bar; b.x = xb_xcc_id(); b.st = st;
    if (threadIdx.x == 0) (void)xb_add(&bar[XB_XCNT(b.x)], 1u);
    return b;
}
__device__ __forceinline__ void xcd_barrier_complete(unsigned* bar, unsigned x, unsigned& nloc, unsigned& nx) {
    const unsigned G = gridDim.x * gridDim.y * gridDim.z;
    unsigned sum, cnt, mine, sp = 0u;
    for (;;) {
        sum = 0u; cnt = 0u; mine = 0u;
#pragma unroll
        for (unsigned j = 0; j < 16; ++j) { const unsigned c = xb_ld(&bar[XB_XCNT(j)]); sum += c; cnt += (c > 0u) ? 1u : 0u; mine = (j == x) ? c : mine; }
        if (sum == G) break;
        __builtin_amdgcn_s_sleep(1);
        if ((++sp & 255u) == 0u) { if (xb_ld(&bar[XB_TMO])) break; if (sp > XB_SPIN_CAP) { atomicAdd(&bar[XB_TMO], 1u); break; } }
    }
    nloc = mine > 0u ? mine : 1u; nx = cnt > 0u ? cnt : 1u;
}

__device__ __forceinline__ void xcd_barrier(const XcdBarrier& b) {
    asm volatile("s_waitcnt vmcnt(0)" ::: "memory");
    __syncthreads();
    if (threadIdx.x == 0) {
        unsigned* bar = b.bar;
        __builtin_amdgcn_s_waitcnt(0);
        unsigned nloc = b.st[0], nx = b.st[1];
        if (nloc == 0u) { xcd_barrier_complete(bar, b.x, nloc, nx); b.st[0] = nloc; b.st[1] = nx; }
        const unsigned old = xb_add(&bar[XB_XSUB(b.x)], 1u);
        const unsigned gen = old / nloc;
        if (old + 1u == (gen + 1u) * nloc) {
            __builtin_amdgcn_fence(__ATOMIC_RELEASE, "agent");
            asm volatile("s_waitcnt vmcnt(0)" ::: "memory");
            const unsigned og = xb_add(&bar[XB_TOP], 1u);
            const unsigned tg = og / nx;
            if (og + 1u == (tg + 1u) * nx) xb_add(&bar[XB_TOPGEN], 1u);
            else XB_SPIN(xb_ld(&bar[XB_TOPGEN]) == tg, bar);
            __builtin_amdgcn_fence(__ATOMIC_ACQUIRE, "agent");
            xb_add(&bar[XB_XGEN(b.x)], 1u);
            asm volatile("s_waitcnt vmcnt(0)" ::: "memory");
        } else {
            XB_SPIN(xb_ld(&bar[XB_XGEN(b.x)]) == gen, bar);
            __builtin_amdgcn_fence(__ATOMIC_ACQUIRE, "agent");
            asm volatile("s_waitcnt vmcnt(0)" ::: "memory");
        }
    }
    __syncthreads();
}

__device__ __forceinline__ unsigned char* ws_of(const Params& P) { unsigned char* w = P.ws; asm volatile("" : "+s"(w)); return w; }
#ifndef PMASK
#define PMASK 0xffffffffu
#endif
#ifndef PROBE_K
#define PROBE_K 0
#endif
constexpr int N_PHASES_C = 1 + 6 * DEPTH + 1;
__global__ void __launch_bounds__(512) trunk_fwd(Params P, int ph_lo, int ph_hi) {
    extern __shared__ __attribute__((aligned(16))) unsigned char lds_raw[];
    LAS unsigned char* lds = (LAS unsigned char*)lds_raw;
    cg::grid_group grid = cg::this_grid();
    volatile LAS unsigned* bst = (volatile LAS unsigned*)(lds + LDS_BYTES - 64);
    if (threadIdx.x < 16) bst[threadIdx.x] = 0u;
    __syncthreads();
    XcdBarrier bar = xcd_barrier_post((unsigned*)(P.ws + WS_CTL) + 4096, bst);
    if (ph_lo < 0) grid.sync();
    for (int ph = ph_lo; ph < ph_hi; ++ph) {
        const int l = (ph - 1) / 6, k = (ph == 0) ? 0 : ((ph == 1 + 6 * DEPTH) ? 7 : 1 + (ph - 1) % 6);
        PT_BEGIN(20 + k);
        unsigned char* ws = ws_of(P);
        float* xpb = (float*)(ws + WS_XPART); float* cpb = (float*)(ws + WS_CPART);
        if (k == 0) { if (PMASK & 1u) prologue(P, lds); }
        else if (k == 1) { if (PMASK & 2u) {
            const float* ropec = (const float*)(ws + WS_ROPE);
            EpiInProj E{(bf16_t*)(ws + WS_Z), (l == 0) ? xpb : xpb + (size_t)2 * M * 16, cpb + (size_t)(2 * l) * M * 4, cpb + (size_t)(2 * l + 1) * M * 4, ropec, ropec + (size_t)M * 16};
            run_gemm(lds, (const bf16_t*)(ws + WS_XB), D, (const bf16_t*)(ws + WS_WIN) + (size_t)l * ZP * D, ZP, D, E); } }
        else if (k == 2) {
            if (PMASK & 4u) { const float* ropec = (const float*)(ws + WS_ROPE); EpiQup E{(bf16_t*)(ws + WS_QM), cpb + (size_t)(2 * l) * M * 4, ropec, ropec + (size_t)M * 16};
                run_gemm(lds, (const bf16_t*)(ws + WS_Z) + Z_CQ, ZP, (const bf16_t*)(ws + WS_WQUP) + (size_t)l * 768 * 256, 768, 256, E); }
            if (PMASK & 8u) { unsigned char* ws2 = ws_of(P); EpiKVup E{(bf16_t*)(ws2 + WS_KVM), (const float*)(ws2 + WS_CPART) + (size_t)(2 * l + 1) * M * 4};
                run_gemm(lds, (const bf16_t*)(ws2 + WS_Z) + Z_CKV, ZP, (const bf16_t*)(ws2 + WS_WKVUP) + (size_t)l * 768 * 128, 768, 128, E, true); }
            if (PMASK & 16u) compress_phase(P, l, lds);
#if PROBE_K == 21
            compress_phase(P, l, lds);
#endif
        }
        else if (k == 3) { if (PMASK & 64u) { attention_phase(P, l, lds, 0);
#if PROBE_K == 3
            attention_phase(P, l, lds, 1);
#endif
        } }
        else if (k == 4) { if (PMASK & 128u) { EpiResid E{(bf16_t*)(ws + WS_XB), xpb + (size_t)(1 + 2 * l) * M * 16};
            run_gemm(lds, (const bf16_t*)(ws + WS_MIX), D, (const bf16_t*)(ws + WS_WOUT) + (size_t)l * D * D, D, D, E); } }
        else if (k == 5) { if (PMASK & 256u) { EpiFF1 E{(bf16_t*)(ws + WS_H), xpb + (size_t)(1 + 2 * l) * M * 16};
            run_gemm(lds, (const bf16_t*)(ws + WS_XB), D, (const bf16_t*)(ws + WS_WFF1) + (size_t)l * FF * D, FF, D, E); } }
        else if (k == 6) { if (PMASK & 512u) { EpiResid E{(bf16_t*)(ws + WS_XB), xpb + (size_t)(2 + 2 * l) * M * 16};
            run_gemm(lds, (const bf16_t*)(ws + WS_H), FF, (const bf16_t*)(ws + WS_WFF2) + (size_t)l * D * FF, D, FF, E); } }
        else { if (PMASK & 1024u) final_phase(P); }
        if (ph + 1 < ph_hi) xcd_barrier(bar);
        PT_END(20 + k);
#if PROBE_T >= 20
        if (ph == N_PHASES_C - 2) { if (bid_() == PROBE_BLK && tid_() == 0) { LAS unsigned* pa_ = (LAS unsigned*)(PT_LDS + LDS_BYTES - 32); const unsigned long long w = (unsigned long long)pa_[0] * PROBE_MUL; pa_[0] = 0u;
            const unsigned long long t0 = __builtin_amdgcn_s_memtime(); while (__builtin_amdgcn_s_memtime() - t0 < w) __builtin_amdgcn_s_sleep(8); }
            __syncthreads(); xcd_barrier(bar); }
#endif
    }
#if PROBE_T == 27
    if (bid_() == PROBE_BLK && tid_() == 0) { LAS unsigned* pa_ = (LAS unsigned*)(PT_LDS + LDS_BYTES - 32); const unsigned long long w = (unsigned long long)pa_[0] * PROBE_MUL;
        const unsigned long long t0 = __builtin_amdgcn_s_memtime(); while (__builtin_amdgcn_s_memtime() - t0 < w) __builtin_amdgcn_s_sleep(8); }
#endif
}
constexpr int N_PHASES = 1 + 6 * DEPTH + 1;

#ifndef MK_MULTI
#define MK_MULTI 0
#endif
extern "C" void kernel_launch(void* const* d_in, const int* in_sizes, int n_in, void* d_out, int out_size, void* d_ws, size_t ws_size, hipStream_t stream) {
    static int grid_blocks = 0;
    if (grid_blocks == 0) {
        if (n_in != 18 || out_size != M * D || ws_size < WS_END) { fprintf(stderr, "kernel_launch: unexpected shapes (n_in %d out %d ws %zu)\n", n_in, out_size, ws_size); grid_blocks = -1; return; }
        int dev = 0, cus = 0, per_cu = 0;
        hipGetDevice(&dev);
        hipDeviceGetAttribute(&cus, hipDeviceAttributeMultiprocessorCount, dev);
        if (hipFuncSetAttribute((const void*)trunk_fwd, hipFuncAttributeMaxDynamicSharedMemorySize, LDS_BYTES) != hipSuccess) { fprintf(stderr, "kernel_launch: hipFuncSetAttribute failed\n"); grid_blocks = -1; return; }
        if (hipOccupancyMaxActiveBlocksPerMultiprocessor(&per_cu, (const void*)trunk_fwd, 512, LDS_BYTES) != hipSuccess || per_cu < 1) { fprintf(stderr, "kernel_launch: occupancy query gave %d\n", per_cu); per_cu = 1; }
        (void)hipGetLastError();
        grid_blocks = cus * per_cu;
    }
    if (grid_blocks < 0) return;
    Params p{};
    for (int i = 0; i < 18; ++i) p.in[i] = (const float*)d_in[i];
    p.out = (float*)d_out; p.ws = (unsigned char*)d_ws;
    if (hipMemsetAsync(d_ws, 0, 65536, stream) != hipSuccess) { fprintf(stderr, "kernel_launch: memset failed\n"); return; }
    int lo = 0, hi = N_PHASES;
    void* args[] = {&p, &lo, &hi};
    hipError_t e = hipLaunchCooperativeKernel((const void*)trunk_fwd, dim3(grid_blocks), dim3(512), args, LDS_BYTES, stream);
    if (e != hipSuccess) fprintf(stderr, "cooperative launch failed: %s (grid %d)\n", hipGetErrorString(e), grid_blocks);
}
```

```cpp
#include <hip/hip_runtime.h>
#include <hip/hip_cooperative_groups.h>
#include <cstdio>
#include <cstdint>
namespace cg = cooperative_groups;

namespace pg8 {
#define PG8_LAS __attribute__((address_space(3)))
typedef unsigned short bf16_t;
typedef short bf16x8 __attribute__((ext_vector_type(8)));
typedef float f32x4 __attribute__((ext_vector_type(4)));
typedef unsigned u32x4 __attribute__((ext_vector_type(4)));
constexpr int BM = 256, BK = 64, HALF = 128, HTB = HALF * BK * 2  , STAGE_BYTES = 8 * HTB, NXCD = 8, WGM = 8;

__host__ __device__ __forceinline__ int lds_byte(int r, int c) { const int st = (r >> 4) * 2 + (c >> 5), rr = r & 15, cc = c & 31, ob = rr * 64 + cc * 2; return st * 1024 + (ob ^ (((ob >> 9) & 1) << 5)); }
__host__ __device__ __forceinline__ void stage_rc(int b, int& R, int& C) { const int st = b / 1024, sb = b % 1024, swz = sb ^ (((sb >> 9) & 1) << 5); R = (st >> 1) * 16 + swz / 64; C = (st & 1) * 32 + (swz % 64) / 2; }
__host__ __device__ __forceinline__ int perm32(int rho) { const int n = rho >> 4, i = rho & 15; return 8 * (i >> 2) + 4 * n + (i & 3); }

struct Unit { int pm, pn; };
struct Gemm { const bf16_t* A; const bf16_t* Bt; int M, N, K, lda; };
struct StaticOrder {
    int nM, nN, nwg, G, c;
    __host__ __device__ void init(int M, int N, int G_, int c_) { nM = M / BM; nN = N / BM; nwg = nM * nN; G = G_; c = c_; }
    __host__ __device__ bool next(int i, Unit& u) const {
        const long L = (long)i * G + c; if (L >= nwg) return false;
        int wgid = (int)L; { const int q = nwg / NXCD, r = nwg % NXCD, xcd = wgid % NXCD, off = wgid / NXCD; wgid = (xcd < r ? xcd * (q + 1) : r * (q + 1) + (xcd - r) * q) + off; }
        const int nig = WGM * nN, gid = wgid / nig, fm = gid * WGM, gsz = (nM - fm) < WGM ? (nM - fm) : WGM;
        u.pm = fm + ((wgid % nig) % gsz); u.pn = (wgid % nig) / gsz; return true;
    }
    __device__ __forceinline__ void a_ready(const Unit&) const {}
    __device__ __forceinline__ void done(const Unit&) const {}
};
__device__ __forceinline__ unsigned cvt_pk_bf16(float lo, float hi) { unsigned r; asm volatile("v_cvt_pk_bf16_f32 %0, %1, %2" : "=v"(r) : "v"(lo), "v"(hi)); return r; }
template <class Epi, class Sched, bool ALIGN_EPI = false, bool SP2 = false>
__device__ __forceinline__ void gemm_phase(PG8_LAS unsigned char* lds, const Gemm g, const Sched& S, const Epi& E) {
    int tid = threadIdx.x; asm volatile("" : "+v"(tid)); const int wid = __builtin_amdgcn_readfirstlane(tid >> 6), lane = tid & 63, wr = wid >> 2, wc = wid & 3, fr = lane & 15, fq = lane >> 4;
    const int K = g.K, nt = K / BK;
    unsigned voffA[2], voffB[2];
#pragma unroll
    for (int i = 0; i < 2; ++i) { int R, C; stage_rc(tid * 16 + i * 8192, R, C); const int Rb = Epi::PERM ? ((R & ~31) + perm32(R & 31)) : R;
        voffA[i] = (unsigned)(R * g.lda + C) * 2u; voffB[i] = (unsigned)(Rb * K + C) * 2u; }
    const size_t kstep = (size_t)(BK * 2);
    const size_t hstepB = (size_t)HALF * K * 2, hstepA = (size_t)HALF * g.lda * 2;
    const size_t tstepB = 2 * hstepB, tstepA = 2 * hstepA;
    const unsigned ldsw = (unsigned)wid * 1024u;
    const int aoff = lds_byte(wr * 64 + fr, fq * 8), boff = lds_byte(wc * 32 + fr, fq * 8);
#define PG8_SA(b, h) (((b) * 2 + (h)) * HTB)
#define PG8_SB(b, h) ((4 + (b) * 2 + (h)) * HTB)
#define PG8_STAGE(bufoff, gbase, voff) do { _Pragma("unroll") for (int _i = 0; _i < 2; ++_i) \
        __builtin_amdgcn_global_load_lds((const unsigned*)((const char*)(gbase) + (voff)[_i]), (PG8_LAS unsigned*)(lds + (bufoff) + ldsw + _i * 8192), 16, 0, 0); } while (0)
#define PG8_LDA(dst, b, h) do { _Pragma("unroll") for (int m = 0; m < 4; ++m) _Pragma("unroll") for (int k = 0; k < 2; ++k) dst[m][k] = *(const PG8_LAS bf16x8*)(lds + PG8_SA(b, h) + aoff + m * 2048 + k * 1024); } while (0)
#define PG8_LDB(dst, b, h) do { _Pragma("unroll") for (int n = 0; n < 2; ++n) _Pragma("unroll") for (int k = 0; k < 2; ++k) dst[n][k] = *(const PG8_LAS bf16x8*)(lds + PG8_SB(b, h) + boff + n * 2048 + k * 1024); } while (0)
#define PG8_MMA(ai, bj, At, Bt) do { __builtin_amdgcn_s_setprio(1); _Pragma("unroll") for (int m = 0; m < 4; ++m) _Pragma("unroll") for (int n = 0; n < 2; ++n) _Pragma("unroll") for (int k = 0; k < 2; ++k) \
        acc[ai][bj][m][n] = __builtin_amdgcn_mfma_f32_16x16x32_bf16(Bt[n][k], At[m][k], acc[ai][bj][m][n], 0, 0, 0); __builtin_amdgcn_s_setprio(0); } while (0)
#define PG8_WAIT_V(n) asm volatile("s_waitcnt vmcnt(" #n ")" ::: "memory")
#define PG8_WAIT_L(n) asm volatile("s_waitcnt lgkmcnt(" #n ")" ::: "memory")
#define PG8_BAR __builtin_amdgcn_s_barrier()
#define PG8_SCHED __builtin_amdgcn_sched_barrier(0)
    Unit cur, nxt; int ui = 0;
    if (!S.next(0, cur)) return;
    f32x4 acc[2][2][4][2];
#pragma unroll
    for (int a = 0; a < 2; ++a)
#pragma unroll
        for (int b = 0; b < 2; ++b)
#pragma unroll
            for (int m = 0; m < 4; ++m)
#pragma unroll
                for (int n = 0; n < 2; ++n) acc[a][b][m][n] = (f32x4){0.f, 0.f, 0.f, 0.f};
    bf16x8 At[4][2], B0[2][2], B1[2][2];
    const char* cA = (const char*)g.A + (size_t)cur.pm * tstepA; const char* cB = (const char*)g.Bt + (size_t)cur.pn * tstepB;
    S.a_ready(cur);
    if constexpr (SP2) {
        PG8_STAGE(PG8_SB(0, 0), cB, voffB); PG8_STAGE(PG8_SB(0, 1), cB + hstepB, voffB); PG8_STAGE(PG8_SA(0, 0), cA, voffA); PG8_STAGE(PG8_SA(0, 1), cA + hstepA, voffA);
        if (wr == 1) PG8_BAR;
        PG8_WAIT_V(2); PG8_BAR;
        PG8_STAGE(PG8_SB(1, 0), cB + kstep, voffB); PG8_STAGE(PG8_SA(1, 0), cA + kstep, voffA); PG8_STAGE(PG8_SB(1, 1), cB + hstepB + kstep, voffB);
        PG8_WAIT_V(6); PG8_BAR;
    } else {
        PG8_STAGE(PG8_SB(0, 0), cB, voffB); PG8_STAGE(PG8_SA(0, 0), cA, voffA); PG8_STAGE(PG8_SB(0, 1), cB + hstepB, voffB); PG8_STAGE(PG8_SA(0, 1), cA + hstepA, voffA);
        if (wr == 1) PG8_BAR;
        PG8_WAIT_V(4); PG8_BAR;
        PG8_STAGE(PG8_SB(1, 0), cB + kstep, voffB); PG8_STAGE(PG8_SA(1, 0), cA + kstep, voffA); PG8_STAGE(PG8_SB(1, 1), cB + hstepB + kstep, voffB);
        PG8_WAIT_V(6); PG8_BAR;
    }
    for (;;) {
        const bool has_next = S.next(ui + 1, nxt);
        const char* nA = has_next ? (const char*)g.A + (size_t)nxt.pm * tstepA : cA; const char* nB = has_next ? (const char*)g.Bt + (size_t)nxt.pn * tstepB : cB;
        for (int t = 0; t < nt; t += 2) {
            const bool last = (t == nt - 2);
            const char* a1 = cA + (size_t)(t + 1) * kstep;
            const char* a2 = last ? nA : cA + (size_t)(t + 2) * kstep; const char* b2 = last ? nB : cB + (size_t)(t + 2) * kstep;
            const char* a3 = a2 + kstep; const char* b3 = b2 + kstep;
            if (last && has_next) S.a_ready(nxt);
            if constexpr (SP2) {
            PG8_LDB(B0, 0, 0); PG8_LDB(B1, 0, 1); PG8_SCHED; PG8_LDA(At, 0, 0); PG8_STAGE(PG8_SA(1, 1), a1 + hstepA, voffA);
            PG8_WAIT_V(8); PG8_WAIT_L(0); PG8_BAR; PG8_MMA(0, 0, At, B0); PG8_MMA(0, 1, At, B1); PG8_BAR; PG8_SCHED;
            PG8_LDA(At, 0, 1); PG8_STAGE(PG8_SB(0, 0), b2, voffB); PG8_STAGE(PG8_SB(0, 1), b2 + hstepB, voffB); PG8_STAGE(PG8_SA(0, 0), a2, voffA);
            PG8_WAIT_V(8); PG8_WAIT_L(0); PG8_BAR; PG8_MMA(1, 0, At, B0); PG8_MMA(1, 1, At, B1); PG8_BAR; PG8_SCHED;
            PG8_LDB(B0, 1, 0); PG8_LDB(B1, 1, 1); PG8_SCHED; PG8_LDA(At, 1, 0); PG8_STAGE(PG8_SA(0, 1), a2 + hstepA, voffA);
            PG8_WAIT_V(8); PG8_WAIT_L(0); PG8_BAR; PG8_MMA(0, 0, At, B0); PG8_MMA(0, 1, At, B1); PG8_BAR; PG8_SCHED;
            PG8_LDA(At, 1, 1); PG8_STAGE(PG8_SB(1, 0), b3, voffB); PG8_STAGE(PG8_SB(1, 1), b3 + hstepB, voffB); PG8_STAGE(PG8_SA(1, 0), a3, voffA);
            PG8_WAIT_V(8); PG8_WAIT_L(0); PG8_BAR; PG8_MMA(1, 0, At, B0); PG8_MMA(1, 1, At, B1); PG8_BAR; PG8_SCHED;
            } else {
            PG8_LDB(B0, 0, 0); PG8_SCHED; PG8_LDA(At, 0, 0); PG8_STAGE(PG8_SA(1, 1), a1 + hstepA, voffA);
            PG8_WAIT_L(8); PG8_BAR; PG8_WAIT_L(0); PG8_MMA(0, 0, At, B0); PG8_BAR; PG8_SCHED;
            PG8_LDB(B1, 0, 1); PG8_STAGE(PG8_SB(0, 0), b2, voffB);
            PG8_BAR; PG8_WAIT_L(0); PG8_MMA(0, 1, At, B1); PG8_BAR;
            PG8_LDA(At, 0, 1); PG8_STAGE(PG8_SA(0, 0), a2, voffA);
            PG8_BAR; PG8_WAIT_L(0); PG8_MMA(1, 0, At, B0); PG8_BAR; PG8_SCHED;
            PG8_STAGE(PG8_SB(0, 1), b2 + hstepB, voffB);
            PG8_WAIT_V(6); PG8_BAR; PG8_MMA(1, 1, At, B1); PG8_BAR;
            PG8_LDB(B0, 1, 0); PG8_SCHED; PG8_LDA(At, 1, 0); PG8_STAGE(PG8_SA(0, 1), a2 + hstepA, voffA);
            PG8_WAIT_L(8); PG8_BAR; PG8_WAIT_L(0); PG8_MMA(0, 0, At, B0); PG8_BAR; PG8_SCHED;
            PG8_LDB(B1, 1, 1); PG8_STAGE(PG8_SB(1, 0), b3, voffB);
            PG8_BAR; PG8_WAIT_L(0); PG8_MMA(0, 1, At, B1); PG8_BAR;
            PG8_LDA(At, 1, 1); PG8_STAGE(PG8_SA(1, 0), a3, voffA);
            PG8_BAR; PG8_WAIT_L(0); PG8_MMA(1, 0, At, B0); PG8_BAR; PG8_SCHED;
            PG8_STAGE(PG8_SB(1, 1), b3 + hstepB, voffB);
            PG8_WAIT_V(6); PG8_BAR; PG8_MMA(1, 1, At, B1); PG8_BAR;
            }
        }
        if constexpr (ALIGN_EPI) { if (wr == 0) PG8_BAR; }
        if constexpr (!Epi::AFTER_DRAIN) { E(acc, cur, wr, wc, fr, fq); S.done(cur); }
        if (!has_next) break;
#pragma unroll
        for (int a = 0; a < 2; ++a)
#pragma unroll
            for (int b = 0; b < 2; ++b)
#pragma unroll
                for (int m = 0; m < 4; ++m)
#pragma unroll
                    for (int n = 0; n < 2; ++n) acc[a][b][m][n] = (f32x4){0.f, 0.f, 0.f, 0.f};
        cur = nxt; cA = nA; cB = nB; ++ui;
        if constexpr (ALIGN_EPI) { if (wr == 1) PG8_BAR; }
    }
    PG8_WAIT_V(0);
    if constexpr (!ALIGN_EPI) { if (wr == 0) PG8_BAR; }
    PG8_BAR;
    if constexpr (Epi::AFTER_DRAIN) { E.fused(acc, cur, wr, wc, fr, fq, lds, wid, lane); S.done(cur); }
#undef PG8_SA
#undef PG8_SB
#undef PG8_STAGE
#undef PG8_LDA
#undef PG8_LDB
#undef PG8_MMA
#undef PG8_WAIT_V
#undef PG8_WAIT_L
#undef PG8_BAR
#undef PG8_SCHED
}
}


#define LAS __attribute__((address_space(3)))
typedef unsigned short bf16_t;
typedef short bf16x8 __attribute__((ext_vector_type(8)));
typedef short s16x4 __attribute__((ext_vector_type(4)));
typedef float f32x4 __attribute__((ext_vector_type(4)));
typedef float f32x16 __attribute__((ext_vector_type(16)));
typedef unsigned u32x4 __attribute__((ext_vector_type(4)));
typedef unsigned u32x2 __attribute__((ext_vector_type(2)));
typedef float f32x2_t __attribute__((ext_vector_type(2)));
typedef __bf16 bf16x2_t __attribute__((ext_vector_type(2)));
typedef short v4i16_t __attribute__((ext_vector_type(4)));

constexpr int NB = 8, T = 4096, M = NB * T, D = 1024, FF = 4096, DEPTH = 2;
constexpr int P_IN = 1842, ZP = 2048;
constexpr int Z_CQ = 0, Z_CKV = 256, Z_KR = 384, Z_GATE = 416, Z_NQ = 512, Z_NKV = 896, Z_PU = 1664;
constexpr int QMP = 768, KVP = 768;
constexpr float EPS = 1e-6f;
constexpr float LOG2E = 1.4426950408889634f;
constexpr float NSA_QS = 0.125f * LOG2E;
constexpr float MLA_QS = 0.10206207261596575f * LOG2E;

constexpr size_t MiB = 1u << 20;
constexpr size_t WS_CTL = 0;
constexpr size_t WS_SS = 1 * MiB;
constexpr size_t WS_ROPE = 3 * MiB;
constexpr size_t WS_BIASP = 7 * MiB;
constexpr size_t WS_KCMP = 7 * MiB + 512 * 1024;
constexpr size_t WS_WIN = 10 * MiB, WS_WOUT = 18 * MiB, WS_WFF1 = 22 * MiB, WS_WFF2 = 38 * MiB, WS_WQUP = 54 * MiB, WS_WKVUP = 55 * MiB;
constexpr size_t WS_W1T = 56 * MiB, WS_W2T = 57 * MiB, WS_WPT = 57 * MiB + 512 * 1024;
constexpr size_t WS_XB = 64 * MiB, WS_MIX = 128 * MiB, WS_H = 192 * MiB, WS_Z = 192 * MiB, WS_QM = 320 * MiB, WS_KVM = 368 * MiB, WS_XPART = 448 * MiB, WS_CPART = 458 * MiB, WS_END = 460 * MiB;

constexpr int LDS_BYTES = 147456;

struct Params { const float* in[18]; float* out; unsigned char* ws; };

__device__ __forceinline__ unsigned f2bf(float f) { unsigned u = __builtin_bit_cast(unsigned, f); return (u + 0x7fffu + ((u >> 16) & 1u)) >> 16; }
__device__ __forceinline__ unsigned pk2(float lo, float hi) { f32x2_t v = {lo, hi}; bf16x2_t b = __builtin_convertvector(v, bf16x2_t); return __builtin_bit_cast(unsigned, b); }
__device__ __forceinline__ float bf2f(unsigned short b) { return __builtin_bit_cast(float, (unsigned)b << 16); }
__device__ __forceinline__ float wave_sum(float v) {
#pragma unroll
    for (int o = 1; o < 64; o <<= 1) v += __shfl_xor(v, o);
    return v;
}
__device__ __forceinline__ int crow(int r, int h) { return (r & 3) + 8 * (r >> 2) + 4 * h; }
__device__ __forceinline__ void atomic_addf(float* p, float v) { __hip_atomic_fetch_add(p, v, __ATOMIC_RELAXED, __HIP_MEMORY_SCOPE_AGENT); }
__device__ __forceinline__ float fast_exp2(float x) { return __builtin_amdgcn_exp2f(x); }

__device__ __forceinline__ int tid_() { int t = threadIdx.x; asm volatile("" : "+v"(t)); return t; }
__device__ __forceinline__ int bid_() { int t = blockIdx.x; asm volatile("" : "+s"(t)); return t; }
__device__ __forceinline__ int gdim_() { int t = gridDim.x; asm volatile("" : "+s"(t)); return t; }
#ifndef PROBE_T
#define PROBE_T 0
#endif
#ifndef PROBE_BLK
#define PROBE_BLK 0
#endif
#ifndef PROBE_TID
#define PROBE_TID 0
#endif
#ifndef PROBE_MUL
#define PROBE_MUL 3
#endif
#if PROBE_T
#define PT_LDS ((LAS unsigned char*)0)
#define PT_BEGIN(tag) unsigned long long pt_t0_ = 0; if ((tag) == PROBE_T) { __builtin_amdgcn_sched_barrier(0); pt_t0_ = __builtin_amdgcn_s_memtime(); __builtin_amdgcn_sched_barrier(0); }
#define PT_END(tag) do { if ((tag) == PROBE_T) { __builtin_amdgcn_sched_barrier(0); const unsigned long long pt_t1_ = __builtin_amdgcn_s_memtime(); __builtin_amdgcn_sched_barrier(0); if (bid_() == PROBE_BLK && tid_() == PROBE_TID) { LAS unsigned* pa_ = (LAS unsigned*)(PT_LDS + LDS_BYTES - 32); pa_[0] += (unsigned)(pt_t1_ - pt_t0_); } } } while (0)
#else
#define PT_BEGIN(tag) do {} while (0)
#define PT_END(tag) do {} while (0)
#endif
#define EPI_LOOP_ROWS  _Pragma("unroll") for (int ai = 0; ai < 2; ++ai) _Pragma("unroll") for (int m = 0; m < 4; ++m) if (epi_fence())
__device__ __forceinline__ bool epi_fence() { asm volatile("" ::: "memory"); return true; }
__device__ __forceinline__ float row_sum16(const float* part, int row) {
    const f32x4* p = (const f32x4*)(part + (size_t)row * 16); const f32x4 a = p[0], b = p[1], c = p[2], d = p[3];
    return (((a[0] + a[1]) + (a[2] + a[3])) + ((b[0] + b[1]) + (b[2] + b[3]))) + (((c[0] + c[1]) + (c[2] + c[3])) + ((d[0] + d[1]) + (d[2] + d[3])));
}
__device__ __forceinline__ float row_sum4(const float* part, int row) { const f32x4 a = *(const f32x4*)(part + (size_t)row * 4); return (a[0] + a[1]) + (a[2] + a[3]); }
template <int NPART>
__device__ __forceinline__ LAS float* epi_row_scales(const float* part, int pm, int wr, int wc, int fr, int fq, float inv_n, float mul) {
    LAS float* sc = (LAS float*)(size_t)131072 + (wr * 4 + wc) * 128;
    const int lane = fq * 16 + fr;
#pragma unroll
    for (int a = 0; a < 2; ++a) {
        const int row = pm * 256 + a * 128 + wr * 64 + lane;
        const float sm = (NPART == 16) ? row_sum16(part, row) : row_sum4(part, row);
        sc[a * 64 + lane] = rsqrtf(sm * inv_n + EPS) * mul;
    }
    asm volatile("" ::: "memory");
    return sc;
}
__device__ __forceinline__ void st_bf4(bf16_t* p, f32x4 v) { u32x2 w; w.x = pk2(v[0], v[1]); w.y = pk2(v[2], v[3]); *(u32x2*)p = w; }
__device__ __forceinline__ float dot4(f32x4 v) { return (v[0] * v[0] + v[1] * v[1]) + (v[2] * v[2] + v[3] * v[3]); }

struct EpiInProj {
    static constexpr bool PERM = true, AFTER_DRAIN = false;
    bf16_t* z; const float* ss_x; float* ss_cq; float* ss_ckv; const float* ropec; const float* ropes;
    __device__ __forceinline__ void operator()(const f32x4 (&acc)[2][2][4][2], const pg8::Unit& u, int wr, int wc, int fr, int fq) const {
        const int pn = u.pn;
        LAS float* sc = epi_row_scales<16>(ss_x, u.pm, wr, wc, fr, fq, 1.0f / 1024.0f, 1.0f);
        EPI_LOOP_ROWS {
            const int row = u.pm * 256 + ai * 128 + wr * 64 + m * 16 + fr;
            const float rs = sc[ai * 64 + m * 16 + fr];
            float sq = 0.f;
#pragma unroll
            for (int bj = 0; bj < 2; ++bj) {
                f32x4 v0 = acc[ai][bj][m][0] * rs, v1 = acc[ai][bj][m][1] * rs;
                const int cb = pn * 256 + bj * 128 + wc * 32;
                if (pn == 0 || (pn == 1 && bj == 0)) sq += dot4(v0) + dot4(v1);
                if (pn == 1 && bj == 1 && wc == 0) {
                    const float* cp = ropec + (size_t)row * 16 + 8 * (fq & 1); const float* sp = ropes + (size_t)row * 16 + 8 * (fq & 1);
                    const f32x4 c0 = *(const f32x4*)cp, c1 = *(const f32x4*)(cp + 4), s0 = *(const f32x4*)sp, s1 = *(const f32x4*)(sp + 4);
                    const float sg = (fq < 2) ? -1.f : 1.f;
                    f32x4 p0v, p1v;
#pragma unroll
                    for (int j = 0; j < 4; ++j) { p0v[j] = __shfl_xor(v0[j], 32); p1v[j] = __shfl_xor(v1[j], 32); }
                    v0 = v0 * c0 + p0v * s0 * sg; v1 = v1 * c1 + p1v * s1 * sg;
                }
                if (cb >= Z_NQ && cb < Z_NKV) { v0 = v0 * NSA_QS; v1 = v1 * NSA_QS; }
                u32x4 w; w.x = pk2(v0[0], v0[1]); w.y = pk2(v0[2], v0[3]); w.z = pk2(v1[0], v1[1]); w.w = pk2(v1[2], v1[3]);
                *(u32x4*)(z + (size_t)row * ZP + cb + 8 * fq) = w;
            }
            if (pn <= 1) {
                sq += __shfl_xor(sq, 16); sq += __shfl_xor(sq, 32);
                if (fq == 0) (pn == 0 ? ss_cq : ss_ckv)[(size_t)row * 4 + wc] = sq;
            }
        }
    }
};

struct EpiQup {
    static constexpr bool PERM = true, AFTER_DRAIN = false;
    bf16_t* qm; const float* ss_cq; const float* ropec; const float* ropes;
    __device__ __forceinline__ void operator()(const f32x4 (&acc)[2][2][4][2], const pg8::Unit& u, int wr, int wc, int fr, int fq) const {
        LAS float* sc = epi_row_scales<4>(ss_cq, u.pm, wr, wc, fr, fq, 1.0f / 256.0f, MLA_QS);
        EPI_LOOP_ROWS {
            const int row = u.pm * 256 + ai * 128 + wr * 64 + m * 16 + fr;
            const float rs = sc[ai * 64 + m * 16 + fr];
#pragma unroll
            for (int bj = 0; bj < 2; ++bj) {
                f32x4 v0 = acc[ai][bj][m][0] * rs, v1 = acc[ai][bj][m][1] * rs;
                const int gi = u.pn * 8 + bj * 4 + wc;
                if (gi % 3 == 2) {
                    const float* cp = ropec + (size_t)row * 16 + 8 * (fq & 1); const float* sp = ropes + (size_t)row * 16 + 8 * (fq & 1);
                    const f32x4 c0 = *(const f32x4*)cp, c1 = *(const f32x4*)(cp + 4), s0 = *(const f32x4*)sp, s1 = *(const f32x4*)(sp + 4);
                    const float sg = (fq < 2) ? -1.f : 1.f;
                    f32x4 p0v, p1v;
#pragma unroll
                    for (int j = 0; j < 4; ++j) { p0v[j] = __shfl_xor(v0[j], 32); p1v[j] = __shfl_xor(v1[j], 32); }
                    v0 = v0 * c0 + p0v * s0 * sg; v1 = v1 * c1 + p1v * s1 * sg;
                }
                u32x4 w; w.x = pk2(v0[0], v0[1]); w.y = pk2(v0[2], v0[3]); w.z = pk2(v1[0], v1[1]); w.w = pk2(v1[2], v1[3]);
                *(u32x4*)(qm + (size_t)row * QMP + gi * 32 + 8 * fq) = w;
            }
        }
    }
};

struct EpiKVup {
    static constexpr bool PERM = true, AFTER_DRAIN = false;
    bf16_t* kvm; const float* ss_ckv;
    __device__ __forceinline__ void operator()(const f32x4 (&acc)[2][2][4][2], const pg8::Unit& u, int wr, int wc, int fr, int fq) const {
        LAS float* sc = epi_row_scales<4>(ss_ckv, u.pm, wr, wc, fr, fq, 1.0f / 128.0f, 1.0f);
        EPI_LOOP_ROWS {
            const int row = u.pm * 256 + ai * 128 + wr * 64 + m * 16 + fr;
            const float rs = sc[ai * 64 + m * 16 + fr];
#pragma unroll
            for (int bj = 0; bj < 2; ++bj) {
                const f32x4 v0 = acc[ai][bj][m][0] * rs, v1 = acc[ai][bj][m][1] * rs;
                u32x4 w; w.x = pk2(v0[0], v0[1]); w.y = pk2(v0[2], v0[3]); w.z = pk2(v1[0], v1[1]); w.w = pk2(v1[2], v1[3]);
                *(u32x4*)(kvm + (size_t)row * KVP + u.pn * 256 + bj * 128 + wc * 32 + 8 * fq) = w;
            }
        }
    }
};

struct EpiResid {
    static constexpr bool PERM = true, AFTER_DRAIN = false;
    bf16_t* xb; float* ss;
    __device__ __forceinline__ void operator()(const f32x4 (&acc)[2][2][4][2], const pg8::Unit& u, int wr, int wc, int fr, int fq) const {
        EPI_LOOP_ROWS {
            const int row = u.pm * 256 + ai * 128 + wr * 64 + m * 16 + fr;
            float sq = 0.f;
#pragma unroll
            for (int bj = 0; bj < 2; ++bj) {
                bf16_t* p = xb + (size_t)row * D + u.pn * 256 + bj * 128 + wc * 32 + 8 * fq;
                const u32x4 a = *(const u32x4*)p;
                f32x4 v0, v1;
                v0[0] = __builtin_bit_cast(float, a.x << 16); v0[1] = __builtin_bit_cast(float, a.x & 0xffff0000u); v0[2] = __builtin_bit_cast(float, a.y << 16); v0[3] = __builtin_bit_cast(float, a.y & 0xffff0000u);
                v1[0] = __builtin_bit_cast(float, a.z << 16); v1[1] = __builtin_bit_cast(float, a.z & 0xffff0000u); v1[2] = __builtin_bit_cast(float, a.w << 16); v1[3] = __builtin_bit_cast(float, a.w & 0xffff0000u);
                v0 = v0 + acc[ai][bj][m][0]; v1 = v1 + acc[ai][bj][m][1];
                u32x4 w; w.x = pk2(v0[0], v0[1]); w.y = pk2(v0[2], v0[3]); w.z = pk2(v1[0], v1[1]); w.w = pk2(v1[2], v1[3]);
                *(u32x4*)p = w;
                sq += dot4(v0) + dot4(v1);
            }
            sq += __shfl_xor(sq, 16); sq += __shfl_xor(sq, 32);
            if (fq == 0) ss[(size_t)row * 16 + u.pn * 4 + wc] = sq;
        }
    }
};

struct EpiFF1 {
    static constexpr bool PERM = true, AFTER_DRAIN = false;
    bf16_t* h; const float* ss;
    __device__ __forceinline__ void operator()(const f32x4 (&acc)[2][2][4][2], const pg8::Unit& u, int wr, int wc, int fr, int fq) const {
        LAS float* sc = epi_row_scales<16>(ss, u.pm, wr, wc, fr, fq, 1.0f / 1024.0f, 1.0f);
        EPI_LOOP_ROWS {
            const int row = u.pm * 256 + ai * 128 + wr * 64 + m * 16 + fr;
            const float rs = sc[ai * 64 + m * 16 + fr];
#pragma unroll
            for (int bj = 0; bj < 2; ++bj) {
                f32x4 v0 = acc[ai][bj][m][0] * rs, v1 = acc[ai][bj][m][1] * rs;
#pragma unroll
                for (int j = 0; j < 4; ++j) { const float a = fmaxf(v0[j], 0.f), b = fmaxf(v1[j], 0.f); v0[j] = a * a; v1[j] = b * b; }
                u32x4 w; w.x = pk2(v0[0], v0[1]); w.y = pk2(v0[2], v0[3]); w.z = pk2(v1[0], v1[1]); w.w = pk2(v1[2], v1[3]);
                *(u32x4*)(h + (size_t)row * FF + u.pn * 256 + bj * 128 + wc * 32 + 8 * fq) = w;
            }
        }
    }
};

template <class Epi>
__device__ __forceinline__ void run_gemm(LAS unsigned char* lds, const bf16_t* A, int lda, const bf16_t* Bt, int N, int K, const Epi& E, bool mirror = false) {
    asm volatile("" : "+s"(N), "+s"(K), "+s"(lda));
    const int gd = gdim_(), bi = bid_();
    pg8::Gemm g{A, Bt, M, N, K, lda}; pg8::StaticOrder S; S.init(M, N, gd, mirror ? gd - 1 - bi : bi);
    pg8::gemm_phase<Epi, pg8::StaticOrder, true, true>(lds, g, S, E);
}

__device__ __forceinline__ int colmap(int mode, int n) {
    if (mode == 0) return n;
    if (mode == 1) {
        if (n < 256) return 1170 + n;
        if (n < 384) return 1426 + (n - 256);
        if (n < 416) return 1554 + (n - 384);
        if (n < 434) return 1152 + (n - 416);
        if (n < 512) return -1;
        if (n < 896) return n - 512;
        if (n < 1664) return 384 + (n - 896);
        if (n < 1920) return 1586 + (n - 1664);
        return -1;
    }
    if (mode == 2) {
        if (n < 384) return (n >> 6) * 128 + (n & 63);
        return ((n - 384) >> 6) * 128 + 64 + ((n - 384) & 63);
    }
    return n < 576 ? n : -1;
}
__device__ __forceinline__ void convert_tile(const float* src, int srcPitch, int K, bf16_t* dst, const float* rowscale, int mode, int n0, int k0, LAS float* tile, int tid) {
#pragma unroll
    for (int i = 0; i < 8; ++i) {
        const int kk = (tid >> 6) + 8 * i, nn = tid & 63; const int sc = colmap(mode, n0 + nn);
        float v = 0.f;
        if (sc >= 0) { v = __builtin_nontemporal_load(src + (size_t)(k0 + kk) * srcPitch + sc); if (rowscale) v *= rowscale[k0 + kk]; }
        tile[kk * 65 + nn] = v;
    }
    __syncthreads();
    { const int nn = tid >> 3, kc = (tid & 7) * 8; const LAS float* s = tile + kc * 65 + nn;
      u32x4 o; o.x = pk2(s[0], s[65]); o.y = pk2(s[2 * 65], s[3 * 65]); o.z = pk2(s[4 * 65], s[5 * 65]); o.w = pk2(s[6 * 65], s[7 * 65]);
      *(u32x4*)(dst + (size_t)(n0 + nn) * K + k0 + kc) = o; }
    __syncthreads();
}

__device__ __forceinline__ void prologue(const Params& P, LAS unsigned char* lds) {
    const int tid = tid_(), bid = bid_(), gdim = gdim_(), lane = tid & 63, wave = tid >> 6;
    const int gw = bid * 8 + wave, NGW = gdim * 8;
    unsigned char* ws = P.ws;
    if (bid == 0) { for (int i = tid; i < 2048; i += 512) ((unsigned*)(ws + WS_CTL))[i] = 0u; }
    { const float* x = P.in[0]; bf16_t* xb = (bf16_t*)(ws + WS_XB); float* ss0 = (float*)(ws + WS_XPART);
      for (int r = gw; r < M; r += 2 * NGW) {
          const int r2 = r + NGW;
          const f32x4* xr = (const f32x4*)(x + (size_t)r * D) + lane; const f32x4* xr2 = (const f32x4*)(x + (size_t)(r2 < M ? r2 : r) * D) + lane;
          f32x4 v[4], w[4]; float sa = 0.f, sb = 0.f;
#pragma unroll
          for (int j = 0; j < 4; ++j) { v[j] = __builtin_nontemporal_load(xr + 64 * j); w[j] = __builtin_nontemporal_load(xr2 + 64 * j); }
#pragma unroll
          for (int j = 0; j < 4; ++j) { sa += dot4(v[j]); sb += dot4(w[j]); }
          sa = wave_sum(sa); sb = wave_sum(sb);
          if (lane < 16) ss0[(size_t)r * 16 + lane] = (lane == 0) ? sa : 0.f;
          u32x2* o = (u32x2*)(xb + (size_t)r * D) + lane;
#pragma unroll
          for (int j = 0; j < 4; ++j) { u32x2 t; t.x = pk2(v[j][0], v[j][1]); t.y = pk2(v[j][2], v[j][3]); o[64 * j] = t; }
          if (r2 < M) {
              if (lane < 16) ss0[(size_t)r2 * 16 + lane] = (lane == 0) ? sb : 0.f;
              u32x2* o2 = (u32x2*)(xb + (size_t)r2 * D) + lane;
#pragma unroll
              for (int j = 0; j < 4; ++j) { u32x2 t; t.x = pk2(w[j][0], w[j][1]); t.y = pk2(w[j][2], w[j][3]); o2[64 * j] = t; }
          }
      } }
    { const int* pos = (const int*)P.in[1]; float* rc = (float*)(ws + WS_ROPE); float* rsn = rc + (size_t)M * 16;
      const float INV[16] = {1.0f, 0.5623413324356079f, 0.3162277638912201f, 0.17782793939113617f, 0.10000000149011612f, 0.05623413249850273f, 0.03162277489900589f, 0.017782794311642647f,
                             0.009999999776482582f, 0.005623413249850273f, 0.003162277629598975f, 0.0017782794311642647f, 0.0010000000474974513f, 0.000562341301701963f, 0.0003162277571391314f, 0.00017782794020604342f};
      for (int i = bid * 512 + tid; i < M * 16; i += gdim * 512) {
          const int r = i >> 4, k = i & 15; float inv = INV[0];
#pragma unroll
          for (int q = 1; q < 16; ++q) inv = (k == q) ? INV[q] : inv;
          const float ang = (float)pos[r] * inv;
          double rev = (double)ang * 0.15915494309189535; rev -= floor(rev);
          const float fr = (float)rev;
          rc[i] = __builtin_amdgcn_cosf(fr); rsn[i] = __builtin_amdgcn_sinf(fr);
      } }
    { float* bp = (float*)(ws + WS_BIASP);
      for (int it = gw; it < DEPTH * 2 * 32; it += NGW) {
          const int lk = it >> 5, ch = it & 31; const float* pp = P.in[4] + (size_t)lk * 2048 + ch * 64; const float* w1 = P.in[5] + (size_t)lk * 2048 * 64 + (size_t)ch * 64 * 64;
          float s = 0.f;
          for (int k = 0; k < 64; ++k) s += pp[k] * w1[k * 64 + lane];
          bp[it * 64 + lane] = s;
      } }
    { LAS float* tile = (LAS float*)lds;
      constexpr int C_IN = 32 * 16, C_OUT = 16 * 16, C_F1 = 64 * 16, C_F2 = 16 * 64, C_QU = 12 * 4, C_KV = 12 * 2, C_W1 = 2 * 32, C_W2 = 2, C_WP = 4;
      constexpr int PER_L = C_IN + C_OUT + C_F1 + C_F2 + C_QU + C_KV + C_W1 + C_W2 + C_WP;
      for (int it = bid; it < DEPTH * PER_L; it += gdim) {
          const int l = it / PER_L; int r = it % PER_L;
          if (r < C_IN) { convert_tile(P.in[3] + (size_t)l * D * P_IN, P_IN, D, (bf16_t*)(ws + WS_WIN) + (size_t)l * ZP * D, P.in[2] + l * D, 1, (r >> 4) * 64, (r & 15) * 64, tile, tid); continue; } r -= C_IN;
          if (r < C_OUT) { convert_tile(P.in[13] + (size_t)l * D * D, D, D, (bf16_t*)(ws + WS_WOUT) + (size_t)l * D * D, nullptr, 0, (r >> 4) * 64, (r & 15) * 64, tile, tid); continue; } r -= C_OUT;
          if (r < C_F1) { convert_tile(P.in[15] + (size_t)l * D * FF, FF, D, (bf16_t*)(ws + WS_WFF1) + (size_t)l * FF * D, P.in[14] + l * D, 0, (r >> 4) * 64, (r & 15) * 64, tile, tid); continue; } r -= C_F1;
          if (r < C_F2) { convert_tile(P.in[16] + (size_t)l * FF * D, D, FF, (bf16_t*)(ws + WS_WFF2) + (size_t)l * D * FF, nullptr, 0, (r >> 6) * 64, (r & 63) * 64, tile, tid); continue; } r -= C_F2;
          if (r < C_QU) { convert_tile(P.in[8] + (size_t)l * 256 * 576, 576, 256, (bf16_t*)(ws + WS_WQUP) + (size_t)l * 768 * 256, P.in[7] + l * 256, 3, (r >> 2) * 64, (r & 3) * 64, tile, tid); continue; } r -= C_QU;
          if (r < C_KV) { convert_tile(P.in[10] + (size_t)l * 128 * 768, 768, 128, (bf16_t*)(ws + WS_WKVUP) + (size_t)l * 768 * 128, P.in[9] + l * 128, 2, (r >> 1) * 64, (r & 1) * 64, tile, tid); continue; } r -= C_KV;
          if (r < C_W1) { const int kv = r >> 5, kt = r & 31; convert_tile(P.in[5] + (size_t)(l * 2 + kv) * 2048 * 64, 64, 2048, (bf16_t*)(ws + WS_W1T) + (size_t)(l * 2 + kv) * 64 * 2048, nullptr, 0, 0, kt * 64, tile, tid); continue; } r -= C_W1;
          if (r < C_W2) { convert_tile(P.in[6] + (size_t)(l * 2 + r) * 64 * 64, 64, 64, (bf16_t*)(ws + WS_W2T) + (size_t)(l * 2 + r) * 64 * 64, nullptr, 0, 0, 0, tile, tid); continue; } r -= C_W2;
          convert_tile(P.in[11] + (size_t)(l * 4 + r) * 64 * 64, 64, 64, (bf16_t*)(ws + WS_WPT) + (size_t)(l * 4 + r) * 64 * 64, nullptr, 0, 0, 0, tile, tid);
      } }
}

#define MFMA16(a, b, c) __builtin_amdgcn_mfma_f32_16x16x32_bf16((a), (b), (c), 0, 0, 0)
#define MFMA32(a, b, c) __builtin_amdgcn_mfma_f32_32x32x16_bf16((a), (b), (c), 0, 0, 0)

__device__ __forceinline__ float gelu_tanh(float x) {
    const float u = 0.7978845608028654f * (x + 0.044715f * x * x * x);
    const float e = __expf(2.f * u);
    const float th = 1.f - 2.f / (e + 1.f);
    return 0.5f * x * (1.f + th);
}

__device__ __forceinline__ void compress_phase(const Params& P, int layer, LAS unsigned char* lds) {
    const int tid = tid_(), bid = bid_(), gdim = gdim_(), lane = tid & 63, wave = tid >> 6, sub = wave >> 2, et = wave & 3;
    const int l16 = lane & 15, quad = lane >> 4;
    unsigned char* ws = P.ws;
    const bf16_t* z = (const bf16_t*)(ws + WS_Z);
    bf16_t* kc = (bf16_t*)(ws + WS_KCMP);
    const float* bp = (const float*)(ws + WS_BIASP);
    LAS bf16_t* hb = (LAS bf16_t*)lds + sub * (16 * 72);
    for (int bi = bid; bi < 256; bi += gdim) {
        const int id = bi * 2 + sub, kv = id >> 8, rest = id & 255, b = rest >> 5, g = (rest >> 4) & 1, n0 = (rest & 15) * 16;
        const bf16_t* w1t = (const bf16_t*)(ws + WS_W1T) + ((size_t)(layer * 2 + kv) * 64 + 16 * et + l16) * 2048 + 8 * quad;
        const bf16_t* w2t = (const bf16_t*)(ws + WS_W2T) + ((size_t)(layer * 2 + kv) * 64 + 16 * et + l16) * 64 + 8 * quad;
        const int n = n0 + l16;
        const bf16_t* zc = z + Z_NKV + (kv * 2 + g) * 64 + 8 * quad;
        f32x4 acc = {0.f, 0.f, 0.f, 0.f};
#pragma unroll 4
        for (int l = 0; l < 32; ++l) {
            int tok = 16 * n + l; tok = tok > T - 1 ? T - 1 : tok;
            const bf16_t* ar = zc + (size_t)(b * T + tok) * ZP;
#pragma unroll
            for (int dh = 0; dh < 2; ++dh) {
                const bf16x8 a = *(const bf16x8*)(ar + 32 * dh);
                const bf16x8 bb = *(const bf16x8*)(w1t + l * 64 + 32 * dh);
                acc = MFMA16(a, bb, acc);
            }
        }
        float bsum = 0.f;
        for (int ch = 0; ch < 32; ++ch) bsum += bp[((size_t)(layer * 2 + kv) * 32 + ch) * 64 + 16 * et + l16];
#pragma unroll
        for (int j = 0; j < 4; ++j) hb[(4 * quad + j) * 72 + 16 * et + l16] = (bf16_t)f2bf(gelu_tanh(acc[j] + bsum));
        __syncthreads();
        f32x4 acc2 = {0.f, 0.f, 0.f, 0.f};
#pragma unroll
        for (int ks = 0; ks < 2; ++ks) {
            const bf16x8 a = *(const LAS bf16x8*)(hb + l16 * 72 + 32 * ks + 8 * quad);
            const bf16x8 bb = *(const bf16x8*)(w2t + 32 * ks);
            acc2 = MFMA16(a, bb, acc2);
        }
#pragma unroll
        for (int j = 0; j < 4; ++j) {
            const int nr = n0 + 4 * quad + j;
            kc[((size_t)((kv * NB + b) * 2 + g) * 256 + nr) * 64 + 16 * et + l16] = (bf16_t)(nr < 255 ? f2bf(acc2[j]) : 0u);
        }
        __syncthreads();
    }
}

__device__ __forceinline__ void pool_phase(const Params& P, int layer, int wi0, int wi1) {
    const int tid = tid_(), bid = bid_(), gdim = gdim_(), lane = tid & 63, wave = tid >> 6, l16 = lane & 15, quad = lane >> 4;
    unsigned char* ws = P.ws;
    const bf16_t* z = (const bf16_t*)(ws + WS_Z);
    bf16_t* mix = (bf16_t*)(ws + WS_MIX);
    const float* psc = P.in[12] + layer * 256;
    for (int wi = wi0 + wave; wi < wi1; wi += 8) {
        const int tt = wi >> 2, gi = wi & 3, w = 2 << gi;
        const int row = tt * 16 + l16, t = row & (T - 1);
        const int cnt = (t + 1 < w) ? t + 1 : w; const float icnt = 1.0f / (float)cnt;
        const bf16_t* wpt = (const bf16_t*)(ws + WS_WPT) + ((size_t)(layer * 4 + gi) * 64 + l16) * 64 + 8 * quad;
        f32x4 acc[4];
#pragma unroll
        for (int dt = 0; dt < 4; ++dt) acc[dt] = (f32x4){0.f, 0.f, 0.f, 0.f};
#pragma unroll
        for (int ks = 0; ks < 2; ++ks) {
            const bf16_t* ur = z + (size_t)row * ZP + Z_PU + gi * 64 + 32 * ks + 8 * quad;
            float s[8];
#pragma unroll
            for (int j = 0; j < 8; ++j) s[j] = 0.f;
            for (int i = 0; i < w; ++i) {
                if (i < cnt) {
                    const bf16x8 v = *(const bf16x8*)(ur - (size_t)i * ZP);
#pragma unroll
                    for (int j = 0; j < 8; ++j) s[j] += bf2f((unsigned short)v[j]);
                }
            }
            const bf16x8 u0 = *(const bf16x8*)ur;
            u32x4 pa;
            pa.x = pk2(s[0] * icnt - bf2f((unsigned short)u0[0]), s[1] * icnt - bf2f((unsigned short)u0[1]));
            pa.y = pk2(s[2] * icnt - bf2f((unsigned short)u0[2]), s[3] * icnt - bf2f((unsigned short)u0[3]));
            pa.z = pk2(s[4] * icnt - bf2f((unsigned short)u0[4]), s[5] * icnt - bf2f((unsigned short)u0[5]));
            pa.w = pk2(s[6] * icnt - bf2f((unsigned short)u0[6]), s[7] * icnt - bf2f((unsigned short)u0[7]));
            const bf16x8 a = __builtin_bit_cast(bf16x8, pa);
#pragma unroll
            for (int dt = 0; dt < 4; ++dt) {
                const bf16x8 bb = *(const bf16x8*)(wpt + (size_t)dt * 16 * 64 + 32 * ks);
                acc[dt] = MFMA16(a, bb, acc[dt]);
            }
        }
#pragma unroll
        for (int dt = 0; dt < 4; ++dt) {
            const float sc = psc[gi * 64 + 16 * dt + l16];
#pragma unroll
            for (int j = 0; j < 4; ++j) mix[(size_t)(tt * 16 + 4 * quad + j) * D + 768 + gi * 64 + 16 * dt + l16] = (bf16_t)f2bf(acc[dt][j] * sc);
        }
    }
}

#ifndef SLC_ELEM_MASK
#define SLC_ELEM_MASK 0
#endif
#ifndef USE_NEGM
#define USE_NEGM 1
#endif
#ifndef KPREF
#define KPREF 1
#endif
#ifndef STAGGER
#define STAGGER 0
#endif
constexpr int AG = 4, NSA_G = 2;
constexpr int AL_WSF = 0, AL_BC = 2048, AL_T0 = 2304, AL_VSZ = 9216;
constexpr int AL_IMP = AL_T0 + AG * 2 * 9216, AL_SCORE = AL_IMP + 6 * 8192, AL_SEL = AL_SCORE + 16384;
static_assert(AL_SEL + 512 <= LDS_BYTES - 64 && AL_T0 + AG * (13312 + 9216) <= LDS_BYTES - 64, "attention LDS map");
constexpr int VPB = 144;

__device__ __forceinline__ s16x4 vtr(const LAS unsigned char* p) { return __builtin_bit_cast(s16x4, __builtin_amdgcn_ds_read_tr16_b64_v4i16((LAS v4i16_t*)p)); }

template <int NDC, int KPB>
__device__ __forceinline__ void qk_tile(f32x16& p0, f32x16& p1, const LAS unsigned char* Kt, const bf16x8* qf, const f32x16& cinit, int r, int h) {
    const LAS unsigned char* kb = Kt + r * KPB + h * 16;
    bf16x8 ka[NDC], kc[NDC];
#pragma unroll
    for (int c = 0; c < NDC; ++c) { ka[c] = *(const LAS bf16x8*)(kb + c * 32); kc[c] = *(const LAS bf16x8*)(kb + 32 * KPB + c * 32); }
    if constexpr (NDC == 4) asm volatile("" : "+v"(ka[0]), "+v"(ka[1]), "+v"(ka[2]), "+v"(ka[3]), "+v"(kc[0]), "+v"(kc[1]), "+v"(kc[2]), "+v"(kc[3]));
    else asm volatile("" : "+v"(ka[0]), "+v"(ka[1]), "+v"(ka[2]), "+v"(ka[3]), "+v"(ka[4]), "+v"(ka[5]), "+v"(kc[0]), "+v"(kc[1]), "+v"(kc[2]), "+v"(kc[3]), "+v"(kc[4]), "+v"(kc[5]));
    p0 = MFMA32(ka[0], qf[0], cinit); p1 = MFMA32(kc[0], qf[0], cinit);
#pragma unroll
    for (int c = 1; c < NDC; ++c) { p0 = MFMA32(ka[c], qf[c], p0); p1 = MFMA32(kc[c], qf[c], p1); }
}

template <int NDC, int KPB>
__device__ __forceinline__ void k_load(bf16x8 (&kf)[2 * NDC], const LAS unsigned char* Kt, int r, int h) {
    const LAS unsigned char* kb = Kt + r * KPB + h * 16;
#pragma unroll
    for (int c = 0; c < NDC; ++c) { kf[2 * c] = *(const LAS bf16x8*)(kb + c * 32); kf[2 * c + 1] = *(const LAS bf16x8*)(kb + 32 * KPB + c * 32); }
}
template <int NDC>
__device__ __forceinline__ void qk_mma(f32x16& p0, f32x16& p1, bf16x8 (&kf)[2 * NDC], const bf16x8* qf, const f32x16& cinit) {
    if constexpr (NDC == 4) asm volatile("" : "+v"(kf[0]), "+v"(kf[1]), "+v"(kf[2]), "+v"(kf[3]), "+v"(kf[4]), "+v"(kf[5]), "+v"(kf[6]), "+v"(kf[7]));
    else asm volatile("" : "+v"(kf[0]), "+v"(kf[1]), "+v"(kf[2]), "+v"(kf[3]), "+v"(kf[4]), "+v"(kf[5]), "+v"(kf[6]), "+v"(kf[7]), "+v"(kf[8]), "+v"(kf[9]), "+v"(kf[10]), "+v"(kf[11]));
    __builtin_amdgcn_s_setprio(1);
    p0 = MFMA32(kf[0], qf[0], cinit); p1 = MFMA32(kf[1], qf[0], cinit);
#pragma unroll
    for (int c = 1; c < NDC; ++c) { p0 = MFMA32(kf[2 * c], qf[c], p0); p1 = MFMA32(kf[2 * c + 1], qf[c], p1); }
    __builtin_amdgcn_s_setprio(0);
}
__device__ __forceinline__ bf16x8 pack8(const f32x16& p, int s, unsigned pmask) {
    u32x4 w; w.x = pk2(p[8 * s], p[8 * s + 1]) & pmask; w.y = pk2(p[8 * s + 2], p[8 * s + 3]) & pmask; w.z = pk2(p[8 * s + 4], p[8 * s + 5]) & pmask; w.w = pk2(p[8 * s + 6], p[8 * s + 7]) & pmask;
    return __builtin_bit_cast(bf16x8, w);
}

__device__ __forceinline__ void pv_load(s16x4 (&vf)[16], const LAS unsigned char* Vt, int lane) {
    const int i16 = lane & 15, q4 = i16 >> 2, p4 = i16 & 3, blk = (lane >> 4) & 1, h = lane >> 5;
    const LAS unsigned char* vb = Vt + (4 * h + q4) * VPB + blk * 32 + p4 * 8;
#pragma unroll
    for (int ks = 0; ks < 4; ++ks) {
        vf[4 * ks + 0] = vtr(vb + (16 * ks) * VPB); vf[4 * ks + 1] = vtr(vb + (16 * ks + 8) * VPB);
        vf[4 * ks + 2] = vtr(vb + (16 * ks) * VPB + 64); vf[4 * ks + 3] = vtr(vb + (16 * ks + 8) * VPB + 64);
    }
}
__device__ __forceinline__ void pv_pin(s16x4 (&vf)[16], f32x16& p0, f32x16& p1) {
    asm volatile("s_nop 15\n\ts_nop 7" : "+v"(p0), "+v"(p1));
    asm volatile("" : "+v"(vf[0]), "+v"(vf[1]), "+v"(vf[2]), "+v"(vf[3]), "+v"(vf[4]), "+v"(vf[5]), "+v"(vf[6]), "+v"(vf[7]),
                      "+v"(vf[8]), "+v"(vf[9]), "+v"(vf[10]), "+v"(vf[11]), "+v"(vf[12]), "+v"(vf[13]), "+v"(vf[14]), "+v"(vf[15]));
}
template <bool MASKED>
__device__ __forceinline__ void pv_mma(f32x16& o0, f32x16& o1, const f32x16& p0, const f32x16& p1, const s16x4 (&vf)[16], unsigned pmask) {
#pragma unroll
    for (int ks = 0; ks < 4; ++ks) {
        const bf16x8 pa = (ks < 2) ? pack8(p0, ks & 1, MASKED ? pmask : 0xffffffffu) : pack8(p1, ks & 1, MASKED ? pmask : 0xffffffffu);
        const bf16x8 v0 = __builtin_shufflevector(vf[4 * ks + 0], vf[4 * ks + 1], 0, 1, 2, 3, 4, 5, 6, 7);
        const bf16x8 v1 = __builtin_shufflevector(vf[4 * ks + 2], vf[4 * ks + 3], 0, 1, 2, 3, 4, 5, 6, 7);
        __builtin_amdgcn_s_setprio(1);
        o0 = MFMA32(pa, v0, o0);
        o1 = MFMA32(pa, v1, o1);
        __builtin_amdgcn_s_setprio(0);
    }
}

__device__ __forceinline__ float max3f(float a, float b, float c) { float r; asm("v_max3_f32 %0, %1, %2, %3" : "=v"(r) : "v"(a), "v"(b), "v"(c)); return r; }
__device__ __forceinline__ float tile_rowmax(const f32x16& p0, const f32x16& p1) {
    float a = max3f(p0[0], p0[1], p1[0]), b = max3f(p0[2], p0[3], p1[1]); a = max3f(a, p1[2], p1[3]);
#pragma unroll
    for (int i = 4; i < 16; i += 4) { a = max3f(a, p0[i], p0[i + 1]); b = max3f(b, p0[i + 2], p0[i + 3]); a = max3f(a, p1[i], p1[i + 1]); b = max3f(b, p1[i + 2], p1[i + 3]); }
    float m; asm("v_max_f32_e32 %0, %1, %2" : "=v"(m) : "v"(a), "v"(b));
    const auto rr = __builtin_amdgcn_permlane32_swap(__float_as_uint(m), __float_as_uint(m), false, false);
    float res; asm("v_max_f32_e32 %0, %1, %2" : "=v"(res) : "v"(__uint_as_float(rr[0])), "v"(__uint_as_float(rr[1])));
    return res;
}

template <bool IMPR>
__device__ __forceinline__ void softmax_step(f32x16& p0, f32x16& p1, bool lane_on, float& mref, f32x16& negm, float& l, f32x16& o0, f32x16& o1, LAS float* wsf, int r, int h, LAS float* impw) {
    float rm = tile_rowmax(p0, p1);
    rm = lane_on ? rm : -INFINITY;
    if (__any(rm > 12.0f)) {
        const float dl = fmaxf(rm, 0.f);
        mref += dl;
        const float alpha = fast_exp2(-dl);
        l *= alpha;
        if (h == 0) wsf[r] = alpha;
        asm volatile("" ::: "memory");
#pragma unroll
        for (int i = 0; i < 16; ++i) { const float a = wsf[crow(i, h)]; o0[i] *= a; o1[i] *= a; p0[i] -= dl; p1[i] -= dl; negm[i] = -mref; }
        if (IMPR) {
            asm volatile("" ::: "memory");
#pragma unroll 8
            for (int j = 0; j < 32; ++j) impw[r * 64 + 2 * j + h] *= alpha;
            asm volatile("" ::: "memory");
        }
    }
    float s0 = 0.f, s1 = 0.f, s2 = 0.f, s3 = 0.f;
#pragma unroll
    for (int i = 0; i < 16; i += 2) { p0[i] = fast_exp2(p0[i]); p1[i] = fast_exp2(p1[i]); p0[i + 1] = fast_exp2(p0[i + 1]); p1[i + 1] = fast_exp2(p1[i + 1]); s0 += p0[i]; s1 += p1[i]; s2 += p0[i + 1]; s3 += p1[i + 1]; }
    l += lane_on ? ((s0 + s1) + (s2 + s3)) : 0.f;
}

enum { MODE_MLA = 0, MODE_WIN = 1, MODE_SLC = 2, MODE_CMP1 = 3, MODE_CMP2 = 4 };

template <int MODE>
__device__ __forceinline__ void attn_tile(bf16x8 (&kpre)[(MODE == MODE_MLA) ? 12 : 8], bool have_pre, const LAS unsigned char* Knext, const LAS unsigned char* Kt, const LAS unsigned char* Vt, int t, int ti, const bf16x8* qf, int qpos, int cblk, unsigned long long sel,
                                          float& mref, f32x16& negm, float& l, f32x16& o0, f32x16& o1, float pscale, float pgate, LAS float* impw, LAS float* wsf, int lane) {
    constexpr int KPB = (MODE == MODE_MLA) ? 208 : 144;
    constexpr int NDC = (MODE == MODE_MLA) ? 6 : 4;
    const int r = lane & 31, h = lane >> 5;
    bool on = true;
    if (MODE == MODE_SLC) { on = (sel >> t) & 1ull; if (!__any((int)on)) return; }
    f32x16 p0, p1;
    PT_BEGIN(11);
    if (!have_pre) k_load<NDC, KPB>(kpre, Kt, r, h);
    if (MODE == MODE_CMP1) { f32x16 zz; for (int i = 0; i < 16; ++i) zz[i] = 0.f; qk_mma<NDC>(p0, p1, kpre, qf, zz); }
    else qk_mma<NDC>(p0, p1, kpre, qf, negm);
    if (Knext) k_load<NDC, KPB>(kpre, Knext, r, h);
    s16x4 vf[16];
    if (MODE != MODE_CMP1) pv_load(vf, Vt, lane);
    pv_pin(vf, p0, p1);
    const int kb = 64 * t + 4 * h;
    if (MODE == MODE_MLA) {
        if (64 * t + 63 > (qpos - r)) {
#pragma unroll
            for (int i = 0; i < 16; ++i) { const int kv = kb + (i & 3) + 8 * (i >> 2); if (kv > qpos) p0[i] = -INFINITY; if (kv + 32 > qpos) p1[i] = -INFINITY; }
        }
    } else if (MODE == MODE_WIN) {
        if (t == cblk || t == cblk - 8) {
#pragma unroll
            for (int i = 0; i < 16; ++i) { const int kv = kb + (i & 3) + 8 * (i >> 2);
                if (kv > qpos || kv <= qpos - 512) p0[i] = -INFINITY; if (kv + 32 > qpos || kv + 32 <= qpos - 512) p1[i] = -INFINITY; }
        }
    } else if (MODE == MODE_SLC) {
#if SLC_ELEM_MASK
        if (t == cblk || !__all((int)on)) {
#pragma unroll
            for (int i = 0; i < 16; ++i) { const int kv = kb + (i & 3) + 8 * (i >> 2); if (!on || kv > qpos) p0[i] = -INFINITY; if (!on || kv + 32 > qpos) p1[i] = -INFINITY; }
        }
        on = true;
#else
        if (t == cblk) {
#pragma unroll
            for (int i = 0; i < 16; ++i) { const int kv = kb + (i & 3) + 8 * (i >> 2); if (kv > qpos) p0[i] = -INFINITY; if (kv + 32 > qpos) p1[i] = -INFINITY; }
        }
#endif
    } else {
#pragma unroll
        for (int i = 0; i < 16; ++i) { const int kv = kb + (i & 3) + 8 * (i >> 2);
            if (16 * kv + 31 > qpos) p0[i] = -INFINITY; if (16 * (kv + 32) + 31 > qpos) p1[i] = -INFINITY; }
    }
    PT_END(11);
    if (MODE == MODE_CMP1) {
        const float rm = tile_rowmax(p0, p1);
        const float mnew = fmaxf(mref, rm);
        const float ms = (mnew == -INFINITY) ? 0.f : mnew;
        const float alpha = (mnew == -INFINITY) ? 1.f : fast_exp2(mref - mnew);
        float sm = 0.f;
#pragma unroll
        for (int i = 0; i < 16; ++i) sm += fast_exp2(p0[i] - ms) + fast_exp2(p1[i] - ms);
        l = l * alpha + sm; mref = mnew;
    } else if (MODE == MODE_CMP2) {
        softmax_step<true>(p0, p1, true, mref, negm, l, o0, o1, wsf, r, h, impw);
        LAS float* iw = impw + r * 64 + 16 * ti + h;
#pragma unroll
        for (int k = 0; k < 4; ++k) { iw[2 * k] += (p0[4 * k] + p0[4 * k + 1]) + (p0[4 * k + 2] + 0.5f * p0[4 * k + 3]); iw[8 + 2 * k] += (p1[4 * k] + p1[4 * k + 1]) + (p1[4 * k + 2] + 0.5f * p1[4 * k + 3]); }
        asm volatile("" ::: "memory");
#pragma unroll
        for (int k = 0; k < 4; ++k) { iw[2 * k + 1] += 0.5f * p0[4 * k + 3]; if (16 * ti + h + 8 + 2 * k + 1 < 64) iw[8 + 2 * k + 1] += 0.5f * p1[4 * k + 3]; }
        asm volatile("" ::: "memory");
        pv_mma<false>(o0, o1, p0, p1, vf, 0xffffffffu);
    } else {
        { PT_BEGIN(12);
        softmax_step<false>(p0, p1, on, mref, negm, l, o0, o1, wsf, r, h, impw);
        PT_END(12); }
        { PT_BEGIN(13);
        pv_mma<MODE == MODE_SLC>(o0, o1, p0, p1, vf, on ? 0xffffffffu : 0u);
        PT_END(13); }
    }
}

template <int MODE, int G>
__device__ __forceinline__ void attn_branch(LAS unsigned char* L, const bf16_t* kS, int kP, const bf16_t* vS, int vP, const bf16_t* rS, int rP,
                                            int t0, int t1, bool preloaded, const bf16x8* qf, int qpos, bool active, int wlo, int whi, int cblk, unsigned long long sel,
                                            float& mref, f32x16& negm, float& l, f32x16& o0, f32x16& o1, float pscale, float pgate, LAS float* impw, LAS float* wsf, int tid) {
    constexpr int KPB = (MODE == MODE_MLA) ? 208 : 144;
    constexpr int KSZ = 64 * KPB;
    constexpr bool DB = (2 * G <= AG);
    const int lane = tid & 63;
    const int srow = tid >> 3, sch = tid & 7;
    const int nsteps = (t1 - t0 + G - 1) / G;
    u32x4 kreg[G], vreg[G], rreg[G];
    bf16x8 kpre[(MODE == MODE_MLA) ? 12 : 8];
#define AB_LOAD(s_) do { _Pragma("unroll") for (int j_ = 0; j_ < G; ++j_) { const int t_ = t0 + (s_) * G + j_; if (t_ < t1) { \
        const size_t row_ = (size_t)t_ * 64 + srow; kreg[j_] = *(const u32x4*)(kS + row_ * kP + sch * 8); vreg[j_] = *(const u32x4*)(vS + row_ * vP + sch * 8); \
        if (MODE == MODE_MLA) { if (tid < 256) rreg[j_] = *(const u32x4*)(rS + ((size_t)t_ * 64 + (tid >> 2)) * rP + (tid & 3) * 8); } } } } while (0)
#define AB_STORE(s_) do { _Pragma("unroll") for (int j_ = 0; j_ < G; ++j_) { const int t_ = t0 + (s_) * G + j_; if (t_ < t1) { const int jj_ = (DB ? ((s_) & 1) * G : 0) + j_; \
        *(LAS u32x4*)(L + AL_T0 + jj_ * KSZ + srow * KPB + sch * 16) = kreg[j_]; *(LAS u32x4*)(L + AL_T0 + AG * KSZ + jj_ * AL_VSZ + srow * VPB + sch * 16) = vreg[j_]; \
        if (MODE == MODE_MLA) { if (tid < 256) *(LAS u32x4*)(L + AL_T0 + jj_ * KSZ + (tid >> 2) * KPB + 128 + (tid & 3) * 16) = rreg[j_]; } } } } while (0)
    if (!preloaded && nsteps > 0) { AB_LOAD(0); AB_STORE(0); }
    __syncthreads();
    for (int s = 0; s < nsteps; ++s) {
        if (s + 1 < nsteps) AB_LOAD(s + 1);
        PT_BEGIN(7);
        if (STAGGER && (tid >> 8)) __builtin_amdgcn_s_sleep(STAGGER);
        bool have_pre = false;
        const int jb = DB ? (s & 1) * G : 0;
#pragma unroll
        for (int j = 0; j < G; ++j) {
            const int t = t0 + s * G + j;
            const bool run = active && t < t1 && t >= wlo && t <= whi && (MODE != MODE_SLC || __any((int)((sel >> t) & 1ull)));
            const int tn = t + 1;
            const bool runn = KPREF && (j + 1 < G) && active && tn < t1 && tn >= wlo && tn <= whi && (MODE != MODE_SLC || __any((int)((sel >> tn) & 1ull)));
            if (run)
                attn_tile<MODE>(kpre, have_pre, runn ? (const LAS unsigned char*)(L + AL_T0 + (jb + j + 1) * KSZ) : (const LAS unsigned char*)nullptr, L + AL_T0 + (jb + j) * KSZ, L + AL_T0 + AG * KSZ + (jb + j) * AL_VSZ, t, t - t0, qf, qpos, cblk, sel, mref, negm, l, o0, o1, pscale, pgate, impw, wsf, lane);
            have_pre = run && runn;
        }
        PT_END(7);
        if (DB) {
            if (s + 1 < nsteps) AB_STORE(s + 1);
            __syncthreads();
        } else {
            __syncthreads();
            if (s + 1 < nsteps) { AB_STORE(s + 1); __syncthreads(); }
        }
    }
#undef AB_LOAD
#undef AB_STORE
}

__device__ __forceinline__ void branch_finish(f32x16& out0, f32x16& out1, const f32x16& o0, const f32x16& o1, float l, float gate, LAS float* wsf, int r, int h) {
    const float lt = l + __shfl_xor(l, 32);
    const float f = lt > 0.f ? gate / lt : 0.f;
    if (h == 0) wsf[r] = f;
    asm volatile("" ::: "memory");
#pragma unroll
    for (int i = 0; i < 16; ++i) { const float a = wsf[crow(i, h)]; out0[i] += o0[i] * a; out1[i] += o1[i] * a; }
    asm volatile("" ::: "memory");
}

__device__ __forceinline__ void branch_finish_lds(LAS float* obuf, bool active, const f32x16& o0, const f32x16& o1, float l, float gate, LAS float* wsf, int r, int h) {
    const float lt = l + __shfl_xor(l, 32);
    const float f = lt > 0.f ? gate / lt : 0.f;
    if (h == 0) wsf[r] = f;
    asm volatile("" ::: "memory");
    if (active) {
#pragma unroll
        for (int i = 0; i < 16; ++i) { const int qq = crow(i, h); const float a = wsf[qq]; obuf[qq * 64] += o0[i] * a; obuf[qq * 64 + 32] += o1[i] * a; }
    }
    asm volatile("" ::: "memory");
}
__device__ __forceinline__ float sigmoidf_(float x) { return 1.f / (1.f + __expf(-x)); }

__device__ __forceinline__ void nsa_unit(const Params& P, LAS unsigned char* L, int b, int g, int c) {
    const int tid = tid_(), lane = tid & 63, wave = __builtin_amdgcn_readfirstlane(tid >> 6), r = lane & 31, h = lane >> 5;
    unsigned char* ws = P.ws;
    const bf16_t* z = (const bf16_t*)(ws + WS_Z);
    const bf16_t* kcmp = (const bf16_t*)(ws + WS_KCMP);
    bf16_t* mix = (bf16_t*)(ws + WS_MIX);
    const bool active = wave < 6;
    const int hh = active ? (wave >> 1) : 0, qh = wave & 1, head = 3 * g + hh;
    const int q0 = 64 * c, qpos = q0 + 32 * qh + r;
    const size_t qrow = (size_t)b * T + qpos;
    LAS float* wsf = (LAS float*)(L + AL_WSF) + wave * 64;
    LAS float* impw = (LAS float*)(L + AL_IMP) + (active ? wave : 0) * 2048;
    bf16x8 qf[4];
#pragma unroll
    for (int cc = 0; cc < 4; ++cc) qf[cc] = *(const bf16x8*)(z + qrow * ZP + Z_NQ + head * 64 + 16 * cc + 8 * h);
    const bf16_t* gp = z + qrow * ZP + Z_GATE + head * 3;
    const float g_cmp = sigmoidf_(bf2f(gp[0])), g_slc = sigmoidf_(bf2f(gp[1])), g_win = sigmoidf_(bf2f(gp[2]));
    f32x16 out0, out1, o0, o1, negm;
#pragma unroll
    for (int i = 0; i < 16; ++i) { out0[i] = 0.f; out1[i] = 0.f; o0[i] = 0.f; o1[i] = 0.f; negm[i] = 0.f; }
    const int ntc = (4 * c + 3 + 63) >> 6;
    const bf16_t* kc = kcmp + (size_t)((0 * NB + b) * 2 + g) * 256 * 64;
    const bf16_t* vc = kcmp + (size_t)((1 * NB + b) * 2 + g) * 256 * 64;
    float m1 = 0.f, l1 = 0.f;
    PT_BEGIN(3);
    if (active) { for (int i = lane; i < 2048; i += 64) impw[i] = 0.f; }
    attn_branch<MODE_CMP2, AG>(L, kc, 64, vc, 64, nullptr, 0, 0, ntc, false, qf, qpos, active, 0, ntc, c, 0ull, m1, negm, l1, o0, o1, 0.f, 0.f, impw, wsf, tid);
    { const float lt = l1 + __shfl_xor(l1, 32); const float inv = lt > 0.f ? 1.f / lt : 0.f;
      if (h == 0) wsf[32 + r] = inv;
      branch_finish(out0, out1, o0, o1, l1, g_cmp, wsf, r, h); }
    __syncthreads();
    PT_END(3);
    {
        PT_BEGIN(4);
        LAS float* imp = (LAS float*)(L + AL_IMP); LAS float* sc = (LAS float*)(L + AL_SCORE); LAS unsigned long long* selL = (LAS unsigned long long*)(L + AL_SEL);
        const int q = tid >> 3, part = tid & 7;
        float my[8];
#pragma unroll
        for (int j = 0; j < 8; ++j) { const int s = part * 8 + j; const int o = (q >> 5) * 2048 + (q & 31) * 64 + s;
            const LAS float* wl = (const LAS float*)(L + AL_WSF) + (q >> 5) * 64 + 32 + (q & 31);
            const float v = (imp[o] * wl[0] + imp[o + 2 * 2048] * wl[2 * 64]) + imp[o + 4 * 2048] * wl[4 * 64];
            my[j] = (s > c) ? -1.f : ((s == 0 || s == c || s == c - 1) ? 1.0e4f : v);
            sc[q * 64 + s] = my[j]; }
        __syncthreads();
        int rank[8];
#pragma unroll
        for (int j = 0; j < 8; ++j) rank[j] = 0;
        if (c >= 16) {
            for (int s2 = 0; s2 <= c; ++s2) { const float v = sc[q * 64 + s2];
#pragma unroll
                for (int j = 0; j < 8; ++j) rank[j] += (v > my[j] || (v == my[j] && s2 < part * 8 + j)) ? 1 : 0; }
        }
        unsigned bits = 0;
#pragma unroll
        for (int j = 0; j < 8; ++j) if (part * 8 + j <= c && rank[j] < 16) bits |= 1u << j;
        unsigned lo = (part < 4) ? (bits << (8 * part)) : 0u, hi = (part >= 4) ? (bits << (8 * (part - 4))) : 0u;
        lo |= __shfl_xor(lo, 1); hi |= __shfl_xor(hi, 1); lo |= __shfl_xor(lo, 2); hi |= __shfl_xor(hi, 2); lo |= __shfl_xor(lo, 4); hi |= __shfl_xor(hi, 4);
        if (part == 0) selL[q] = ((unsigned long long)hi << 32) | lo;
        __syncthreads();
        PT_END(4);
    }
    const unsigned long long sel = ((LAS unsigned long long*)(L + AL_SEL))[32 * qh + r];
    LAS float* obuf = impw + r;
    if (active) {
#pragma unroll
        for (int i = 0; i < 16; ++i) { obuf[crow(i, h) * 64] = out0[i]; obuf[crow(i, h) * 64 + 32] = out1[i]; }
    }
    {
        const bf16_t* ks = z + (size_t)b * T * ZP + Z_NKV + ((1 * 2 + 0) * 2 + g) * 64;
        const bf16_t* vs = z + (size_t)b * T * ZP + Z_NKV + ((1 * 2 + 1) * 2 + g) * 64;
        float m = 0.f, l = 0.f;
#pragma unroll
        for (int i = 0; i < 16; ++i) { o0[i] = 0.f; o1[i] = 0.f; }
        PT_BEGIN(5);
        attn_branch<MODE_SLC, NSA_G>(L, ks, ZP, vs, ZP, nullptr, 0, 0, c + 1, false, qf, qpos, active, 0, c, c, sel, m, negm, l, o0, o1, 0.f, 0.f, impw, wsf, tid);
        branch_finish_lds(obuf, active, o0, o1, l, g_slc, wsf, r, h);
        PT_END(5);
    }
    {
        const bf16_t* kw = z + (size_t)b * T * ZP + Z_NKV + ((2 * 2 + 0) * 2 + g) * 64;
        const bf16_t* vw = z + (size_t)b * T * ZP + Z_NKV + ((2 * 2 + 1) * 2 + g) * 64;
        float m = 0.f, l = 0.f;
#pragma unroll
        for (int i = 0; i < 16; ++i) { o0[i] = 0.f; o1[i] = 0.f; negm[i] = 0.f; }
        const int tb = c >= 8 ? c - 8 : 0;
        PT_BEGIN(6);
        attn_branch<MODE_WIN, NSA_G>(L, kw, ZP, vw, ZP, nullptr, 0, tb, c + 1, false, qf, qpos, active, tb, c, c, 0ull, m, negm, l, o0, o1, 0.f, 0.f, impw, wsf, tid);
        branch_finish_lds(obuf, active, o0, o1, l, g_win, wsf, r, h);
        PT_END(6);
    }
    if (active) {
        bf16_t* op = mix + ((size_t)b * T + q0 + 32 * qh) * D + head * 64 + r;
#pragma unroll
        for (int i = 0; i < 16; ++i) { const int qq = crow(i, h); op[(size_t)qq * D] = (bf16_t)f2bf(obuf[qq * 64]); op[(size_t)qq * D + 32] = (bf16_t)f2bf(obuf[qq * 64 + 32]); }
    }
    __syncthreads();
}

__device__ __forceinline__ void mla_unit(const Params& P, LAS unsigned char* L, int b, int hd, int qb) {
    const int tid = tid_(), lane = tid & 63, wave = __builtin_amdgcn_readfirstlane(tid >> 6), r = lane & 31, h = lane >> 5;
    unsigned char* ws = P.ws;
    const bf16_t* z = (const bf16_t*)(ws + WS_Z);
    const bf16_t* qm = (const bf16_t*)(ws + WS_QM);
    const bf16_t* kvm = (const bf16_t*)(ws + WS_KVM);
    bf16_t* mix = (bf16_t*)(ws + WS_MIX);
    const int q0 = 256 * qb, qpos = q0 + 32 * wave + r;
    const size_t qrow = (size_t)b * T + qpos;
    LAS float* wsf = (LAS float*)(L + AL_WSF) + wave * 64;
    bf16x8 qf[6];
#pragma unroll
    for (int cc = 0; cc < 6; ++cc) qf[cc] = *(const bf16x8*)(qm + qrow * QMP + hd * 96 + 16 * cc + 8 * h);
    f32x16 o0, o1, out0, out1, negm;
#pragma unroll
    for (int i = 0; i < 16; ++i) { o0[i] = 0.f; o1[i] = 0.f; negm[i] = 0.f; }
    float m = 0.f, l = 0.f;
    const bf16_t* kS = kvm + (size_t)b * T * KVP + hd * 64;
    const bf16_t* vS = kvm + (size_t)b * T * KVP + 384 + hd * 64;
    const bf16_t* rS = z + (size_t)b * T * ZP + Z_KR;
    const int nt = 4 * qb + 4, whi = (q0 + 32 * wave + 31) >> 6;
    attn_branch<MODE_MLA, 2>(L, kS, KVP, vS, KVP, rS, ZP, 0, nt, false, qf, qpos, true, 0, whi, 0, 0ull, m, negm, l, o0, o1, 0.f, 0.f, wsf, wsf, tid);
    { const float lt = l + __shfl_xor(l, 32); const float f = lt > 0.f ? 1.f / lt : 0.f;
      if (h == 0) wsf[r] = f;
      asm volatile("" ::: "memory");
#pragma unroll
      for (int i = 0; i < 16; ++i) { const float a = wsf[crow(i, h)]; out0[i] = o0[i] * a; out1[i] = o1[i] * a; } }
    bf16_t* op = mix + ((size_t)b * T + q0 + 32 * wave) * D + 384 + hd * 64 + r;
#pragma unroll
    for (int i = 0; i < 16; ++i) { const int qq = crow(i, h); op[(size_t)qq * D] = (bf16_t)f2bf(out0[i]); op[(size_t)qq * D + 32] = (bf16_t)f2bf(out1[i]); }
}

constexpr int Q_NSA = 128, Q_MLA = 96, Q_UNITS = Q_NSA + Q_MLA;
__device__ const unsigned char Q_ORDER[Q_UNITS] = {63, 127, 62, 126, 61, 125, 60, 124, 59, 123, 58, 122, 57, 121, 56, 120, 55, 119, 54, 118, 53, 117, 52, 116, 51, 115, 50, 114, 49, 113, 48, 112, 47, 111, 46, 110, 45, 109, 44, 108, 43, 107, 42, 106, 41, 105, 40, 104, 39, 103, 38, 102, 37, 101, 36, 100, 35, 99, 34, 98, 33, 97, 32, 96, 31, 95, 30, 94, 29, 93, 143, 159, 175, 191, 207, 223, 28, 92, 27, 91, 26, 90, 142, 158, 174, 190, 206, 222, 25, 89, 24, 88, 23, 87, 141, 157, 173, 189, 205, 221, 22, 86, 21, 85, 140, 156, 172, 188, 204, 220, 20, 84, 19, 83, 18, 82, 139, 155, 171, 187, 203, 219, 17, 81, 16, 80, 138, 154, 170, 186, 202, 218, 15, 79, 14, 78, 13, 77, 137, 153, 169, 185, 201, 217, 12, 76, 11, 75, 136, 152, 168, 184, 200, 216, 10, 74, 9, 73, 8, 72, 135, 151, 167, 183, 199, 215, 7, 71, 134, 150, 166, 182, 198, 214, 6, 70, 5, 69, 133, 149, 165, 181, 197, 213, 4, 68, 132, 148, 164, 180, 196, 212, 3, 67, 131, 147, 163, 179, 195, 211, 2, 66, 1, 65, 130, 146, 162, 178, 194, 210, 0, 64, 129, 145, 161, 177, 193, 209, 128, 144, 160, 176, 192, 208};
__device__ __forceinline__ unsigned xcc_id_() { return (unsigned)__builtin_amdgcn_s_getreg((3 << 11) | 20) & 0x7u; }
__device__ __forceinline__ void attention_phase(const Params& P, int layer, LAS unsigned char* L, int rep) {
    unsigned* ctr = (unsigned*)(P.ws + WS_CTL) + 1024 * rep + 512 * layer;
    LAS unsigned* bc = (LAS unsigned*)(L + AL_BC);
    const int x = (int)xcc_id_();
    for (int dx = 0; dx < 8; ++dx) {
        const int q = (x + dx) & 7;
        for (;;) {
            if (tid_() == 0) bc[0] = __hip_atomic_fetch_add(ctr + 64 * q, 1u, __ATOMIC_RELAXED, __HIP_MEMORY_SCOPE_AGENT);
            __syncthreads();
            const unsigned u = bc[0];
            __syncthreads();
            if (u >= (unsigned)Q_UNITS) break;
            PT_BEGIN(u < (unsigned)Q_NSA ? 1 : 2);
            const unsigned e = Q_ORDER[u];
            if (!(e & 0x80u)) { const int bg = 2 * q + (int)((e >> 6) & 1u), c = (int)(e & 63u); nsa_unit(P, L, bg >> 1, bg & 1, c); }
            else { const int hd = (int)((e >> 4) & 7u), qb = (int)(e & 15u); mla_unit(P, L, q, hd, qb); }
            PT_END(u < (unsigned)Q_NSA ? 1 : 2);
        }
    }
    { unsigned* pc = (unsigned*)(P.ws + WS_CTL) + 1536 + 64 * layer;
      for (;;) {
          if (tid_() == 0) bc[0] = __hip_atomic_fetch_add(pc, 1u, __ATOMIC_RELAXED, __HIP_MEMORY_SCOPE_AGENT);
          __syncthreads();
          const unsigned u = bc[0];
          __syncthreads();
          if (u >= 1024u) break;
          pool_phase(P, layer, (int)u * 8, (int)u * 8 + 8);
      } }
#if PROBE_T && PROBE_T < 20
    if (bid_() == PROBE_BLK && tid_() == 0) { LAS unsigned* pa_ = (LAS unsigned*)(PT_LDS + LDS_BYTES - 32); const unsigned long long w = (unsigned long long)pa_[0] * PROBE_MUL; pa_[0] = 0u;
        const unsigned long long t0 = __builtin_amdgcn_s_memtime(); while (__builtin_amdgcn_s_memtime() - t0 < w) __builtin_amdgcn_s_sleep(8); }
    __syncthreads();
#endif
}

__device__ __forceinline__ void final_phase(const Params& P) {
    const int tid = tid_(), bid = bid_(), gdim = gdim_(), lane = tid & 63, wave = tid >> 6;
    const float* ss = (const float*)(P.ws + WS_XPART) + (size_t)4 * M * 16; const float* gf = P.in[17];
    const bf16_t* xb = (const bf16_t*)(P.ws + WS_XB);
    for (int r = bid * 8 + wave; r < M; r += gdim * 8) {
        const float rs = rsqrtf(row_sum16(ss, r) * (1.0f / 1024.0f) + EPS);
        const u32x2* xr = (const u32x2*)(xb + (size_t)r * D) + lane;
        f32x4* orow = (f32x4*)(P.out + (size_t)r * D) + lane;
#pragma unroll
        for (int j = 0; j < 4; ++j) { const f32x4 gv = *((const f32x4*)gf + lane + 64 * j); const u32x2 a = xr[64 * j];
            f32x4 v; v[0] = __builtin_bit_cast(float, a.x << 16); v[1] = __builtin_bit_cast(float, a.x & 0xffff0000u); v[2] = __builtin_bit_cast(float, a.y << 16); v[3] = __builtin_bit_cast(float, a.y & 0xffff0000u);
            __builtin_nontemporal_store(v * rs * gv, orow + 64 * j); }
    }
}

#define XB_TMO      128
#define XB_XCNT(j)  (256  + 64 * (j))
#define XB_XSUB(j)  (1280 + 64 * (j))
#define XB_XGEN(j)  (2304 + 64 * (j))
#define XB_TOP      3328
#define XB_TOPGEN   3392
#define XCD_BAR_WORDS 3456
#define XB_SPIN_CAP (1u << 18)

__device__ __forceinline__ unsigned xb_ld(unsigned* p)              { return __hip_atomic_load(p, __ATOMIC_RELAXED, __HIP_MEMORY_SCOPE_AGENT); }
__device__ __forceinline__ unsigned xb_add(unsigned* p, unsigned v) { return __hip_atomic_fetch_add(p, v, __ATOMIC_RELAXED, __HIP_MEMORY_SCOPE_AGENT); }
__device__ __forceinline__ unsigned xb_xcc_id() { return (unsigned)__builtin_amdgcn_s_getreg((3 << 11) | 20) & 0xFu; }
#define XB_SPIN(cond, bar) do { unsigned _sp = 0; while (cond) { __builtin_amdgcn_s_sleep(1); \
    if ((++_sp & 255u) == 0u) { if (xb_ld(&(bar)[XB_TMO])) break; if (_sp > XB_SPIN_CAP) { atomicAdd(&(bar)[XB_TMO], 1u); break; } } } } while (0)

struct XcdBarrier {
    unsigned* bar; unsigned x;
    volatile LAS unsigned* st;
};

__device__ __forceinline__ XcdBarrier xcd_barrier_post(unsigned* bar, volatile LAS unsigned* st) {
    XcdBarrier b; b.bar = bar; b.x = xb_xcc_id(); b.st = st;
    if (threadIdx.x == 0) (void)xb_add(&bar[XB_XCNT(b.x)], 1u);
    return b;
}
__device__ __forceinline__ void xcd_barrier_complete(unsigned* bar, unsigned x, unsigned& nloc, unsigned& nx) {
    const unsigned G = gridDim.x * gridDim.y * gridDim.z;
    unsigned sum, cnt, mine, sp = 0u;
    for (;;) {
        sum = 0u; cnt = 0u; mine = 0u;
#pragma unroll
        for (unsigned j = 0; j < 16; ++j) { const unsigned c = xb_ld(&bar[XB_XCNT(j)]); sum += c; cnt += (c > 0u) ? 1u : 0u; mine = (j == x) ? c : mine; }
        if (sum == G) break;
        __builtin_amdgcn_s_sleep(1);
        if ((++sp & 255u) == 0u) { if (xb_ld(&bar[XB_TMO])) break; if (sp > XB_SPIN_CAP) { atomicAdd(&bar[XB_TMO], 1u); break; } }
    }
    nloc = mine > 0u ? mine : 1u; nx = cnt > 0u ? cnt : 1u;
}

__device__ __forceinline__ void xcd_barrier(const XcdBarrier& b) {
    asm volatile("s_waitcnt vmcnt(0)" ::: "memory");
    __syncthreads();
    if (threadIdx.x == 0) {
        unsigned* bar = b.bar;
        __builtin_amdgcn_s_waitcnt(0);
        unsigned nloc = b.st[0], nx = b.st[1];
        if (nloc == 0u) { xcd_barrier_complete(bar, b.x, nloc, nx); b.st[0] = nloc; b.st[1] = nx; }
        const unsigned old = xb_add(&bar[XB_XSUB(b.x)], 1u);
        const unsigned gen = old / nloc;
        if (old + 1u == (gen + 1u) * nloc) {
            __builtin_amdgcn_fence(__ATOMIC_RELEASE, "agent");
            asm volatile("s_waitcnt vmcnt(0)" ::: "memory");
            const unsigned og = xb_add(&bar[XB_TOP], 1u);
            const unsigned tg = og / nx;
            if (og + 1u == (tg + 1u) * nx) xb_add(&bar[XB_TOPGEN], 1u);
            else XB_SPIN(xb_ld(&bar[XB_TOPGEN]) == tg, bar);
            __builtin_amdgcn_fence(__ATOMIC_ACQUIRE, "agent");
            xb_add(&bar[XB_XGEN(b.x)], 1u);
            asm volatile("s_waitcnt vmcnt(0)" ::: "memory");
        } else {
            XB_SPIN(xb_ld(&bar[XB_XGEN(b.x)]) == gen, bar);
            __builtin_amdgcn_fence(__ATOMIC_ACQUIRE, "agent");
            asm volatile("s_waitcnt vmcnt(0)" ::: "memory");
        }
    }
    __syncthreads();
}

__device__ __forceinline__ unsigned char* ws_of(const Params& P) { unsigned char* w = P.ws; asm volatile("" : "+s"(w)); return w; }
#ifndef PMASK
#define PMASK 0xffffffffu
#endif
#ifndef PROBE_K
#define PROBE_K 0
#endif
constexpr int N_PHASES_C = 1 + 6 * DEPTH + 1;
__global__ void __launch_bounds__(512) trunk_fwd(Params P, int ph_lo, int ph_hi) {
    extern __shared__ __attribute__((aligned(16))) unsigned char lds_raw[];
    LAS unsigned char* lds = (LAS unsigned char*)lds_raw;
    cg::grid_group grid = cg::this_grid();
    volatile LAS unsigned* bst = (volatile LAS unsigned*)(lds + LDS_BYTES - 64);
    if (threadIdx.x < 16) bst[threadIdx.x] = 0u;
    __syncthreads();
    XcdBarrier bar = xcd_barrier_post((unsigned*)(P.ws + WS_CTL) + 4096, bst);
    if (ph_lo < 0) grid.sync();
    for (int ph = ph_lo; ph < ph_hi; ++ph) {
        const int l = (ph - 1) / 6, k = (ph == 0) ? 0 : ((ph == 1 + 6 * DEPTH) ? 7 : 1 + (ph - 1) % 6);
        PT_BEGIN(20 + k);
        unsigned char* ws = ws_of(P);
        float* xpb = (float*)(ws + WS_XPART); float* cpb = (float*)(ws + WS_CPART);
        if (k == 0) { if (PMASK & 1u) prologue(P, lds); }
        else if (k == 1) { if (PMASK & 2u) {
            const float* ropec = (const float*)(ws + WS_ROPE);
            EpiInProj E{(bf16_t*)(ws + WS_Z), (l == 0) ? xpb : xpb + (size_t)2 * M * 16, cpb + (size_t)(2 * l) * M * 4, cpb + (size_t)(2 * l + 1) * M * 4, ropec, ropec + (size_t)M * 16};
            run_gemm(lds, (const bf16_t*)(ws + WS_XB), D, (const bf16_t*)(ws + WS_WIN) + (size_t)l * ZP * D, ZP, D, E); } }
        else if (k == 2) {
            if (PMASK & 4u) { const float* ropec = (const float*)(ws + WS_ROPE); EpiQup E{(bf16_t*)(ws + WS_QM), cpb + (size_t)(2 * l) * M * 4, ropec, ropec + (size_t)M * 16};
                run_gemm(lds, (const bf16_t*)(ws + WS_Z) + Z_CQ, ZP, (const bf16_t*)(ws + WS_WQUP) + (size_t)l * 768 * 256, 768, 256, E); }
            if (PMASK & 8u) { unsigned char* ws2 = ws_of(P); EpiKVup E{(bf16_t*)(ws2 + WS_KVM), (const float*)(ws2 + WS_CPART) + (size_t)(2 * l + 1) * M * 4};
                run_gemm(lds, (const bf16_t*)(ws2 + WS_Z) + Z_CKV, ZP, (const bf16_t*)(ws2 + WS_WKVUP) + (size_t)l * 768 * 128, 768, 128, E, true); }
            if (PMASK & 16u) compress_phase(P, l, lds);
#if PROBE_K == 21
            compress_phase(P, l, lds);
#endif
        }
        else if (k == 3) { if (PMASK & 64u) { attention_phase(P, l, lds, 0);
#if PROBE_K == 3
            attention_phase(P, l, lds, 1);
#endif
        } }
        else if (k == 4) { if (PMASK & 128u) { EpiResid E{(bf16_t*)(ws + WS_XB), xpb + (size_t)(1 + 2 * l) * M * 16};
            run_gemm(lds, (const bf16_t*)(ws + WS_MIX), D, (const bf16_t*)(ws + WS_WOUT) + (size_t)l * D * D, D, D, E); } }
        else if (k == 5) { if (PMASK & 256u) { EpiFF1 E{(bf16_t*)(ws + WS_H), xpb + (size_t)(1 + 2 * l) * M * 16};
            run_gemm(lds, (const bf16_t*)(ws + WS_XB), D, (const bf16_t*)(ws + WS_WFF1) + (size_t)l * FF * D, FF, D, E); } }
        else if (k == 6) { if (PMASK & 512u) { EpiResid E{(bf16_t*)(ws + WS_XB), xpb + (size_t)(2 + 2 * l) * M * 16};
            run_gemm(lds, (const bf16_t*)(ws + WS_H), FF, (const bf16_t*)(ws + WS_WFF2) + (size_t)l * D * FF, D, FF, E); } }
        else { if (PMASK & 1024u) final_phase(P); }
        if (ph + 1 < ph_hi) xcd_barrier(bar);
        PT_END(20 + k);
#if PROBE_T >= 20
        if (ph == N_PHASES_C - 2) { if (bid_() == PROBE_BLK && tid_() == 0) { LAS unsigned* pa_ = (LAS unsigned*)(PT_LDS + LDS_BYTES - 32); const unsigned long long w = (unsigned long long)pa_[0] * PROBE_MUL; pa_[0] = 0u;
            const unsigned long long t0 = __builtin_amdgcn_s_memtime(); while (__builtin_amdgcn_s_memtime() - t0 < w) __builtin_amdgcn_s_sleep(8); }
            __syncthreads(); xcd_barrier(bar); }
#endif
    }
#if PROBE_T == 27
    if (bid_() == PROBE_BLK && tid_() == 0) { LAS unsigned* pa_ = (LAS unsigned*)(PT_LDS + LDS_BYTES - 32); const unsigned long long w = (unsigned long long)pa_[0] * PROBE_MUL;
        const unsigned long long t0 = __builtin_amdgcn_s_memtime(); while (__builtin_amdgcn_s_memtime() - t0 < w) __builtin_amdgcn_s_sleep(8); }
#endif
}
constexpr int N_PHASES = 1 + 6 * DEPTH + 1;

#ifndef MK_MULTI
#define MK_MULTI 0
#endif
extern "C" void kernel_launch(void* const* d_in, const int* in_sizes, int n_in, void* d_out, int out_size, void* d_ws, size_t ws_size, hipStream_t stream) {
    static int grid_blocks = 0;
    if (grid_blocks == 0) {
        if (n_in != 18 || out_size != M * D || ws_size < WS_END) { fprintf(stderr, "kernel_launch: unexpected shapes (n_in %d out %d ws %zu)\n", n_in, out_size, ws_size); grid_blocks = -1; return; }
        int dev = 0, cus = 0, per_cu = 0;
        hipGetDevice(&dev);
        hipDeviceGetAttribute(&cus, hipDeviceAttributeMultiprocessorCount, dev);
        if (hipFuncSetAttribute((const void*)trunk_fwd, hipFuncAttributeMaxDynamicSharedMemorySize, LDS_BYTES) != hipSuccess) { fprintf(stderr, "kernel_launch: hipFuncSetAttribute failed\n"); grid_blocks = -1; return; }
        if (hipOccupancyMaxActiveBlocksPerMultiprocessor(&per_cu, (const void*)trunk_fwd, 512, LDS_BYTES) != hipSuccess || per_cu < 1) { fprintf(stderr, "kernel_launch: occupancy query gave %d\n", per_cu); per_cu = 1; }
        (void)hipGetLastError();
        grid_blocks = cus * per_cu;
    }
    if (grid_blocks < 0) return;
    Params p{};
    for (int i = 0; i < 18; ++i) p.in[i] = (const float*)d_in[i];
    p.out = (float*)d_out; p.ws = (unsigned char*)d_ws;
    if (hipMemsetAsync(d_ws, 0, 65536, stream) != hipSuccess) { fprintf(stderr, "kernel_launch: memset failed\n"); return; }
    int lo = 0, hi = N_PHASES;
    void* args[] = {&p, &lo, &hi};
    hipError_t e = hipLaunchCooperativeKernel((const void*)trunk_fwd, dim3(grid_blocks), dim3(512), args, LDS_BYTES, stream);
    if (e != hipSuccess) fprintf(stderr, "cooperative launch failed: %s (grid %d)\n", hipGetErrorString(e), grid_blocks);
}
```

```cpp
#include <hip/hip_runtime.h>
#include <hip/hip_cooperative_groups.h>
#include <cstdio>
#include <cstdint>
namespace cg = cooperative_groups;

namespace pg8 {
#define PG8_LAS __attribute__((address_space(3)))
typedef unsigned short bf16_t;
typedef short bf16x8 __attribute__((ext_vector_type(8)));
typedef float f32x4 __attribute__((ext_vector_type(4)));
typedef unsigned u32x4 __attribute__((ext_vector_type(4)));
constexpr int BM = 256, BK = 64, HALF = 128, HTB = HALF * BK * 2  , STAGE_BYTES = 8 * HTB, NXCD = 8, WGM = 8;

__host__ __device__ __forceinline__ int lds_byte(int r, int c) { const int st = (r >> 4) * 2 + (c >> 5), rr = r & 15, cc = c & 31, ob = rr * 64 + cc * 2; return st * 1024 + (ob ^ (((ob >> 9) & 1) << 5)); }
__host__ __device__ __forceinline__ void stage_rc(int b, int& R, int& C) { const int st = b / 1024, sb = b % 1024, swz = sb ^ (((sb >> 9) & 1) << 5); R = (st >> 1) * 16 + swz / 64; C = (st & 1) * 32 + (swz % 64) / 2; }
__host__ __device__ __forceinline__ int perm32(int rho) { const int n = rho >> 4, i = rho & 15; return 8 * (i >> 2) + 4 * n + (i & 3); }

struct Unit { int pm, pn; };
struct Gemm { const bf16_t* A; const bf16_t* Bt; int M, N, K, lda; };
struct StaticOrder {
    int nM, nN, nwg, G, c;
    __host__ __device__ void init(int M, int N, int G_, int c_) { nM = M / BM; nN = N / BM; nwg = nM * nN; G = G_; c = c_; }
    __host__ __device__ bool next(int i, Unit& u) const {
        const long L = (long)i * G + c; if (L >= nwg) return false;
        int wgid = (int)L; { const int q = nwg / NXCD, r = nwg % NXCD, xcd = wgid % NXCD, off = wgid / NXCD; wgid = (xcd < r ? xcd * (q + 1) : r * (q + 1) + (xcd - r) * q) + off; }
        const int nig = WGM * nN, gid = wgid / nig, fm = gid * WGM, gsz = (nM - fm) < WGM ? (nM - fm) : WGM;
        u.pm = fm + ((wgid % nig) % gsz); u.pn = (wgid % nig) / gsz; return true;
    }
    __device__ __forceinline__ void a_ready(const Unit&) const {}
    __device__ __forceinline__ void done(const Unit&) const {}
};
__device__ __forceinline__ unsigned cvt_pk_bf16(float lo, float hi) { unsigned r; asm volatile("v_cvt_pk_bf16_f32 %0, %1, %2" : "=v"(r) : "v"(lo), "v"(hi)); return r; }
template <class Epi, class Sched, bool ALIGN_EPI = false, bool SP2 = false>
__device__ __forceinline__ void gemm_phase(PG8_LAS unsigned char* lds, const Gemm g, const Sched& S, const Epi& E) {
    int tid = threadIdx.x; asm volatile("" : "+v"(tid)); const int wid = __builtin_amdgcn_readfirstlane(tid >> 6), lane = tid & 63, wr = wid >> 2, wc = wid & 3, fr = lane & 15, fq = lane >> 4;
    const int K = g.K, nt = K / BK;
    unsigned voffA[2], voffB[2];
#pragma unroll
    for (int i = 0; i < 2; ++i) { int R, C; stage_rc(tid * 16 + i * 8192, R, C); const int Rb = Epi::PERM ? ((R & ~31) + perm32(R & 31)) : R;
        voffA[i] = (unsigned)(R * g.lda + C) * 2u; voffB[i] = (unsigned)(Rb * K + C) * 2u; }
    const size_t kstep = (size_t)(BK * 2);
    const size_t hstepB = (size_t)HALF * K * 2, hstepA = (size_t)HALF * g.lda * 2;
    const size_t tstepB = 2 * hstepB, tstepA = 2 * hstepA;
    const unsigned ldsw = (unsigned)wid * 1024u;
    const int aoff = lds_byte(wr * 64 + fr, fq * 8), boff = lds_byte(wc * 32 + fr, fq * 8);
#define PG8_SA(b, h) (((b) * 2 + (h)) * HTB)
#define PG8_SB(b, h) ((4 + (b) * 2 + (h)) * HTB)
#define PG8_STAGE(bufoff, gbase, voff) do { _Pragma("unroll") for (int _i = 0; _i < 2; ++_i) \
        __builtin_amdgcn_global_load_lds((const unsigned*)((const char*)(gbase) + (voff)[_i]), (PG8_LAS unsigned*)(lds + (bufoff) + ldsw + _i * 8192), 16, 0, 0); } while (0)
#define PG8_LDA(dst, b, h) do { _Pragma("unroll") for (int m = 0; m < 4; ++m) _Pragma("unroll") for (int k = 0; k < 2; ++k) dst[m][k] = *(const PG8_LAS bf16x8*)(lds + PG8_SA(b, h) + aoff + m * 2048 + k * 1024); } while (0)
#define PG8_LDB(dst, b, h) do { _Pragma("unroll") for (int n = 0; n < 2; ++n) _Pragma("unroll") for (int k = 0; k < 2; ++k) dst[n][k] = *(const PG8_LAS bf16x8*)(lds + PG8_SB(b, h) + boff + n * 2048 + k * 1024); } while (0)
#define PG8_MMA(ai, bj, At, Bt) do { __builtin_amdgcn_s_setprio(1); _Pragma("unroll") for (int m = 0; m < 4; ++m) _Pragma("unroll") for (int n = 0; n < 2; ++n) _Pragma("unroll") for (int k = 0; k < 2; ++k) \
        acc[ai][bj][m][n] = __builtin_amdgcn_mfma_f32_16x16x32_bf16(Bt[n][k], At[m][k], acc[ai][bj][m][n], 0, 0, 0); __builtin_amdgcn_s_setprio(0); } while (0)
#define PG8_WAIT_V(n) asm volatile("s_waitcnt vmcnt(" #n ")" ::: "memory")
#define PG8_WAIT_L(n) asm volatile("s_waitcnt lgkmcnt(" #n ")" ::: "memory")
#define PG8_BAR __builtin_amdgcn_s_barrier()
#define PG8_SCHED __builtin_amdgcn_sched_barrier(0)
    Unit cur, nxt; int ui = 0;
    if (!S.next(0, cur)) return;
    f32x4 acc[2][2][4][2];
#pragma unroll
    for (int a = 0; a < 2; ++a)
#pragma unroll
        for (int b = 0; b < 2; ++b)
#pragma unroll
            for (int m = 0; m < 4; ++m)
#pragma unroll
                for (int n = 0; n < 2; ++n) acc[a][b][m][n] = (f32x4){0.f, 0.f, 0.f, 0.f};
    bf16x8 At[4][2], B0[2][2], B1[2][2];
    const char* cA = (const char*)g.A + (size_t)cur.pm * tstepA; const char* cB = (const char*)g.Bt + (size_t)cur.pn * tstepB;
    S.a_ready(cur);
    if constexpr (SP2) {
        PG8_STAGE(PG8_SB(0, 0), cB, voffB); PG8_STAGE(PG8_SB(0, 1), cB + hstepB, voffB); PG8_STAGE(PG8_SA(0, 0), cA, voffA); PG8_STAGE(PG8_SA(0, 1), cA + hstepA, voffA);
        if (wr == 1) PG8_BAR;
        PG8_WAIT_V(2); PG8_BAR;
        PG8_STAGE(PG8_SB(1, 0), cB + kstep, voffB); PG8_STAGE(PG8_SA(1, 0), cA + kstep, voffA); PG8_STAGE(PG8_SB(1, 1), cB + hstepB + kstep, voffB);
        PG8_WAIT_V(6); PG8_BAR;
    } else {
        PG8_STAGE(PG8_SB(0, 0), cB, voffB); PG8_STAGE(PG8_SA(0, 0), cA, voffA); PG8_STAGE(PG8_SB(0, 1), cB + hstepB, voffB); PG8_STAGE(PG8_SA(0, 1), cA + hstepA, voffA);
        if (wr == 1) PG8_BAR;
        PG8_WAIT_V(4); PG8_BAR;
        PG8_STAGE(PG8_SB(1, 0), cB + kstep, voffB); PG8_STAGE(PG8_SA(1, 0), cA + kstep, voffA); PG8_STAGE(PG8_SB(1, 1), cB + hstepB + kstep, voffB);
        PG8_WAIT_V(6); PG8_BAR;
    }
    for (;;) {
        const bool has_next = S.next(ui + 1, nxt);
        const char* nA = has_next ? (const char*)g.A + (size_t)nxt.pm * tstepA : cA; const char* nB = has_next ? (const char*)g.Bt + (size_t)nxt.pn * tstepB : cB;
        for (int t = 0; t < nt; t += 2) {
            const bool last = (t == nt - 2);
            const char* a1 = cA + (size_t)(t + 1) * kstep;
            const char* a2 = last ? nA : cA + (size_t)(t + 2) * kstep; const char* b2 = last ? nB : cB + (size_t)(t + 2) * kstep;
            const char* a3 = a2 + kstep; const char* b3 = b2 + kstep;
            if (last && has_next) S.a_ready(nxt);
            if constexpr (SP2) {
            PG8_LDB(B0, 0, 0); PG8_LDB(B1, 0, 1); PG8_SCHED; PG8_LDA(At, 0, 0); PG8_STAGE(PG8_SA(1, 1), a1 + hstepA, voffA);
            PG8_WAIT_V(8); PG8_WAIT_L(0); PG8_BAR; PG8_MMA(0, 0, At, B0); PG8_MMA(0, 1, At, B1); PG8_BAR; PG8_SCHED;
            PG8_LDA(At, 0, 1); PG8_STAGE(PG8_SB(0, 0), b2, voffB); PG8_STAGE(PG8_SB(0, 1), b2 + hstepB, voffB); PG8_STAGE(PG8_SA(0, 0), a2, voffA);
            PG8_WAIT_V(8); PG8_WAIT_L(0); PG8_BAR; PG8_MMA(1, 0, At, B0); PG8_MMA(1, 1, At, B1); PG8_BAR; PG8_SCHED;
            PG8_LDB(B0, 1, 0); PG8_LDB(B1, 1, 1); PG8_SCHED; PG8_LDA(At, 1, 0); PG8_STAGE(PG8_SA(0, 1), a2 + hstepA, voffA);
            PG8_WAIT_V(8); PG8_WAIT_L(0); PG8_BAR; PG8_MMA(0, 0, At, B0); PG8_MMA(0, 1, At, B1); PG8_BAR; PG8_SCHED;
            PG8_LDA(At, 1, 1); PG8_STAGE(PG8_SB(1, 0), b3, voffB); PG8_STAGE(PG8_SB(1, 1), b3 + hstepB, voffB); PG8_STAGE(PG8_SA(1, 0), a3, voffA);
            PG8_WAIT_V(8); PG8_WAIT_L(0); PG8_BAR; PG8_MMA(1, 0, At, B0); PG8_MMA(1, 1, At, B1); PG8_BAR; PG8_SCHED;
            } else {
            PG8_LDB(B0, 0, 0); PG8_SCHED; PG8_LDA(At, 0, 0); PG8_STAGE(PG8_SA(1, 1), a1 + hstepA, voffA);
            PG8_WAIT_L(8); PG8_BAR; PG8_WAIT_L(0); PG8_MMA(0, 0, At, B0); PG8_BAR; PG8_SCHED;
            PG8_LDB(B1, 0, 1); PG8_STAGE(PG8_SB(0, 0), b2, voffB);
            PG8_BAR; PG8_WAIT_L(0); PG8_MMA(0, 1, At, B1); PG8_BAR;
            PG8_LDA(At, 0, 1); PG8_STAGE(PG8_SA(0, 0), a2, voffA);
            PG8_BAR; PG8_WAIT_L(0); PG8_MMA(1, 0, At, B0); PG8_BAR; PG8_SCHED;
            PG8_STAGE(PG8_SB(0, 1), b2 + hstepB, voffB);
            PG8_WAIT_V(6); PG8_BAR; PG8_MMA(1, 1, At, B1); PG8_BAR;
            PG8_LDB(B0, 1, 0); PG8_SCHED; PG8_LDA(At, 1, 0); PG8_STAGE(PG8_SA(0, 1), a2 + hstepA, voffA);
            PG8_WAIT_L(8); PG8_BAR; PG8_WAIT_L(0); PG8_MMA(0, 0, At, B0); PG8_BAR; PG8_SCHED;
            PG8_LDB(B1, 1, 1); PG8_STAGE(PG8_SB(1, 0), b3, voffB);
            PG8_BAR; PG8_WAIT_L(0); PG8_MMA(0, 1, At, B1); PG8_BAR;
            PG8_LDA(At, 1, 1); PG8_STAGE(PG8_SA(1, 0), a3, voffA);
            PG8_BAR; PG8_WAIT_L(0); PG8_MMA(1, 0, At, B0); PG8_BAR; PG8_SCHED;
            PG8_STAGE(PG8_SB(1, 1), b3 + hstepB, voffB);
            PG8_WAIT_V(6); PG8_BAR; PG8_MMA(1, 1, At, B1); PG8_BAR;
            }
        }
        if constexpr (ALIGN_EPI) { if (wr == 0) PG8_BAR; }
        if constexpr (!Epi::AFTER_DRAIN) { E(acc, cur, wr, wc, fr, fq); S.done(cur); }
        if (!has_next) break;
#pragma unroll
        for (int a = 0; a < 2; ++a)
#pragma unroll
            for (int b = 0; b < 2; ++b)
#pragma unroll
                for (int m = 0; m < 4; ++m)
#pragma unroll
                    for (int n = 0; n < 2; ++n) acc[a][b][m][n] = (f32x4){0.f, 0.f, 0.f, 0.f};
        cur = nxt; cA = nA; cB = nB; ++ui;
        if constexpr (ALIGN_EPI) { if (wr == 1) PG8_BAR; }
    }
    PG8_WAIT_V(0);
    if constexpr (!ALIGN_EPI) { if (wr == 0) PG8_BAR; }
    PG8_BAR;
    if constexpr (Epi::AFTER_DRAIN) { E.fused(acc, cur, wr, wc, fr, fq, lds, wid, lane); S.done(cur); }
#undef PG8_SA
#undef PG8_SB
#undef PG8_STAGE
#undef PG8_LDA
#undef PG8_LDB
#undef PG8_MMA
#undef PG8_WAIT_V
#undef PG8_WAIT_L
#undef PG8_BAR
#undef PG8_SCHED
}
}


#define LAS __attribute__((address_space(3)))
typedef unsigned short bf16_t;
typedef short bf16x8 __attribute__((ext_vector_type(8)));
typedef short s16x4 __attribute__((ext_vector_type(4)));
typedef float f32x4 __attribute__((ext_vector_type(4)));
typedef float f32x16 __attribute__((ext_vector_type(16)));
typedef unsigned u32x4 __attribute__((ext_vector_type(4)));
typedef unsigned u32x2 __attribute__((ext_vector_type(2)));
typedef float f32x2_t __attribute__((ext_vector_type(2)));
typedef __bf16 bf16x2_t __attribute__((ext_vector_type(2)));
typedef short v4i16_t __attribute__((ext_vector_type(4)));

constexpr int NB = 8, T = 4096, M = NB * T, D = 1024, FF = 4096, DEPTH = 2;
constexpr int P_IN = 1842, ZP = 2048;
constexpr int Z_CQ = 0, Z_CKV = 256, Z_KR = 384, Z_GATE = 416, Z_NQ = 512, Z_NKV = 896, Z_PU = 1664;
constexpr int QMP = 768, KVP = 768;
constexpr float EPS = 1e-6f;
constexpr float LOG2E = 1.4426950408889634f;
constexpr float NSA_QS = 0.125f * LOG2E;
constexpr float MLA_QS = 0.10206207261596575f * LOG2E;

constexpr size_t MiB = 1u << 20;
constexpr size_t WS_CTL = 0;
constexpr size_t WS_SS = 1 * MiB;
constexpr size_t WS_ROPE = 3 * MiB;
constexpr size_t WS_BIASP = 7 * MiB;
constexpr size_t WS_KCMP = 7 * MiB + 512 * 1024;
constexpr size_t WS_WIN = 10 * MiB, WS_WOUT = 18 * MiB, WS_WFF1 = 22 * MiB, WS_WFF2 = 38 * MiB, WS_WQUP = 54 * MiB, WS_WKVUP = 55 * MiB;
constexpr size_t WS_W1T = 56 * MiB, WS_W2T = 57 * MiB, WS_WPT = 57 * MiB + 512 * 1024;
constexpr size_t WS_XB = 64 * MiB, WS_MIX = 128 * MiB, WS_H = 192 * MiB, WS_Z = 192 * MiB, WS_QM = 320 * MiB, WS_KVM = 368 * MiB, WS_XPART = 448 * MiB, WS_CPART = 458 * MiB, WS_END = 460 * MiB;

constexpr int LDS_BYTES = 147456;

struct Params { const float* in[18]; float* out; unsigned char* ws; };

__device__ __forceinline__ unsigned f2bf(float f) { unsigned u = __builtin_bit_cast(unsigned, f); return (u + 0x7fffu + ((u >> 16) & 1u)) >> 16; }
__device__ __forceinline__ unsigned pk2(float lo, float hi) { f32x2_t v = {lo, hi}; bf16x2_t b = __builtin_convertvector(v, bf16x2_t); return __builtin_bit_cast(unsigned, b); }
__device__ __forceinline__ float bf2f(unsigned short b) { return __builtin_bit_cast(float, (unsigned)b << 16); }
__device__ __forceinline__ float wave_sum(float v) {
#pragma unroll
    for (int o = 1; o < 64; o <<= 1) v += __shfl_xor(v, o);
    return v;
}
__device__ __forceinline__ int crow(int r, int h) { return (r & 3) + 8 * (r >> 2) + 4 * h; }
__device__ __forceinline__ void atomic_addf(float* p, float v) { __hip_atomic_fetch_add(p, v, __ATOMIC_RELAXED, __HIP_MEMORY_SCOPE_AGENT); }
__device__ __forceinline__ float fast_exp2(float x) { return __builtin_amdgcn_exp2f(x); }

__device__ __forceinline__ int tid_() { int t = threadIdx.x; asm volatile("" : "+v"(t)); return t; }
__device__ __forceinline__ int bid_() { int t = blockIdx.x; asm volatile("" : "+s"(t)); return t; }
__device__ __forceinline__ int gdim_() { int t = gridDim.x; asm volatile("" : "+s"(t)); return t; }
#ifndef PROBE_T
#define PROBE_T 0
#endif
#ifndef PROBE_BLK
#define PROBE_BLK 0
#endif
#ifndef PROBE_TID
#define PROBE_TID 0
#endif
#ifndef PROBE_MUL
#define PROBE_MUL 3
#endif
#if PROBE_T
#define PT_LDS ((LAS unsigned char*)0)
#define PT_BEGIN(tag) unsigned long long pt_t0_ = 0; if ((tag) == PROBE_T) { __builtin_amdgcn_sched_barrier(0); pt_t0_ = __builtin_amdgcn_s_memtime(); __builtin_amdgcn_sched_barrier(0); }
#define PT_END(tag) do { if ((tag) == PROBE_T) { __builtin_amdgcn_sched_barrier(0); const unsigned long long pt_t1_ = __builtin_amdgcn_s_memtime(); __builtin_amdgcn_sched_barrier(0); if (bid_() == PROBE_BLK && tid_() == PROBE_TID) { LAS unsigned* pa_ = (LAS unsigned*)(PT_LDS + LDS_BYTES - 32); pa_[0] += (unsigned)(pt_t1_ - pt_t0_); } } } while (0)
#else
#define PT_BEGIN(tag) do {} while (0)
#define PT_END(tag) do {} while (0)
#endif
#define EPI_LOOP_ROWS  _Pragma("unroll") for (int ai = 0; ai < 2; ++ai) _Pragma("unroll") for (int m = 0; m < 4; ++m) if (epi_fence())
__device__ __forceinline__ bool epi_fence() { asm volatile("" ::: "memory"); return true; }
__device__ __forceinline__ float row_sum16(const float* part, int row) {
    const f32x4* p = (const f32x4*)(part + (size_t)row * 16); const f32x4 a = p[0], b = p[1], c = p[2], d = p[3];
    return (((a[0] + a[1]) + (a[2] + a[3])) + ((b[0] + b[1]) + (b[2] + b[3]))) + (((c[0] + c[1]) + (c[2] + c[3])) + ((d[0] + d[1]) + (d[2] + d[3])));
}
__device__ __forceinline__ float row_sum4(const float* part, int row) { const f32x4 a = *(const f32x4*)(part + (size_t)row * 4); return (a[0] + a[1]) + (a[2] + a[3]); }
template <int NPART>
__device__ __forceinline__ LAS float* epi_row_scales(const float* part, int pm, int wr, int wc, int fr, int fq, float inv_n, float mul) {
    LAS float* sc = (LAS float*)(size_t)131072 + (wr * 4 + wc) * 128;
    const int lane = fq * 16 + fr;
#pragma unroll
    for (int a = 0; a < 2; ++a) {
        const int row = pm * 256 + a * 128 + wr * 64 + lane;
        const float sm = (NPART == 16) ? row_sum16(part, row) : row_sum4(part, row);
        sc[a * 64 + lane] = rsqrtf(sm * inv_n + EPS) * mul;
    }
    asm volatile("" ::: "memory");
    return sc;
}
__device__ __forceinline__ void st_bf4(bf16_t* p, f32x4 v) { u32x2 w; w.x = pk2(v[0], v[1]); w.y = pk2(v[2], v[3]); *(u32x2*)p = w; }
__device__ __forceinline__ float dot4(f32x4 v) { return (v[0] * v[0] + v[1] * v[1]) + (v[2] * v[2] + v[3] * v[3]); }

struct EpiInProj {
    static constexpr bool PERM = true, AFTER_DRAIN = false;
    bf16_t* z; const float* ss_x; float* ss_cq; float* ss_ckv; const float* ropec; const float* ropes;
    __device__ __forceinline__ void operator()(const f32x4 (&acc)[2][2][4][2], const pg8::Unit& u, int wr, int wc, int fr, int fq) const {
        const int pn = u.pn;
        LAS float* sc = epi_row_scales<16>(ss_x, u.pm, wr, wc, fr, fq, 1.0f / 1024.0f, 1.0f);
        EPI_LOOP_ROWS {
            const int row = u.pm * 256 + ai * 128 + wr * 64 + m * 16 + fr;
            const float rs = sc[ai * 64 + m * 16 + fr];
            float sq = 0.f;
#pragma unroll
            for (int bj = 0; bj < 2; ++bj) {
                f32x4 v0 = acc[ai][bj][m][0] * rs, v1 = acc[ai][bj][m][1] * rs;
                const int cb = pn * 256 + bj * 128 + wc * 32;
                if (pn == 0 || (pn == 1 && bj == 0)) sq += dot4(v0) + dot4(v1);
                if (pn == 1 && bj == 1 && wc == 0) {
                    const float* cp = ropec + (size_t)row * 16 + 8 * (fq & 1); const float* sp = ropes + (size_t)row * 16 + 8 * (fq & 1);
                    const f32x4 c0 = *(const f32x4*)cp, c1 = *(const f32x4*)(cp + 4), s0 = *(const f32x4*)sp, s1 = *(const f32x4*)(sp + 4);
                    const float sg = (fq < 2) ? -1.f : 1.f;
                    f32x4 p0v, p1v;
#pragma unroll
                    for (int j = 0; j < 4; ++j) { p0v[j] = __shfl_xor(v0[j], 32); p1v[j] = __shfl_xor(v1[j], 32); }
                    v0 = v0 * c0 + p0v * s0 * sg; v1 = v1 * c1 + p1v * s1 * sg;
                }
                if (cb >= Z_NQ && cb < Z_NKV) { v0 = v0 * NSA_QS; v1 = v1 * NSA_QS; }
                u32x4 w; w.x = pk2(v0[0], v0[1]); w.y = pk2(v0[2], v0[3]); w.z = pk2(v1[0], v1[1]); w.w = pk2(v1[2], v1[3]);
                *(u32x4*)(z + (size_t)row * ZP + cb + 8 * fq) = w;
            }
            if (pn <= 1) {
                sq += __shfl_xor(sq, 16); sq += __shfl_xor(sq, 32);
                if (fq == 0) (pn == 0 ? ss_cq : ss_ckv)[(size_t)row * 4 + wc] = sq;
            }
        }
    }
};

struct EpiQup {
    static constexpr bool PERM = true, AFTER_DRAIN = false;
    bf16_t* qm; const float* ss_cq; const float* ropec; const float* ropes;
    __device__ __forceinline__ void operator()(const f32x4 (&acc)[2][2][4][2], const pg8::Unit& u, int wr, int wc, int fr, int fq) const {
        LAS float* sc = epi_row_scales<4>(ss_cq, u.pm, wr, wc, fr, fq, 1.0f / 256.0f, MLA_QS);
        EPI_LOOP_ROWS {
            const int row = u.pm * 256 + ai * 128 + wr * 64 + m * 16 + fr;
            const float rs = sc[ai * 64 + m * 16 + fr];
#pragma unroll
            for (int bj = 0; bj < 2; ++bj) {
                f32x4 v0 = acc[ai][bj][m][0] * rs, v1 = acc[ai][bj][m][1] * rs;
                const int gi = u.pn * 8 + bj * 4 + wc;
                if (gi % 3 == 2) {
                    const float* cp = ropec + (size_t)row * 16 + 8 * (fq & 1); const float* sp = ropes + (size_t)row * 16 + 8 * (fq & 1);
                    const f32x4 c0 = *(const f32x4*)cp, c1 = *(const f32x4*)(cp + 4), s0 = *(const f32x4*)sp, s1 = *(const f32x4*)(sp + 4);
                    const float sg = (fq < 2) ? -1.f : 1.f;
                    f32x4 p0v, p1v;
#pragma unroll
                    for (int j = 0; j < 4; ++j) { p0v[j] = __shfl_xor(v0[j], 32); p1v[j] = __shfl_xor(v1[j], 32); }
                    v0 = v0 * c0 + p0v * s0 * sg; v1 = v1 * c1 + p1v * s1 * sg;
                }
                u32x4 w; w.x = pk2(v0[0], v0[1]); w.y = pk2(v0[2], v0[3]); w.z = pk2(v1[0], v1[1]); w.w = pk2(v1[2], v1[3]);
                *(u32x4*)(qm + (size_t)row * QMP + gi * 32 + 8 * fq) = w;
            }
        }
    }
};

struct EpiKVup {
    static constexpr bool PERM = true, AFTER_DRAIN = false;
    bf16_t* kvm; const float* ss_ckv;
    __device__ __forceinline__ void operator()(const f32x4 (&acc)[2][2][4][2], const pg8::Unit& u, int wr, int wc, int fr, int fq) const {
        LAS float* sc = epi_row_scales<4>(ss_ckv, u.pm, wr, wc, fr, fq, 1.0f / 128.0f, 1.0f);
        EPI_LOOP_ROWS {
            const int row = u.pm * 256 + ai * 128 + wr * 64 + m * 16 + fr;
            const float rs = sc[ai * 64 + m * 16 + fr];
#pragma unroll
            for (int bj = 0; bj < 2; ++bj) {
                const f32x4 v0 = acc[ai][bj][m][0] * rs, v1 = acc[ai][bj][m][1] * rs;
                u32x4 w; w.x = pk2(v0[0], v0[1]); w.y = pk2(v0[2], v0[3]); w.z = pk2(v1[0], v1[1]); w.w = pk2(v1[2], v1[3]);
                *(u32x4*)(kvm + (size_t)row * KVP + u.pn * 256 + bj * 128 + wc * 32 + 8 * fq) = w;
            }
        }
    }
};

struct EpiResid {
    static constexpr bool PERM = true, AFTER_DRAIN = false;
    bf16_t* xb; float* ss;
    __device__ __forceinline__ void operator()(const f32x4 (&acc)[2][2][4][2], const pg8::Unit& u, int wr, int wc, int fr, int fq) const {
        EPI_LOOP_ROWS {
            const int row = u.pm * 256 + ai * 128 + wr * 64 + m * 16 + fr;
            float sq = 0.f;
#pragma unroll
            for (int bj = 0; bj < 2; ++bj) {
                bf16_t* p = xb + (size_t)row * D + u.pn * 256 + bj * 128 + wc * 32 + 8 * fq;
                const u32x4 a = *(const u32x4*)p;
                f32x4 v0, v1;
                v0[0] = __builtin_bit_cast(float, a.x << 16); v0[1] = __builtin_bit_cast(float, a.x & 0xffff0000u); v0[2] = __builtin_bit_cast(float, a.y << 16); v0[3] = __builtin_bit_cast(float, a.y & 0xffff0000u);
                v1[0] = __builtin_bit_cast(float, a.z << 16); v1[1] = __builtin_bit_cast(float, a.z & 0xffff0000u); v1[2] = __builtin_bit_cast(float, a.w << 16); v1[3] = __builtin_bit_cast(float, a.w & 0xffff0000u);
                v0 = v0 + acc[ai][bj][m][0]; v1 = v1 + acc[ai][bj][m][1];
                u32x4 w; w.x = pk2(v0[0], v0[1]); w.y = pk2(v0[2], v0[3]); w.z = pk2(v1[0], v1[1]); w.w = pk2(v1[2], v1[3]);
                *(u32x4*)p = w;
                sq += dot4(v0) + dot4(v1);
            }
            sq += __shfl_xor(sq, 16); sq += __shfl_xor(sq, 32);
            if (fq == 0) ss[(size_t)row * 16 + u.pn * 4 + wc] = sq;
        }
    }
};

struct EpiFF1 {
    static constexpr bool PERM = true, AFTER_DRAIN = false;
    bf16_t* h; const float* ss;
    __device__ __forceinline__ void operator()(const f32x4 (&acc)[2][2][4][2], const pg8::Unit& u, int wr, int wc, int fr, int fq) const {
        LAS float* sc = epi_row_scales<16>(ss, u.pm, wr, wc, fr, fq, 1.0f / 1024.0f, 1.0f);
        EPI_LOOP_ROWS {
            const int row = u.pm * 256 + ai * 128 + wr * 64 + m * 16 + fr;
            const float rs = sc[ai * 64 + m * 16 + fr];
#pragma unroll
            for (int bj = 0; bj < 2; ++bj) {
                f32x4 v0 = acc[ai][bj][m][0] * rs, v1 = acc[ai][bj][m][1] * rs;
#pragma unroll
                for (int j = 0; j < 4; ++j) { const float a = fmaxf(v0[j], 0.f), b = fmaxf(v1[j], 0.f); v0[j] = a * a; v1[j] = b * b; }
                u32x4 w; w.x = pk2(v0[0], v0[1]); w.y = pk2(v0[2], v0[3]); w.z = pk2(v1[0], v1[1]); w.w = pk2(v1[2], v1[3]);
                *(u32x4*)(h + (size_t)row * FF + u.pn * 256 + bj * 128 + wc * 32 + 8 * fq) = w;
            }
        }
    }
};

template <class Epi>
__device__ __forceinline__ void run_gemm(LAS unsigned char* lds, const bf16_t* A, int lda, const bf16_t* Bt, int N, int K, const Epi& E, bool mirror = false) {
    asm volatile("" : "+s"(N), "+s"(K), "+s"(lda));
    const int gd = gdim_(), bi = bid_();
    pg8::Gemm g{A, Bt, M, N, K, lda}; pg8::StaticOrder S; S.init(M, N, gd, mirror ? gd - 1 - bi : bi);
    pg8::gemm_phase<Epi, pg8::StaticOrder, true, true>(lds, g, S, E);
}

__device__ __forceinline__ int colmap(int mode, int n) {
    if (mode == 0) return n;
    if (mode == 1) {
        if (n < 256) return 1170 + n;
        if (n < 384) return 1426 + (n - 256);
        if (n < 416) return 1554 + (n - 384);
        if (n < 434) return 1152 + (n - 416);
        if (n < 512) return -1;
        if (n < 896) return n - 512;
        if (n < 1664) return 384 + (n - 896);
        if (n < 1920) return 1586 + (n - 1664);
        return -1;
    }
    if (mode == 2) {
        if (n < 384) return (n >> 6) * 128 + (n & 63);
        return ((n - 384) >> 6) * 128 + 64 + ((n - 384) & 63);
    }
    return n < 576 ? n : -1;
}
__device__ __forceinline__ void convert_tile(const float* src, int srcPitch, int K, bf16_t* dst, const float* rowscale, int mode, int n0, int k0, LAS float* tile, int tid) {
    if (mode == 0) {
#pragma unroll
        for (int i = 0; i < 2; ++i) {
            const int kk = (tid >> 4) + 32 * i, n4 = (tid & 15) * 4;
            f32x4 v = __builtin_nontemporal_load((const f32x4*)(src + (size_t)(k0 + kk) * srcPitch + n0 + n4));
            if (rowscale) v = v * rowscale[k0 + kk];
            tile[kk * 65 + n4] = v[0]; tile[kk * 65 + n4 + 1] = v[1]; tile[kk * 65 + n4 + 2] = v[2]; tile[kk * 65 + n4 + 3] = v[3];
        }
    } else
#pragma unroll
    for (int i = 0; i < 8; ++i) {
        const int kk = (tid >> 6) + 8 * i, nn = tid & 63; const int sc = colmap(mode, n0 + nn);
        float v = 0.f;
        if (sc >= 0) { v = __builtin_nontemporal_load(src + (size_t)(k0 + kk) * srcPitch + sc); if (rowscale) v *= rowscale[k0 + kk]; }
        tile[kk * 65 + nn] = v;
    }
    __syncthreads();
    { const int nn = tid >> 3, kc = (tid & 7) * 8; const LAS float* s = tile + kc * 65 + nn;
      u32x4 o; o.x = pk2(s[0], s[65]); o.y = pk2(s[2 * 65], s[3 * 65]); o.z = pk2(s[4 * 65], s[5 * 65]); o.w = pk2(s[6 * 65], s[7 * 65]);
      *(u32x4*)(dst + (size_t)(n0 + nn) * K + k0 + kc) = o; }
    __syncthreads();
}

__device__ __forceinline__ void prologue(const Params& P, LAS unsigned char* lds) {
    const int tid = tid_(), bid = bid_(), gdim = gdim_(), lane = tid & 63, wave = tid >> 6;
    const int gw = bid * 8 + wave, NGW = gdim * 8;
    unsigned char* ws = P.ws;
    if (bid == 0) { for (int i = tid; i < 2048; i += 512) ((unsigned*)(ws + WS_CTL))[i] = 0u; }
    { const float* x = P.in[0]; bf16_t* xb = (bf16_t*)(ws + WS_XB); float* ss0 = (float*)(ws + WS_XPART);
      for (int r = gw; r < M; r += 2 * NGW) {
          const int r2 = r + NGW;
          const f32x4* xr = (const f32x4*)(x + (size_t)r * D) + lane; const f32x4* xr2 = (const f32x4*)(x + (size_t)(r2 < M ? r2 : r) * D) + lane;
          f32x4 v[4], w[4]; float sa = 0.f, sb = 0.f;
#pragma unroll
          for (int j = 0; j < 4; ++j) { v[j] = __builtin_nontemporal_load(xr + 64 * j); w[j] = __builtin_nontemporal_load(xr2 + 64 * j); }
#pragma unroll
          for (int j = 0; j < 4; ++j) { sa += dot4(v[j]); sb += dot4(w[j]); }
          sa = wave_sum(sa); sb = wave_sum(sb);
          if (lane < 16) ss0[(size_t)r * 16 + lane] = (lane == 0) ? sa : 0.f;
          u32x2* o = (u32x2*)(xb + (size_t)r * D) + lane;
#pragma unroll
          for (int j = 0; j < 4; ++j) { u32x2 t; t.x = pk2(v[j][0], v[j][1]); t.y = pk2(v[j][2], v[j][3]); o[64 * j] = t; }
          if (r2 < M) {
              if (lane < 16) ss0[(size_t)r2 * 16 + lane] = (lane == 0) ? sb : 0.f;
              u32x2* o2 = (u32x2*)(xb + (size_t)r2 * D) + lane;
#pragma unroll
              for (int j = 0; j < 4; ++j) { u32x2 t; t.x = pk2(w[j][0], w[j][1]); t.y = pk2(w[j][2], w[j][3]); o2[64 * j] = t; }
          }
      } }
    { const int* pos = (const int*)P.in[1]; float* rc = (float*)(ws + WS_ROPE); float* rsn = rc + (size_t)M * 16;
      const float INV[16] = {1.0f, 0.5623413324356079f, 0.3162277638912201f, 0.17782793939113617f, 0.10000000149011612f, 0.05623413249850273f, 0.03162277489900589f, 0.017782794311642647f,
                             0.009999999776482582f, 0.005623413249850273f, 0.003162277629598975f, 0.0017782794311642647f, 0.0010000000474974513f, 0.000562341301701963f, 0.0003162277571391314f, 0.00017782794020604342f};
      for (int i = bid * 512 + tid; i < M * 16; i += gdim * 512) {
          const int r = i >> 4, k = i & 15; float inv = INV[0];
#pragma unroll
          for (int q = 1; q < 16; ++q) inv = (k == q) ? INV[q] : inv;
          const float ang = (float)pos[r] * inv;
          double rev = (double)ang * 0.15915494309189535; rev -= floor(rev);
          const float fr = (float)rev;
          rc[i] = __builtin_amdgcn_cosf(fr); rsn[i] = __builtin_amdgcn_sinf(fr);
      } }
    { float* bp = (float*)(ws + WS_BIASP);
      for (int it = gw; it < DEPTH * 2 * 32; it += NGW) {
          const int lk = it >> 5, ch = it & 31; const float* pp = P.in[4] + (size_t)lk * 2048 + ch * 64; const float* w1 = P.in[5] + (size_t)lk * 2048 * 64 + (size_t)ch * 64 * 64;
          float s = 0.f;
          for (int k = 0; k < 64; ++k) s += pp[k] * w1[k * 64 + lane];
          bp[it * 64 + lane] = s;
      } }
    { LAS float* tile = (LAS float*)lds;
      constexpr int C_IN = 32 * 16, C_OUT = 16 * 16, C_F1 = 64 * 16, C_F2 = 16 * 64, C_QU = 12 * 4, C_KV = 12 * 2, C_W1 = 2 * 32, C_W2 = 2, C_WP = 4;
      constexpr int PER_L = C_IN + C_OUT + C_F1 + C_F2 + C_QU + C_KV + C_W1 + C_W2 + C_WP;
      for (int it = bid; it < DEPTH * PER_L; it += gdim) {
          const int l = it / PER_L; int r = it % PER_L;
          if (r < C_IN) { convert_tile(P.in[3] + (size_t)l * D * P_IN, P_IN, D, (bf16_t*)(ws + WS_WIN) + (size_t)l * ZP * D, P.in[2] + l * D, 1, (r >> 4) * 64, (r & 15) * 64, tile, tid); continue; } r -= C_IN;
          if (r < C_OUT) { convert_tile(P.in[13] + (size_t)l * D * D, D, D, (bf16_t*)(ws + WS_WOUT) + (size_t)l * D * D, nullptr, 0, (r >> 4) * 64, (r & 15) * 64, tile, tid); continue; } r -= C_OUT;
          if (r < C_F1) { convert_tile(P.in[15] + (size_t)l * D * FF, FF, D, (bf16_t*)(ws + WS_WFF1) + (size_t)l * FF * D, P.in[14] + l * D, 0, (r >> 4) * 64, (r & 15) * 64, tile, tid); continue; } r -= C_F1;
          if (r < C_F2) { convert_tile(P.in[16] + (size_t)l * FF * D, D, FF, (bf16_t*)(ws + WS_WFF2) + (size_t)l * D * FF, nullptr, 0, (r >> 6) * 64, (r & 63) * 64, tile, tid); continue; } r -= C_F2;
          if (r < C_QU) { convert_tile(P.in[8] + (size_t)l * 256 * 576, 576, 256, (bf16_t*)(ws + WS_WQUP) + (size_t)l * 768 * 256, P.in[7] + l * 256, 3, (r >> 2) * 64, (r & 3) * 64, tile, tid); continue; } r -= C_QU;
          if (r < C_KV) { convert_tile(P.in[10] + (size_t)l * 128 * 768, 768, 128, (bf16_t*)(ws + WS_WKVUP) + (size_t)l * 768 * 128, P.in[9] + l * 128, 2, (r >> 1) * 64, (r & 1) * 64, tile, tid); continue; } r -= C_KV;
          if (r < C_W1) { const int kv = r >> 5, kt = r & 31; convert_tile(P.in[5] + (size_t)(l * 2 + kv) * 2048 * 64, 64, 2048, (bf16_t*)(ws + WS_W1T) + (size_t)(l * 2 + kv) * 64 * 2048, nullptr, 0, 0, kt * 64, tile, tid); continue; } r -= C_W1;
          if (r < C_W2) { convert_tile(P.in[6] + (size_t)(l * 2 + r) * 64 * 64, 64, 64, (bf16_t*)(ws + WS_W2T) + (size_t)(l * 2 + r) * 64 * 64, nullptr, 0, 0, 0, tile, tid); continue; } r -= C_W2;
          convert_tile(P.in[11] + (size_t)(l * 4 + r) * 64 * 64, 64, 64, (bf16_t*)(ws + WS_WPT) + (size_t)(l * 4 + r) * 64 * 64, nullptr, 0, 0, 0, tile, tid);
      } }
}

#define MFMA16(a, b, c) __builtin_amdgcn_mfma_f32_16x16x32_bf16((a), (b), (c), 0, 0, 0)
#define MFMA32(a, b, c) __builtin_amdgcn_mfma_f32_32x32x16_bf16((a), (b), (c), 0, 0, 0)

__device__ __forceinline__ float gelu_tanh(float x) {
    const float u = 0.7978845608028654f * (x + 0.044715f * x * x * x);
    const float e = __expf(2.f * u);
    const float th = 1.f - 2.f / (e + 1.f);
    return 0.5f * x * (1.f + th);
}

__device__ __forceinline__ void compress_phase(const Params& P, int layer, LAS unsigned char* lds) {
    const int tid = tid_(), bid = bid_(), gdim = gdim_(), lane = tid & 63, wave = tid >> 6, sub = wave >> 2, et = wave & 3;
    const int l16 = lane & 15, quad = lane >> 4;
    unsigned char* ws = P.ws;
    const bf16_t* z = (const bf16_t*)(ws + WS_Z);
    bf16_t* kc = (bf16_t*)(ws + WS_KCMP);
    const float* bp = (const float*)(ws + WS_BIASP);
    LAS bf16_t* hb = (LAS bf16_t*)lds + sub * (16 * 72);
    for (int bi = bid; bi < 256; bi += gdim) {
        const int id = bi * 2 + sub, kv = id >> 8, rest = id & 255, b = rest >> 5, g = (rest >> 4) & 1, n0 = (rest & 15) * 16;
        const bf16_t* w1t = (const bf16_t*)(ws + WS_W1T) + ((size_t)(layer * 2 + kv) * 64 + 16 * et + l16) * 2048 + 8 * quad;
        const bf16_t* w2t = (const bf16_t*)(ws + WS_W2T) + ((size_t)(layer * 2 + kv) * 64 + 16 * et + l16) * 64 + 8 * quad;
        const int n = n0 + l16;
        const bf16_t* zc = z + Z_NKV + (kv * 2 + g) * 64 + 8 * quad;
        f32x4 acc = {0.f, 0.f, 0.f, 0.f};
#pragma unroll 4
        for (int l = 0; l < 32; ++l) {
            int tok = 16 * n + l; tok = tok > T - 1 ? T - 1 : tok;
            const bf16_t* ar = zc + (size_t)(b * T + tok) * ZP;
#pragma unroll
            for (int dh = 0; dh < 2; ++dh) {
                const bf16x8 a = *(const bf16x8*)(ar + 32 * dh);
                const bf16x8 bb = *(const bf16x8*)(w1t + l * 64 + 32 * dh);
                acc = MFMA16(a, bb, acc);
            }
        }
        float bsum = 0.f;
        for (int ch = 0; ch < 32; ++ch) bsum += bp[((size_t)(layer * 2 + kv) * 32 + ch) * 64 + 16 * et + l16];
#pragma unroll
        for (int j = 0; j < 4; ++j) hb[(4 * quad + j) * 72 + 16 * et + l16] = (bf16_t)f2bf(gelu_tanh(acc[j] + bsum));
        __syncthreads();
        f32x4 acc2 = {0.f, 0.f, 0.f, 0.f};
#pragma unroll
        for (int ks = 0; ks < 2; ++ks) {
            const bf16x8 a = *(const LAS bf16x8*)(hb + l16 * 72 + 32 * ks + 8 * quad);
            const bf16x8 bb = *(const bf16x8*)(w2t + 32 * ks);
            acc2 = MFMA16(a, bb, acc2);
        }
#pragma unroll
        for (int j = 0; j < 4; ++j) {
            const int nr = n0 + 4 * quad + j;
            kc[((size_t)((kv * NB + b) * 2 + g) * 256 + nr) * 64 + 16 * et + l16] = (bf16_t)(nr < 255 ? f2bf(acc2[j]) : 0u);
        }
        __syncthreads();
    }
}

__device__ __forceinline__ void pool_phase(const Params& P, int layer, int wi0, int wi1) {
    const int tid = tid_(), bid = bid_(), gdim = gdim_(), lane = tid & 63, wave = tid >> 6, l16 = lane & 15, quad = lane >> 4;
    unsigned char* ws = P.ws;
    const bf16_t* z = (const bf16_t*)(ws + WS_Z);
    bf16_t* mix = (bf16_t*)(ws + WS_MIX);
    const float* psc = P.in[12] + layer * 256;
    for (int wi = wi0 + wave; wi < wi1; wi += 8) {
        const int tt = wi >> 2, gi = wi & 3, w = 2 << gi;
        const int row = tt * 16 + l16, t = row & (T - 1);
        const int cnt = (t + 1 < w) ? t + 1 : w; const float icnt = 1.0f / (float)cnt;
        const bf16_t* wpt = (const bf16_t*)(ws + WS_WPT) + ((size_t)(layer * 4 + gi) * 64 + l16) * 64 + 8 * quad;
        f32x4 acc[4];
#pragma unroll
        for (int dt = 0; dt < 4; ++dt) acc[dt] = (f32x4){0.f, 0.f, 0.f, 0.f};
#pragma unroll
        for (int ks = 0; ks < 2; ++ks) {
            const bf16_t* ur = z + (size_t)row * ZP + Z_PU + gi * 64 + 32 * ks + 8 * quad;
            float s[8];
#pragma unroll
            for (int j = 0; j < 8; ++j) s[j] = 0.f;
            for (int i = 0; i < w; ++i) {
                if (i < cnt) {
                    const bf16x8 v = *(const bf16x8*)(ur - (size_t)i * ZP);
#pragma unroll
                    for (int j = 0; j < 8; ++j) s[j] += bf2f((unsigned short)v[j]);
                }
            }
            const bf16x8 u0 = *(const bf16x8*)ur;
            u32x4 pa;
            pa.x = pk2(s[0] * icnt - bf2f((unsigned short)u0[0]), s[1] * icnt - bf2f((unsigned short)u0[1]));
            pa.y = pk2(s[2] * icnt - bf2f((unsigned short)u0[2]), s[3] * icnt - bf2f((unsigned short)u0[3]));
            pa.z = pk2(s[4] * icnt - bf2f((unsigned short)u0[4]), s[5] * icnt - bf2f((unsigned short)u0[5]));
            pa.w = pk2(s[6] * icnt - bf2f((unsigned short)u0[6]), s[7] * icnt - bf2f((unsigned short)u0[7]));
            const bf16x8 a = __builtin_bit_cast(bf16x8, pa);
#pragma unroll
            for (int dt = 0; dt < 4; ++dt) {
                const bf16x8 bb = *(const bf16x8*)(wpt + (size_t)dt * 16 * 64 + 32 * ks);
                acc[dt] = MFMA16(a, bb, acc[dt]);
            }
        }
#pragma unroll
        for (int dt = 0; dt < 4; ++dt) {
            const float sc = psc[gi * 64 + 16 * dt + l16];
#pragma unroll
            for (int j = 0; j < 4; ++j) mix[(size_t)(tt * 16 + 4 * quad + j) * D + 768 + gi * 64 + 16 * dt + l16] = (bf16_t)f2bf(acc[dt][j] * sc);
        }
    }
}

#ifndef SLC_ELEM_MASK
#define SLC_ELEM_MASK 0
#endif
#ifndef USE_NEGM
#define USE_NEGM 1
#endif
#ifndef KPREF
#define KPREF 1
#endif
#ifndef STAGGER
#define STAGGER 0
#endif
constexpr int AG = 4, NSA_G = 2;
constexpr int AL_WSF = 0, AL_BC = 2048, AL_T0 = 2304, AL_VSZ = 9216;
constexpr int AL_IMP = AL_T0 + AG * 2 * 9216, AL_SCORE = AL_IMP + 6 * 8192, AL_SEL = AL_SCORE + 16384;
static_assert(AL_SEL + 512 <= LDS_BYTES - 64 && AL_T0 + AG * (13312 + 9216) <= LDS_BYTES - 64, "attention LDS map");
constexpr int VPB = 144;

__device__ __forceinline__ s16x4 vtr(const LAS unsigned char* p) { return __builtin_bit_cast(s16x4, __builtin_amdgcn_ds_read_tr16_b64_v4i16((LAS v4i16_t*)p)); }

template <int NDC, int KPB>
__device__ __forceinline__ void qk_tile(f32x16& p0, f32x16& p1, const LAS unsigned char* Kt, const bf16x8* qf, const f32x16& cinit, int r, int h) {
    const LAS unsigned char* kb = Kt + r * KPB + h * 16;
    bf16x8 ka[NDC], kc[NDC];
#pragma unroll
    for (int c = 0; c < NDC; ++c) { ka[c] = *(const LAS bf16x8*)(kb + c * 32); kc[c] = *(const LAS bf16x8*)(kb + 32 * KPB + c * 32); }
    if constexpr (NDC == 4) asm volatile("" : "+v"(ka[0]), "+v"(ka[1]), "+v"(ka[2]), "+v"(ka[3]), "+v"(kc[0]), "+v"(kc[1]), "+v"(kc[2]), "+v"(kc[3]));
    else asm volatile("" : "+v"(ka[0]), "+v"(ka[1]), "+v"(ka[2]), "+v"(ka[3]), "+v"(ka[4]), "+v"(ka[5]), "+v"(kc[0]), "+v"(kc[1]), "+v"(kc[2]), "+v"(kc[3]), "+v"(kc[4]), "+v"(kc[5]));
    p0 = MFMA32(ka[0], qf[0], cinit); p1 = MFMA32(kc[0], qf[0], cinit);
#pragma unroll
    for (int c = 1; c < NDC; ++c) { p0 = MFMA32(ka[c], qf[c], p0); p1 = MFMA32(kc[c], qf[c], p1); }
}

template <int NDC, int KPB>
__device__ __forceinline__ void k_load(bf16x8 (&kf)[2 * NDC], const LAS unsigned char* Kt, int r, int h) {
    const LAS unsigned char* kb = Kt + r * KPB + h * 16;
#pragma unroll
    for (int c = 0; c < NDC; ++c) { kf[2 * c] = *(const LAS bf16x8*)(kb + c * 32); kf[2 * c + 1] = *(const LAS bf16x8*)(kb + 32 * KPB + c * 32); }
}
template <int NDC>
__device__ __forceinline__ void qk_mma(f32x16& p0, f32x16& p1, bf16x8 (&kf)[2 * NDC], const bf16x8* qf, const f32x16& cinit) {
    if constexpr (NDC == 4) asm volatile("" : "+v"(kf[0]), "+v"(kf[1]), "+v"(kf[2]), "+v"(kf[3]), "+v"(kf[4]), "+v"(kf[5]), "+v"(kf[6]), "+v"(kf[7]));
    else asm volatile("" : "+v"(kf[0]), "+v"(kf[1]), "+v"(kf[2]), "+v"(kf[3]), "+v"(kf[4]), "+v"(kf[5]), "+v"(kf[6]), "+v"(kf[7]), "+v"(kf[8]), "+v"(kf[9]), "+v"(kf[10]), "+v"(kf[11]));
    __builtin_amdgcn_s_setprio(1);
    p0 = MFMA32(kf[0], qf[0], cinit); p1 = MFMA32(kf[1], qf[0], cinit);
#pragma unroll
    for (int c = 1; c < NDC; ++c) { p0 = MFMA32(kf[2 * c], qf[c], p0); p1 = MFMA32(kf[2 * c + 1], qf[c], p1); }
    __builtin_amdgcn_s_setprio(0);
}
__device__ __forceinline__ bf16x8 pack8(const f32x16& p, int s, unsigned pmask) {
    u32x4 w; w.x = pk2(p[8 * s], p[8 * s + 1]) & pmask; w.y = pk2(p[8 * s + 2], p[8 * s + 3]) & pmask; w.z = pk2(p[8 * s + 4], p[8 * s + 5]) & pmask; w.w = pk2(p[8 * s + 6], p[8 * s + 7]) & pmask;
    return __builtin_bit_cast(bf16x8, w);
}

__device__ __forceinline__ void pv_load(s16x4 (&vf)[16], const LAS unsigned char* Vt, int lane) {
    const int i16 = lane & 15, q4 = i16 >> 2, p4 = i16 & 3, blk = (lane >> 4) & 1, h = lane >> 5;
    const LAS unsigned char* vb = Vt + (4 * h + q4) * VPB + blk * 32 + p4 * 8;
#pragma unroll
    for (int ks = 0; ks < 4; ++ks) {
        vf[4 * ks + 0] = vtr(vb + (16 * ks) * VPB); vf[4 * ks + 1] = vtr(vb + (16 * ks + 8) * VPB);
        vf[4 * ks + 2] = vtr(vb + (16 * ks) * VPB + 64); vf[4 * ks + 3] = vtr(vb + (16 * ks + 8) * VPB + 64);
    }
}
__device__ __forceinline__ void pv_pin(s16x4 (&vf)[16], f32x16& p0, f32x16& p1) {
    asm volatile("s_nop 15\n\ts_nop 7" : "+v"(p0), "+v"(p1));
    asm volatile("" : "+v"(vf[0]), "+v"(vf[1]), "+v"(vf[2]), "+v"(vf[3]), "+v"(vf[4]), "+v"(vf[5]), "+v"(vf[6]), "+v"(vf[7]),
                      "+v"(vf[8]), "+v"(vf[9]), "+v"(vf[10]), "+v"(vf[11]), "+v"(vf[12]), "+v"(vf[13]), "+v"(vf[14]), "+v"(vf[15]));
}
template <bool MASKED>
__device__ __forceinline__ void pv_mma(f32x16& o0, f32x16& o1, const f32x16& p0, const f32x16& p1, const s16x4 (&vf)[16], unsigned pmask) {
#pragma unroll
    for (int ks = 0; ks < 4; ++ks) {
        const bf16x8 pa = (ks < 2) ? pack8(p0, ks & 1, MASKED ? pmask : 0xffffffffu) : pack8(p1, ks & 1, MASKED ? pmask : 0xffffffffu);
        const bf16x8 v0 = __builtin_shufflevector(vf[4 * ks + 0], vf[4 * ks + 1], 0, 1, 2, 3, 4, 5, 6, 7);
        const bf16x8 v1 = __builtin_shufflevector(vf[4 * ks + 2], vf[4 * ks + 3], 0, 1, 2, 3, 4, 5, 6, 7);
        __builtin_amdgcn_s_setprio(1);
        o0 = MFMA32(pa, v0, o0);
        o1 = MFMA32(pa, v1, o1);
        __builtin_amdgcn_s_setprio(0);
    }
}

__device__ __forceinline__ float max3f(float a, float b, float c) { float r; asm("v_max3_f32 %0, %1, %2, %3" : "=v"(r) : "v"(a), "v"(b), "v"(c)); return r; }
__device__ __forceinline__ float tile_rowmax(const f32x16& p0, const f32x16& p1) {
    float a = max3f(p0[0], p0[1], p1[0]), b = max3f(p0[2], p0[3], p1[1]); a = max3f(a, p1[2], p1[3]);
#pragma unroll
    for (int i = 4; i < 16; i += 4) { a = max3f(a, p0[i], p0[i + 1]); b = max3f(b, p0[i + 2], p0[i + 3]); a = max3f(a, p1[i], p1[i + 1]); b = max3f(b, p1[i + 2], p1[i + 3]); }
    float m; asm("v_max_f32_e32 %0, %1, %2" : "=v"(m) : "v"(a), "v"(b));
    const auto rr = __builtin_amdgcn_permlane32_swap(__float_as_uint(m), __float_as_uint(m), false, false);
    float res; asm("v_max_f32_e32 %0, %1, %2" : "=v"(res) : "v"(__uint_as_float(rr[0])), "v"(__uint_as_float(rr[1])));
    return res;
}

template <bool IMPR>
__device__ __forceinline__ void softmax_step(f32x16& p0, f32x16& p1, bool lane_on, float& mref, f32x16& negm, float& l, f32x16& o0, f32x16& o1, LAS float* wsf, int r, int h, LAS float* impw) {
    float rm = tile_rowmax(p0, p1);
    rm = lane_on ? rm : -INFINITY;
    if (__any(rm > 12.0f)) {
        const float dl = fmaxf(rm, 0.f);
        mref += dl;
        const float alpha = fast_exp2(-dl);
        l *= alpha;
        if (h == 0) wsf[r] = alpha;
        asm volatile("" ::: "memory");
#pragma unroll
        for (int i = 0; i < 16; ++i) { const float a = wsf[crow(i, h)]; o0[i] *= a; o1[i] *= a; p0[i] -= dl; p1[i] -= dl; negm[i] = -mref; }
        if (IMPR) {
            asm volatile("" ::: "memory");
#pragma unroll 8
            for (int j = 0; j < 32; ++j) impw[r * 64 + 2 * j + h] *= alpha;
            asm volatile("" ::: "memory");
        }
    }
    float s0 = 0.f, s1 = 0.f, s2 = 0.f, s3 = 0.f;
#pragma unroll
    for (int i = 0; i < 16; i += 2) { p0[i] = fast_exp2(p0[i]); p1[i] = fast_exp2(p1[i]); p0[i + 1] = fast_exp2(p0[i + 1]); p1[i + 1] = fast_exp2(p1[i + 1]); s0 += p0[i]; s1 += p1[i]; s2 += p0[i + 1]; s3 += p1[i + 1]; }
    l += lane_on ? ((s0 + s1) + (s2 + s3)) : 0.f;
}

enum { MODE_MLA = 0, MODE_WIN = 1, MODE_SLC = 2, MODE_CMP1 = 3, MODE_CMP2 = 4 };

template <int MODE>
__device__ __forceinline__ void attn_tile(bf16x8 (&kpre)[(MODE == MODE_MLA) ? 12 : 8], bool have_pre, const LAS unsigned char* Knext, const LAS unsigned char* Kt, const LAS unsigned char* Vt, int t, int ti, const bf16x8* qf, int qpos, int cblk, unsigned long long sel,
                                          float& mref, f32x16& negm, float& l, f32x16& o0, f32x16& o1, float pscale, float pgate, LAS float* impw, LAS float* wsf, int lane) {
    constexpr int KPB = (MODE == MODE_MLA) ? 208 : 144;
    constexpr int NDC = (MODE == MODE_MLA) ? 6 : 4;
    const int r = lane & 31, h = lane >> 5;
    bool on = true;
    if (MODE == MODE_SLC) { on = (sel >> t) & 1ull; if (!__any((int)on)) return; }
    f32x16 p0, p1;
    PT_BEGIN(11);
    if (!have_pre) k_load<NDC, KPB>(kpre, Kt, r, h);
    if (MODE == MODE_CMP1) { f32x16 zz; for (int i = 0; i < 16; ++i) zz[i] = 0.f; qk_mma<NDC>(p0, p1, kpre, qf, zz); }
    else qk_mma<NDC>(p0, p1, kpre, qf, negm);
    if (Knext) k_load<NDC, KPB>(kpre, Knext, r, h);
    s16x4 vf[16];
    if (MODE != MODE_CMP1) pv_load(vf, Vt, lane);
    pv_pin(vf, p0, p1);
    const int kb = 64 * t + 4 * h;
    if (MODE == MODE_MLA) {
        if (64 * t + 63 > (qpos - r)) {
#pragma unroll
            for (int i = 0; i < 16; ++i) { const int kv = kb + (i & 3) + 8 * (i >> 2); if (kv > qpos) p0[i] = -INFINITY; if (kv + 32 > qpos) p1[i] = -INFINITY; }
        }
    } else if (MODE == MODE_WIN) {
        if (t == cblk || t == cblk - 8) {
#pragma unroll
            for (int i = 0; i < 16; ++i) { const int kv = kb + (i & 3) + 8 * (i >> 2);
                if (kv > qpos || kv <= qpos - 512) p0[i] = -INFINITY; if (kv + 32 > qpos || kv + 32 <= qpos - 512) p1[i] = -INFINITY; }
        }
    } else if (MODE == MODE_SLC) {
#if SLC_ELEM_MASK
        if (t == cblk || !__all((int)on)) {
#pragma unroll
            for (int i = 0; i < 16; ++i) { const int kv = kb + (i & 3) + 8 * (i >> 2); if (!on || kv > qpos) p0[i] = -INFINITY; if (!on || kv + 32 > qpos) p1[i] = -INFINITY; }
        }
        on = true;
#else
        if (t == cblk) {
#pragma unroll
            for (int i = 0; i < 16; ++i) { const int kv = kb + (i & 3) + 8 * (i >> 2); if (kv > qpos) p0[i] = -INFINITY; if (kv + 32 > qpos) p1[i] = -INFINITY; }
        }
#endif
    } else {
#pragma unroll
        for (int i = 0; i < 16; ++i) { const int kv = kb + (i & 3) + 8 * (i >> 2);
            if (16 * kv + 31 > qpos) p0[i] = -INFINITY; if (16 * (kv + 32) + 31 > qpos) p1[i] = -INFINITY; }
    }
    PT_END(11);
    if (MODE == MODE_CMP1) {
        const float rm = tile_rowmax(p0, p1);
        const float mnew = fmaxf(mref, rm);
        const float ms = (mnew == -INFINITY) ? 0.f : mnew;
        const float alpha = (mnew == -INFINITY) ? 1.f : fast_exp2(mref - mnew);
        float sm = 0.f;
#pragma unroll
        for (int i = 0; i < 16; ++i) sm += fast_exp2(p0[i] - ms) + fast_exp2(p1[i] - ms);
        l = l * alpha + sm; mref = mnew;
    } else if (MODE == MODE_CMP2) {
        softmax_step<true>(p0, p1, true, mref, negm, l, o0, o1, wsf, r, h, impw);
        LAS float* iw = impw + r * 64 + 16 * ti + h;
#pragma unroll
        for (int k = 0; k < 4; ++k) { iw[2 * k] += (p0[4 * k] + p0[4 * k + 1]) + (p0[4 * k + 2] + 0.5f * p0[4 * k + 3]); iw[8 + 2 * k] += (p1[4 * k] + p1[4 * k + 1]) + (p1[4 * k + 2] + 0.5f * p1[4 * k + 3]); }
        asm volatile("" ::: "memory");
#pragma unroll
        for (int k = 0; k < 4; ++k) { iw[2 * k + 1] += 0.5f * p0[4 * k + 3]; if (16 * ti + h + 8 + 2 * k + 1 < 64) iw[8 + 2 * k + 1] += 0.5f * p1[4 * k + 3]; }
        asm volatile("" ::: "memory");
        pv_mma<false>(o0, o1, p0, p1, vf, 0xffffffffu);
    } else {
        { PT_BEGIN(12);
        softmax_step<false>(p0, p1, on, mref, negm, l, o0, o1, wsf, r, h, impw);
        PT_END(12); }
        { PT_BEGIN(13);
        pv_mma<MODE == MODE_SLC>(o0, o1, p0, p1, vf, on ? 0xffffffffu : 0u);
        PT_END(13); }
    }
}

template <int MODE, int G>
__device__ __forceinline__ void attn_branch(LAS unsigned char* L, const bf16_t* kS, int kP, const bf16_t* vS, int vP, const bf16_t* rS, int rP,
                                            int t0, int t1, bool preloaded, const bf16x8* qf, int qpos, bool active, int wlo, int whi, int cblk, unsigned long long sel,
                                            float& mref, f32x16& negm, float& l, f32x16& o0, f32x16& o1, float pscale, float pgate, LAS float* impw, LAS float* wsf, int tid) {
    constexpr int KPB = (MODE == MODE_MLA) ? 208 : 144;
    constexpr int KSZ = 64 * KPB;
    constexpr bool DB = (2 * G <= AG);
    const int lane = tid & 63;
    const int srow = tid >> 3, sch = tid & 7;
    const int nsteps = (t1 - t0 + G - 1) / G;
    u32x4 kreg[G], vreg[G], rreg[G];
    bf16x8 kpre[(MODE == MODE_MLA) ? 12 : 8];
#define AB_LOAD(s_) do { _Pragma("unroll") for (int j_ = 0; j_ < G; ++j_) { const int t_ = t0 + (s_) * G + j_; if (t_ < t1) { \
        const size_t row_ = (size_t)t_ * 64 + srow; kreg[j_] = *(const u32x4*)(kS + row_ * kP + sch * 8); vreg[j_] = *(const u32x4*)(vS + row_ * vP + sch * 8); \
        if (MODE == MODE_MLA) { if (tid < 256) rreg[j_] = *(const u32x4*)(rS + ((size_t)t_ * 64 + (tid >> 2)) * rP + (tid & 3) * 8); } } } } while (0)
#define AB_STORE(s_) do { _Pragma("unroll") for (int j_ = 0; j_ < G; ++j_) { const int t_ = t0 + (s_) * G + j_; if (t_ < t1) { const int jj_ = (DB ? ((s_) & 1) * G : 0) + j_; \
        *(LAS u32x4*)(L + AL_T0 + jj_ * KSZ + srow * KPB + sch * 16) = kreg[j_]; *(LAS u32x4*)(L + AL_T0 + AG * KSZ + jj_ * AL_VSZ + srow * VPB + sch * 16) = vreg[j_]; \
        if (MODE == MODE_MLA) { if (tid < 256) *(LAS u32x4*)(L + AL_T0 + jj_ * KSZ + (tid >> 2) * KPB + 128 + (tid & 3) * 16) = rreg[j_]; } } } } while (0)
    if (!preloaded && nsteps > 0) { AB_LOAD(0); AB_STORE(0); }
    __syncthreads();
    for (int s = 0; s < nsteps; ++s) {
        if (s + 1 < nsteps) AB_LOAD(s + 1);
        PT_BEGIN(7);
        if (STAGGER && (tid >> 8)) __builtin_amdgcn_s_sleep(STAGGER);
        bool have_pre = false;
        const int jb = DB ? (s & 1) * G : 0;
#pragma unroll
        for (int j = 0; j < G; ++j) {
            const int t = t0 + s * G + j;
            const bool run = active && t < t1 && t >= wlo && t <= whi && (MODE != MODE_SLC || __any((int)((sel >> t) & 1ull)));
            const int tn = t + 1;
            const bool runn = KPREF && (j + 1 < G) && active && tn < t1 && tn >= wlo && tn <= whi && (MODE != MODE_SLC || __any((int)((sel >> tn) & 1ull)));
            if (run)
                attn_tile<MODE>(kpre, have_pre, runn ? (const LAS unsigned char*)(L + AL_T0 + (jb + j + 1) * KSZ) : (const LAS unsigned char*)nullptr, L + AL_T0 + (jb + j) * KSZ, L + AL_T0 + AG * KSZ + (jb + j) * AL_VSZ, t, t - t0, qf, qpos, cblk, sel, mref, negm, l, o0, o1, pscale, pgate, impw, wsf, lane);
            have_pre = run && runn;
        }
        PT_END(7);
        if (DB) {
            if (s + 1 < nsteps) AB_STORE(s + 1);
            __syncthreads();
        } else {
            __syncthreads();
            if (s + 1 < nsteps) { AB_STORE(s + 1); __syncthreads(); }
        }
    }
#undef AB_LOAD
#undef AB_STORE
}

__device__ __forceinline__ void branch_finish(f32x16& out0, f32x16& out1, const f32x16& o0, const f32x16& o1, float l, float gate, LAS float* wsf, int r, int h) {
    const float lt = l + __shfl_xor(l, 32);
    const float f = lt > 0.f ? gate / lt : 0.f;
    if (h == 0) wsf[r] = f;
    asm volatile("" ::: "memory");
#pragma unroll
    for (int i = 0; i < 16; ++i) { const float a = wsf[crow(i, h)]; out0[i] += o0[i] * a; out1[i] += o1[i] * a; }
    asm volatile("" ::: "memory");
}

__device__ __forceinline__ void branch_finish_lds(LAS float* obuf, bool active, const f32x16& o0, const f32x16& o1, float l, float gate, LAS float* wsf, int r, int h) {
    const float lt = l + __shfl_xor(l, 32);
    const float f = lt > 0.f ? gate / lt : 0.f;
    if (h == 0) wsf[r] = f;
    asm volatile("" ::: "memory");
    if (active) {
#pragma unroll
        for (int i = 0; i < 16; ++i) { const int qq = crow(i, h); const float a = wsf[qq]; obuf[qq * 64] += o0[i] * a; obuf[qq * 64 + 32] += o1[i] * a; }
    }
    asm volatile("" ::: "memory");
}
__device__ __forceinline__ float sigmoidf_(float x) { return 1.f / (1.f + __expf(-x)); }

__device__ __forceinline__ void nsa_unit(const Params& P, LAS unsigned char* L, int b, int g, int c) {
    const int tid = tid_(), lane = tid & 63, wave = __builtin_amdgcn_readfirstlane(tid >> 6), r = lane & 31, h = lane >> 5;
    unsigned char* ws = P.ws;
    const bf16_t* z = (const bf16_t*)(ws + WS_Z);
    const bf16_t* kcmp = (const bf16_t*)(ws + WS_KCMP);
    bf16_t* mix = (bf16_t*)(ws + WS_MIX);
    const bool active = wave < 6;
    const int hh = active ? (wave >> 1) : 0, qh = wave & 1, head = 3 * g + hh;
    const int q0 = 64 * c, qpos = q0 + 32 * qh + r;
    const size_t qrow = (size_t)b * T + qpos;
    LAS float* wsf = (LAS float*)(L + AL_WSF) + wave * 64;
    LAS float* impw = (LAS float*)(L + AL_IMP) + (active ? wave : 0) * 2048;
    bf16x8 qf[4];
#pragma unroll
    for (int cc = 0; cc < 4; ++cc) qf[cc] = *(const bf16x8*)(z + qrow * ZP + Z_NQ + head * 64 + 16 * cc + 8 * h);
    const bf16_t* gp = z + qrow * ZP + Z_GATE + head * 3;
    const float g_cmp = sigmoidf_(bf2f(gp[0])), g_slc = sigmoidf_(bf2f(gp[1])), g_win = sigmoidf_(bf2f(gp[2]));
    f32x16 out0, out1, o0, o1, negm;
#pragma unroll
    for (int i = 0; i < 16; ++i) { out0[i] = 0.f; out1[i] = 0.f; o0[i] = 0.f; o1[i] = 0.f; negm[i] = 0.f; }
    const int ntc = (4 * c + 3 + 63) >> 6;
    const bf16_t* kc = kcmp + (size_t)((0 * NB + b) * 2 + g) * 256 * 64;
    const bf16_t* vc = kcmp + (size_t)((1 * NB + b) * 2 + g) * 256 * 64;
    float m1 = 0.f, l1 = 0.f;
    PT_BEGIN(3);
    if (active) { for (int i = lane; i < 2048; i += 64) impw[i] = 0.f; }
    attn_branch<MODE_CMP2, AG>(L, kc, 64, vc, 64, nullptr, 0, 0, ntc, false, qf, qpos, active, 0, ntc, c, 0ull, m1, negm, l1, o0, o1, 0.f, 0.f, impw, wsf, tid);
    { const float lt = l1 + __shfl_xor(l1, 32); const float inv = lt > 0.f ? 1.f / lt : 0.f;
      if (h == 0) wsf[32 + r] = inv;
      branch_finish(out0, out1, o0, o1, l1, g_cmp, wsf, r, h); }
    __syncthreads();
    PT_END(3);
    {
        PT_BEGIN(4);
        LAS float* imp = (LAS float*)(L + AL_IMP); LAS float* sc = (LAS float*)(L + AL_SCORE); LAS unsigned long long* selL = (LAS unsigned long long*)(L + AL_SEL);
        const int q = tid >> 3, part = tid & 7;
        float my[8];
#pragma unroll
        for (int j = 0; j < 8; ++j) { const int s = part * 8 + j; const int o = (q >> 5) * 2048 + (q & 31) * 64 + s;
            const LAS float* wl = (const LAS float*)(L + AL_WSF) + (q >> 5) * 64 + 32 + (q & 31);
            const float v = (imp[o] * wl[0] + imp[o + 2 * 2048] * wl[2 * 64]) + imp[o + 4 * 2048] * wl[4 * 64];
            my[j] = (s > c) ? -1.f : ((s == 0 || s == c || s == c - 1) ? 1.0e4f : v);
            sc[q * 64 + s] = my[j]; }
        __syncthreads();
        int rank[8];
#pragma unroll
        for (int j = 0; j < 8; ++j) rank[j] = 0;
        if (c >= 16) {
            for (int s2 = 0; s2 <= c; ++s2) { const float v = sc[q * 64 + s2];
#pragma unroll
                for (int j = 0; j < 8; ++j) rank[j] += (v > my[j] || (v == my[j] && s2 < part * 8 + j)) ? 1 : 0; }
        }
        unsigned bits = 0;
#pragma unroll
        for (int j = 0; j < 8; ++j) if (part * 8 + j <= c && rank[j] < 16) bits |= 1u << j;
        unsigned lo = (part < 4) ? (bits << (8 * part)) : 0u, hi = (part >= 4) ? (bits << (8 * (part - 4))) : 0u;
        lo |= __shfl_xor(lo, 1); hi |= __shfl_xor(hi, 1); lo |= __shfl_xor(lo, 2); hi |= __shfl_xor(hi, 2); lo |= __shfl_xor(lo, 4); hi |= __shfl_xor(hi, 4);
        if (part == 0) selL[q] = ((unsigned long long)hi << 32) | lo;
        __syncthreads();
        PT_END(4);
    }
    const unsigned long long sel = ((LAS unsigned long long*)(L + AL_SEL))[32 * qh + r];
    LAS float* obuf = impw + r;
    if (active) {
#pragma unroll
        for (int i = 0; i < 16; ++i) { obuf[crow(i, h) * 64] = out0[i]; obuf[crow(i, h) * 64 + 32] = out1[i]; }
    }
    {
        const bf16_t* ks = z + (size_t)b * T * ZP + Z_NKV + ((1 * 2 + 0) * 2 + g) * 64;
        const bf16_t* vs = z + (size_t)b * T * ZP + Z_NKV + ((1 * 2 + 1) * 2 + g) * 64;
        float m = 0.f, l = 0.f;
#pragma unroll
        for (int i = 0; i < 16; ++i) { o0[i] = 0.f; o1[i] = 0.f; }
        PT_BEGIN(5);
        attn_branch<MODE_SLC, NSA_G>(L, ks, ZP, vs, ZP, nullptr, 0, 0, c + 1, false, qf, qpos, active, 0, c, c, sel, m, negm, l, o0, o1, 0.f, 0.f, impw, wsf, tid);
        branch_finish_lds(obuf, active, o0, o1, l, g_slc, wsf, r, h);
        PT_END(5);
    }
    {
        const bf16_t* kw = z + (size_t)b * T * ZP + Z_NKV + ((2 * 2 + 0) * 2 + g) * 64;
        const bf16_t* vw = z + (size_t)b * T * ZP + Z_NKV + ((2 * 2 + 1) * 2 + g) * 64;
        float m = 0.f, l = 0.f;
#pragma unroll
        for (int i = 0; i < 16; ++i) { o0[i] = 0.f; o1[i] = 0.f; negm[i] = 0.f; }
        const int tb = c >= 8 ? c - 8 : 0;
        PT_BEGIN(6);
        attn_branch<MODE_WIN, NSA_G>(L, kw, ZP, vw, ZP, nullptr, 0, tb, c + 1, false, qf, qpos, active, tb, c, c, 0ull, m, negm, l, o0, o1, 0.f, 0.f, impw, wsf, tid);
        branch_finish_lds(obuf, active, o0, o1, l, g_win, wsf, r, h);
        PT_END(6);
    }
    if (active) {
        bf16_t* op = mix + ((size_t)b * T + q0 + 32 * qh) * D + head * 64 + r;
#pragma unroll
        for (int i = 0; i < 16; ++i) { const int qq = crow(i, h); op[(size_t)qq * D] = (bf16_t)f2bf(obuf[qq * 64]); op[(size_t)qq * D + 32] = (bf16_t)f2bf(obuf[qq * 64 + 32]); }
    }
    __syncthreads();
}

__device__ __forceinline__ void mla_unit(const Params& P, LAS unsigned char* L, int b, int hd, int qb) {
    const int tid = tid_(), lane = tid & 63, wave = __builtin_amdgcn_readfirstlane(tid >> 6), r = lane & 31, h = lane >> 5;
    unsigned char* ws = P.ws;
    const bf16_t* z = (const bf16_t*)(ws + WS_Z);
    const bf16_t* qm = (const bf16_t*)(ws + WS_QM);
    const bf16_t* kvm = (const bf16_t*)(ws + WS_KVM);
    bf16_t* mix = (bf16_t*)(ws + WS_MIX);
    const int q0 = 256 * qb, qpos = q0 + 32 * wave + r;
    const size_t qrow = (size_t)b * T + qpos;
    LAS float* wsf = (LAS float*)(L + AL_WSF) + wave * 64;
    bf16x8 qf[6];
#pragma unroll
    for (int cc = 0; cc < 6; ++cc) qf[cc] = *(const bf16x8*)(qm + qrow * QMP + hd * 96 + 16 * cc + 8 * h);
    f32x16 o0, o1, out0, out1, negm;
#pragma unroll
    for (int i = 0; i < 16; ++i) { o0[i] = 0.f; o1[i] = 0.f; negm[i] = 0.f; }
    float m = 0.f, l = 0.f;
    const bf16_t* kS = kvm + (size_t)b * T * KVP + hd * 64;
    const bf16_t* vS = kvm + (size_t)b * T * KVP + 384 + hd * 64;
    const bf16_t* rS = z + (size_t)b * T * ZP + Z_KR;
    const int nt = 4 * qb + 4, whi = (q0 + 32 * wave + 31) >> 6;
    attn_branch<MODE_MLA, 2>(L, kS, KVP, vS, KVP, rS, ZP, 0, nt, false, qf, qpos, true, 0, whi, 0, 0ull, m, negm, l, o0, o1, 0.f, 0.f, wsf, wsf, tid);
    { const float lt = l + __shfl_xor(l, 32); const float f = lt > 0.f ? 1.f / lt : 0.f;
      if (h == 0) wsf[r] = f;
      asm volatile("" ::: "memory");
#pragma unroll
      for (int i = 0; i < 16; ++i) { const float a = wsf[crow(i, h)]; out0[i] = o0[i] * a; out1[i] = o1[i] * a; } }
    bf16_t* op = mix + ((size_t)b * T + q0 + 32 * wave) * D + 384 + hd * 64 + r;
#pragma unroll
    for (int i = 0; i < 16; ++i) { const int qq = crow(i, h); op[(size_t)qq * D] = (bf16_t)f2bf(out0[i]); op[(size_t)qq * D + 32] = (bf16_t)f2bf(out1[i]); }
}

constexpr int Q_NSA = 128, Q_MLA = 96, Q_UNITS = Q_NSA + Q_MLA;
__device__ const unsigned char Q_ORDER[Q_UNITS] = {63, 127, 62, 126, 61, 125, 60, 124, 59, 123, 58, 122, 57, 121, 56, 120, 55, 119, 54, 118, 53, 117, 52, 116, 51, 115, 50, 114, 49, 113, 48, 112, 47, 111, 46, 110, 45, 109, 44, 108, 43, 107, 42, 106, 41, 105, 40, 104, 39, 103, 38, 102, 37, 101, 36, 100, 35, 99, 34, 98, 33, 97, 32, 96, 31, 95, 30, 94, 29, 93, 143, 159, 175, 191, 207, 223, 28, 92, 27, 91, 26, 90, 142, 158, 174, 190, 206, 222, 25, 89, 24, 88, 23, 87, 141, 157, 173, 189, 205, 221, 22, 86, 21, 85, 140, 156, 172, 188, 204, 220, 20, 84, 19, 83, 18, 82, 139, 155, 171, 187, 203, 219, 17, 81, 16, 80, 138, 154, 170, 186, 202, 218, 15, 79, 14, 78, 13, 77, 137, 153, 169, 185, 201, 217, 12, 76, 11, 75, 136, 152, 168, 184, 200, 216, 10, 74, 9, 73, 8, 72, 135, 151, 167, 183, 199, 215, 7, 71, 134, 150, 166, 182, 198, 214, 6, 70, 5, 69, 133, 149, 165, 181, 197, 213, 4, 68, 132, 148, 164, 180, 196, 212, 3, 67, 131, 147, 163, 179, 195, 211, 2, 66, 1, 65, 130, 146, 162, 178, 194, 210, 0, 64, 129, 145, 161, 177, 193, 209, 128, 144, 160, 176, 192, 208};
__device__ __forceinline__ unsigned xcc_id_() { return (unsigned)__builtin_amdgcn_s_getreg((3 << 11) | 20) & 0x7u; }
__device__ __forceinline__ void attention_phase(const Params& P, int layer, LAS unsigned char* L, int rep) {
    unsigned* ctr = (unsigned*)(P.ws + WS_CTL) + 1024 * rep + 512 * layer;
    LAS unsigned* bc = (LAS unsigned*)(L + AL_BC);
    const int x = (int)xcc_id_();
    for (int dx = 0; dx < 8; ++dx) {
        const int q = (x + dx) & 7;
        for (;;) {
            if (tid_() == 0) bc[0] = __hip_atomic_fetch_add(ctr + 64 * q, 1u, __ATOMIC_RELAXED, __HIP_MEMORY_SCOPE_AGENT);
            __syncthreads();
            const unsigned u = bc[0];
            __syncthreads();
            if (u >= (unsigned)Q_UNITS) break;
            PT_BEGIN(u < (unsigned)Q_NSA ? 1 : 2);
            const unsigned e = Q_ORDER[u];
            if (!(e & 0x80u)) { const int bg = 2 * q + (int)((e >> 6) & 1u), c = (int)(e & 63u); nsa_unit(P, L, bg >> 1, bg & 1, c); }
            else { const int hd = (int)((e >> 4) & 7u), qb = (int)(e & 15u); mla_unit(P, L, q, hd, qb); }
            PT_END(u < (unsigned)Q_NSA ? 1 : 2);
        }
    }
    { unsigned* pc = (unsigned*)(P.ws + WS_CTL) + 1536 + 64 * layer;
      for (;;) {
          if (tid_() == 0) bc[0] = __hip_atomic_fetch_add(pc, 1u, __ATOMIC_RELAXED, __HIP_MEMORY_SCOPE_AGENT);
          __syncthreads();
          const unsigned u = bc[0];
          __syncthreads();
          if (u >= 1024u) break;
          pool_phase(P, layer, (int)u * 8, (int)u * 8 + 8);
      } }
#if PROBE_T && PROBE_T < 20
    if (bid_() == PROBE_BLK && tid_() == 0) { LAS unsigned* pa_ = (LAS unsigned*)(PT_LDS + LDS_BYTES - 32); const unsigned long long w = (unsigned long long)pa_[0] * PROBE_MUL; pa_[0] = 0u;
        const unsigned long long t0 = __builtin_amdgcn_s_memtime(); while (__builtin_amdgcn_s_memtime() - t0 < w) __builtin_amdgcn_s_sleep(8); }
    __syncthreads();
#endif
}

__device__ __forceinline__ void final_phase(const Params& P) {
    const int tid = tid_(), bid = bid_(), gdim = gdim_(), lane = tid & 63, wave = tid >> 6;
    const float* ss = (const float*)(P.ws + WS_XPART) + (size_t)4 * M * 16; const float* gf = P.in[17];
    const bf16_t* xb = (const bf16_t*)(P.ws + WS_XB);
    for (int r = bid * 8 + wave; r < M; r += gdim * 8) {
        const float rs = rsqrtf(row_sum16(ss, r) * (1.0f / 1024.0f) + EPS);
        const u32x2* xr = (const u32x2*)(xb + (size_t)r * D) + lane;
        f32x4* orow = (f32x4*)(P.out + (size_t)r * D) + lane;
#pragma unroll
        for (int j = 0; j < 4; ++j) { const f32x4 gv = *((const f32x4*)gf + lane + 64 * j); const u32x2 a = xr[64 * j];
            f32x4 v; v[0] = __builtin_bit_cast(float, a.x << 16); v[1] = __builtin_bit_cast(float, a.x & 0xffff0000u); v[2] = __builtin_bit_cast(float, a.y << 16); v[3] = __builtin_bit_cast(float, a.y & 0xffff0000u);
            __builtin_nontemporal_store(v * rs * gv, orow + 64 * j); }
    }
}

#define XB_TMO      128
#define XB_XCNT(j)  (256  + 64 * (j))
#define XB_XSUB(j)  (1280 + 64 * (j))
#define XB_XGEN(j)  (2304 + 64 * (j))
#define XB_TOP      3328
#define XB_TOPGEN   3392
#define XCD_BAR_WORDS 3456
#define XB_SPIN_CAP (1u << 18)

__device__ __forceinline__ unsigned xb_ld(unsigned* p)              { return __hip_atomic_load(p, __ATOMIC_RELAXED, __HIP_MEMORY_SCOPE_AGENT); }
__device__ __forceinline__ unsigned xb_add(unsigned* p, unsigned v) { return __hip_atomic_fetch_add(p, v, __ATOMIC_RELAXED, __HIP_MEMORY_SCOPE_AGENT); }
__device__ __forceinline__ unsigned xb_xcc_id() { return (unsigned)__builtin_amdgcn_s_getreg((3 << 11) | 20) & 0xFu; }
#define XB_SPIN(cond, bar) do { unsigned _sp = 0; while (cond) { __builtin_amdgcn_s_sleep(1); \
    if ((++_sp & 255u) == 0u) { if (xb_ld(&(bar)[XB_TMO])) break; if (_sp > XB_SPIN_CAP) { atomicAdd(&(bar)[XB_TMO], 1u); break; } } } } while (0)

struct XcdBarrier {
    unsigned* bar; unsigned x;
    volatile LAS unsigned* st;
};

__device__ __forceinline__ XcdBarrier xcd_barrier_post(unsigned* bar, volatile LAS unsigned* st) {
    XcdBarrier b; b.bar = bar; b.x = xb_xcc_id(); b.st = st;
    if (threadIdx.x == 0) (void)xb_add(&bar[XB_XCNT(b.x)], 1u);
    return b;
}
__device__ __forceinline__ void xcd_barrier_complete(unsigned* bar, unsigned x, unsigned& nloc, unsigned& nx) {
    const unsigned G = gridDim.x * gridDim.y * gridDim.z;
    unsigned sum, cnt, mine, sp = 0u;
    for (;;) {
        sum = 0u; cnt = 0u; mine = 0u;
#pragma unroll
        for (unsigned j = 0; j < 16; ++j) { const unsigned c = xb_ld(&bar[XB_XCNT(j)]); sum += c; cnt += (c > 0u) ? 1u : 0u; mine = (j == x) ? c : mine; }
        if (sum == G) break;
        __builtin_amdgcn_s_sleep(1);
        if ((++sp & 255u) == 0u) { if (xb_ld(&bar[XB_TMO])) break; if (sp > XB_SPIN_CAP) { atomicAdd(&bar[XB_TMO], 1u); break; } }
    }
    nloc = mine > 0u ? mine : 1u; nx = cnt > 0u ? cnt : 1u;
}

__device__ __forceinline__ void xcd_barrier(const XcdBarrier& b) {
    asm volatile("s_waitcnt vmcnt(0)" ::: "memory");
    __syncthreads();
    if (threadIdx.x == 0) {
        unsigned* bar = b.bar;
        __builtin_amdgcn_s_waitcnt(0);
        unsigned nloc = b.st[0], nx = b.st[1];
        if (nloc == 0u) { xcd_barrier_complete(bar, b.x, nloc, nx); b.st[0] = nloc; b.st[1] = nx; }
        const unsigned old = xb_add(&bar[XB_XSUB(b.x)], 1u);
        const unsigned gen = old / nloc;
        if (old + 1u == (gen + 1u) * nloc) {
            __builtin_amdgcn_fence(__ATOMIC_RELEASE, "agent");
            asm volatile("s_waitcnt vmcnt(0)" ::: "memory");
            const unsigned og = xb_add(&bar[XB_TOP], 1u);
            const unsigned tg = og / nx;
            if (og + 1u == (tg + 1u) * nx) xb_add(&bar[XB_TOPGEN], 1u);
            else XB_SPIN(xb_ld(&bar[XB_TOPGEN]) == tg, bar);
            __builtin_amdgcn_fence(__ATOMIC_ACQUIRE, "agent");
            xb_add(&bar[XB_XGEN(b.x)], 1u);
            asm volatile("s_waitcnt vmcnt(0)" ::: "memory");
        } else {
            XB_SPIN(xb_ld(&bar[XB_XGEN(b.x)]) == gen, bar);
            __builtin_amdgcn_fence(__ATOMIC_ACQUIRE, "agent");
            asm volatile("s_waitcnt vmcnt(0)" ::: "memory");
        }
    }
    __syncthreads();
}

__device__ __forceinline__ unsigned char* ws_of(const Params& P) { unsigned char* w = P.ws; asm volatile("" : "+s"(w)); return w; }
#ifndef PMASK
#define PMASK 0xffffffffu
#endif
#ifndef PROBE_K
#define PROBE_K 0
#endif
constexpr int N_PHASES_C = 1 + 6 * DEPTH + 1;
__global__ void __launch_bounds__(512) trunk_fwd(Params P, int ph_lo, int ph_hi) {
    extern __shared__ __attribute__((aligned(16))) unsigned char lds_raw[];
    LAS unsigned char* lds = (LAS unsigned char*)lds_raw;
    cg::grid_group grid = cg::this_grid();
    volatile LAS unsigned* bst = (volatile LAS unsigned*)(lds + LDS_BYTES - 64);
    if (threadIdx.x < 16) bst[threadIdx.x] = 0u;
    __syncthreads();
    XcdBarrier bar = xcd_barrier_post((unsigned*)(P.ws + WS_CTL) + 4096, bst);
    if (ph_lo < 0) grid.sync();
    for (int ph = ph_lo; ph < ph_hi; ++ph) {
        const int l = (ph - 1) / 6, k = (ph == 0) ? 0 : ((ph == 1 + 6 * DEPTH) ? 7 : 1 + (ph - 1) % 6);
        PT_BEGIN(20 + k);
        unsigned char* ws = ws_of(P);
        float* xpb = (float*)(ws + WS_XPART); float* cpb = (float*)(ws + WS_CPART);
        if (k == 0) { if (PMASK & 1u) prologue(P, lds); }
        else if (k == 1) { if (PMASK & 2u) {
            const float* ropec = (const float*)(ws + WS_ROPE);
            EpiInProj E{(bf16_t*)(ws + WS_Z), (l == 0) ? xpb : xpb + (size_t)2 * M * 16, cpb + (size_t)(2 * l) * M * 4, cpb + (size_t)(2 * l + 1) * M * 4, ropec, ropec + (size_t)M * 16};
            run_gemm(lds, (const bf16_t*)(ws + WS_XB), D, (const bf16_t*)(ws + WS_WIN) + (size_t)l * ZP * D, ZP, D, E); } }
        else if (k == 2) {
            if (PMASK & 4u) { const float* ropec = (const float*)(ws + WS_ROPE); EpiQup E{(bf16_t*)(ws + WS_QM), cpb + (size_t)(2 * l) * M * 4, ropec, ropec + (size_t)M * 16};
                run_gemm(lds, (const bf16_t*)(ws + WS_Z) + Z_CQ, ZP, (const bf16_t*)(ws + WS_WQUP) + (size_t)l * 768 * 256, 768, 256, E); }
            if (PMASK & 8u) { unsigned char* ws2 = ws_of(P); EpiKVup E{(bf16_t*)(ws2 + WS_KVM), (const float*)(ws2 + WS_CPART) + (size_t)(2 * l + 1) * M * 4};
                run_gemm(lds, (const bf16_t*)(ws2 + WS_Z) + Z_CKV, ZP, (const bf16_t*)(ws2 + WS_WKVUP) + (size_t)l * 768 * 128, 768, 128, E, true); }
            if (PMASK & 16u) compress_phase(P, l, lds);
#if PROBE_K == 21
            compress_phase(P, l, lds);
#endif
        }
        else if (k == 3) { if (PMASK & 64u) { attention_phase(P, l, lds, 0);
#if PROBE_K == 3
            attention_phase(P, l, lds, 1);
#endif
        } }
        else if (k == 4) { if (PMASK & 128u) { EpiResid E{(bf16_t*)(ws + WS_XB), xpb + (size_t)(1 + 2 * l) * M * 16};
            run_gemm(lds, (const bf16_t*)(ws + WS_MIX), D, (const bf16_t*)(ws + WS_WOUT) + (size_t)l * D * D, D, D, E); } }
        else if (k == 5) { if (PMASK & 256u) { EpiFF1 E{(bf16_t*)(ws + WS_H), xpb + (size_t)(1 + 2 * l) * M * 16};
            run_gemm(lds, (const bf16_t*)(ws + WS_XB), D, (const bf16_t*)(ws + WS_WFF1) + (size_t)l * FF * D, FF, D, E); } }
        else if (k == 6) { if (PMASK & 512u) { EpiResid E{(bf16_t*)(ws + WS_XB), xpb + (size_t)(2 + 2 * l) * M * 16};
            run_gemm(lds, (const bf16_t*)(ws + WS_H), FF, (const bf16_t*)(ws + WS_WFF2) + (size_t)l * D * FF, D, FF, E); } }
        else { if (PMASK & 1024u) final_phase(P); }
        if (ph + 1 < ph_hi) xcd_barrier(bar);
        PT_END(20 + k);
#if PROBE_T >= 20
        if (ph == N_PHASES_C - 2) { if (bid_() == PROBE_BLK && tid_() == 0) { LAS unsigned* pa_ = (LAS unsigned*)(PT_LDS + LDS_BYTES - 32); const unsigned long long w = (unsigned long long)pa_[0] * PROBE_MUL; pa_[0] = 0u;
            const unsigned long long t0 = __builtin_amdgcn_s_memtime(); while (__builtin_amdgcn_s_memtime() - t0 < w) __builtin_amdgcn_s_sleep(8); }
            __syncthreads(); xcd_barrier(bar); }
#endif
    }
#if PROBE_T == 27
    if (bid_() == PROBE_BLK && tid_() == 0) { LAS unsigned* pa_ = (LAS unsigned*)(PT_LDS + LDS_BYTES - 32); const unsigned long long w = (unsigned long long)pa_[0] * PROBE_MUL;
        const unsigned long long t0 = __builtin_amdgcn_s_memtime(); while (__builtin_amdgcn_s_memtime() - t0 < w) __builtin_amdgcn_s_sleep(8); }
#endif
}
constexpr int N_PHASES = 1 + 6 * DEPTH + 1;

#ifndef MK_MULTI
#define MK_MULTI 0
#endif
extern "C" void kernel_launch(void* const* d_in, const int* in_sizes, int n_in, void* d_out, int out_size, void* d_ws, size_t ws_size, hipStream_t stream) {
    static int grid_blocks = 0;
    if (grid_blocks == 0) {
        if (n_in != 18 || out_size != M * D || ws_size < WS_END) { fprintf(stderr, "kernel_launch: unexpected shapes (n_in %d out %d ws %zu)\n", n_in, out_size, ws_size); grid_blocks = -1; return; }
        int dev = 0, cus = 0, per_cu = 0;
        hipGetDevice(&dev);
        hipDeviceGetAttribute(&cus, hipDeviceAttributeMultiprocessorCount, dev);
        if (hipFuncSetAttribute((const void*)trunk_fwd, hipFuncAttributeMaxDynamicSharedMemorySize, LDS_BYTES) != hipSuccess) { fprintf(stderr, "kernel_launch: hipFuncSetAttribute failed\n"); grid_blocks = -1; return; }
        if (hipOccupancyMaxActiveBlocksPerMultiprocessor(&per_cu, (const void*)trunk_fwd, 512, LDS_BYTES) != hipSuccess || per_cu < 1) { fprintf(stderr, "kernel_launch: occupancy query gave %d\n", per_cu); per_cu = 1; }
        (void)hipGetLastError();
        grid_blocks = cus * per_cu;
    }
    if (grid_blocks < 0) return;
    Params p{};
    for (int i = 0; i < 18; ++i) p.in[i] = (const float*)d_in[i];
    p.out = (float*)d_out; p.ws = (unsigned char*)d_ws;
    if (hipMemsetAsync(d_ws, 0, 65536, stream) != hipSuccess) { fprintf(stderr, "kernel_launch: memset failed\n"); return; }
    int lo = 0, hi = N_PHASES;
    void* args[] = {&p, &lo, &hi};
    hipError_t e = hipLaunchCooperativeKernel((const void*)trunk_fwd, dim3(grid_blocks), dim3(512), args, LDS_BYTES, stream);
    if (e != hipSuccess) fprintf(stderr, "cooperative launch failed: %s (grid %d)\n", hipGetErrorString(e), grid_blocks);
}
```
